# Optimizing an MI355X kernel written in HIP

```python
import jax, jax.numpy as jnp
from jax import lax
import numpy as np

D_MODEL = 1024
BATCH = 8
SEQ = 2048
DEPTH = 2

D_FF = 2816
NORM_EPS = 1e-6
LRU_WIDTH = 512
LRU_HEADS = 8
LRU_HEAD_DIM = LRU_WIDTH // LRU_HEADS
LRU_CONV_WIDTH = 4
LRU_C = 8.0
MLA_HEADS = 8
QK_NOPE_DIM = 64
QK_ROPE_DIM = 32
V_HEAD_DIM = 64
Q_LORA_RANK = 384
KV_LORA_RANK = 256
ROPE_THETA = 10000.0
Q_BLOCK = 128
CONV_CH = 512
CONV_WIDTH = 31
N_BRANCH = 3
IN_A = 2 * LRU_WIDTH
IN_B = Q_LORA_RANK + KV_LORA_RANK + QK_ROPE_DIM
IN_C = 2 * CONV_CH
IN_G = N_BRANCH * D_MODEL
D_IN = IN_A + IN_B + IN_C + IN_G
MAX_POS_OFFSET = 4096

kernel_name = 'hybrid_rglru_mla_conformer_macaron'


def rms_norm(x, g):
    xf = x.astype(jnp.float32)
    y = xf * lax.rsqrt(jnp.mean(xf * xf, axis=-1, keepdims=True) + NORM_EPS)
    return (y * g.astype(jnp.float32)).astype(x.dtype)


def layer_norm(x, g, b):
    xf = x.astype(jnp.float32)
    mu = jnp.mean(xf, axis=-1, keepdims=True)
    var = jnp.mean(jnp.square(xf - mu), axis=-1, keepdims=True)
    y = (xf - mu) * lax.rsqrt(var + NORM_EPS)
    return (y * g.astype(jnp.float32) + b.astype(jnp.float32)).astype(x.dtype)


def swiglu(x, w1, w2):
    gu = x @ w1
    g, u = gu[..., :D_FF], gu[..., D_FF:]
    return (jax.nn.silu(g) * u) @ w2


def causal_depthwise_conv(x, w, b):
    k = w.shape[0]
    y = lax.conv_general_dilated(
        x, w[:, None, :].astype(x.dtype), window_strides=(1,), padding=[(k - 1, 0)],
        dimension_numbers=('NWC', 'WIO', 'NWC'), feature_group_count=x.shape[-1])
    return y + b.astype(x.dtype)


def rg_lru(x, w_gate, b_gate, lam):
    b, s, w = x.shape
    xf = x.astype(jnp.float32)
    xh = xf.reshape(b, s, LRU_HEADS, LRU_HEAD_DIM)
    gates = jnp.einsum('bshd,hde->bshe', xh, w_gate.astype(jnp.float32)) + b_gate.astype(jnp.float32)
    r = jax.nn.sigmoid(gates[..., :LRU_HEAD_DIM]).reshape(b, s, w)
    i = jax.nn.sigmoid(gates[..., LRU_HEAD_DIM:]).reshape(b, s, w)
    log_a = -LRU_C * r * jax.nn.softplus(-lam.astype(jnp.float32))
    a = jnp.exp(log_a)
    u = jnp.sqrt(-jnp.expm1(2.0 * log_a)) * (i * xf)

    def combine(left, right):
        a_l, h_l = left
        a_r, h_r = right
        return a_l * a_r, a_r * h_l + h_r

    _, h = lax.associative_scan(combine, (a, u), axis=1)
    return h.astype(x.dtype)


def rope_tables(positions):
    inv_freq = ROPE_THETA ** (-jnp.arange(0, QK_ROPE_DIM, 2, dtype=jnp.float32) / QK_ROPE_DIM)
    ang = positions.astype(jnp.float32)[..., None] * inv_freq
    return jnp.cos(ang), jnp.sin(ang)


def apply_rope(x, cos, sin):
    half = x.shape[-1] // 2
    x1, x2 = x[..., :half], x[..., half:]
    cos = cos.astype(x.dtype)
    sin = sin.astype(x.dtype)
    return jnp.concatenate([x1 * cos - x2 * sin, x2 * cos + x1 * sin], axis=-1)


def mla_branch(cq, ckv, kpe, positions, q_norm, w_uq, kv_norm, w_ukv, w_o):
    b, s, _ = cq.shape
    q = (rms_norm(cq, q_norm) @ w_uq).reshape(b, s, MLA_HEADS, QK_NOPE_DIM + QK_ROPE_DIM)
    q_nope, q_pe = q[..., :QK_NOPE_DIM], q[..., QK_NOPE_DIM:]
    kv = (rms_norm(ckv, kv_norm) @ w_ukv).reshape(b, s, MLA_HEADS, QK_NOPE_DIM + V_HEAD_DIM)
    k_nope, v = kv[..., :QK_NOPE_DIM], kv[..., QK_NOPE_DIM:]
    cos, sin = rope_tables(positions)
    q_pe = apply_rope(q_pe, cos[:, :, None, :], sin[:, :, None, :])
    k_pe = apply_rope(kpe, cos, sin)
    n_blk = s // Q_BLOCK
    qn_blocks = q_nope.reshape(b, n_blk, Q_BLOCK, MLA_HEADS, QK_NOPE_DIM).swapaxes(0, 1)
    qp_blocks = q_pe.reshape(b, n_blk, Q_BLOCK, MLA_HEADS, QK_ROPE_DIM).swapaxes(0, 1)
    scale = (QK_NOPE_DIM + QK_ROPE_DIM) ** -0.5
    key_idx = jnp.arange(s)

    def attend(args):
        qn, qp, blk = args
        sc = (jnp.einsum('bqhd,bkhd->bhqk', qn, k_nope, preferred_element_type=jnp.float32)
              + jnp.einsum('bqhr,bkr->bhqk', qp, k_pe, preferred_element_type=jnp.float32)) * scale
        q_idx = blk * Q_BLOCK + jnp.arange(Q_BLOCK)
        mask = key_idx[None, :] <= q_idx[:, None]
        sc = jnp.where(mask, sc, jnp.finfo(jnp.float32).min)
        p = jax.nn.softmax(sc, axis=-1).astype(v.dtype)
        return jnp.einsum('bhqk,bkhd->bqhd', p, v)

    o = lax.map(attend, (qn_blocks, qp_blocks, jnp.arange(n_blk)))
    o = o.swapaxes(0, 1).reshape(b, s, MLA_HEADS * V_HEAD_DIM)
    return o @ w_o


def conformer_conv_branch(pc, dw_w, dw_b, ln_g, ln_b, w_pw, b_pw):
    c = pc[..., :CONV_CH] * jax.nn.sigmoid(pc[..., CONV_CH:])
    c = causal_depthwise_conv(c, dw_w, dw_b)
    c = jax.nn.silu(layer_norm(c, ln_g, ln_b))
    return c @ w_pw + b_pw


def hybrid_mixer(h, positions, w_in, b_in, lru_conv_w, lru_conv_b, lru_w_gate, lru_b_gate,
                 lru_lambda, lru_w_out, q_norm, w_uq, kv_norm, w_ukv, mla_w_o,
                 conv_dw_w, conv_dw_b, conv_ln_g, conv_ln_b, conv_w_out, conv_b_out, w_out):
    proj = h @ w_in + b_in
    o1, o2, o3 = IN_A, IN_A + IN_B, IN_A + IN_B + IN_C
    pa, pb, pc, pg = proj[..., :o1], proj[..., o1:o2], proj[..., o2:o3], proj[..., o3:]
    xa = causal_depthwise_conv(pa[..., :LRU_WIDTH], lru_conv_w, lru_conv_b)
    y_a = (rg_lru(xa, lru_w_gate, lru_b_gate, lru_lambda) * jax.nn.gelu(pa[..., LRU_WIDTH:])) @ lru_w_out
    cq = pb[..., :Q_LORA_RANK]
    ckv = pb[..., Q_LORA_RANK:Q_LORA_RANK + KV_LORA_RANK]
    kpe = pb[..., Q_LORA_RANK + KV_LORA_RANK:]
    y_b = mla_branch(cq, ckv, kpe, positions, q_norm, w_uq, kv_norm, w_ukv, mla_w_o)
    y_c = conformer_conv_branch(pc, conv_dw_w, conv_dw_b, conv_ln_g, conv_ln_b, conv_w_out, conv_b_out)
    gates = jax.nn.sigmoid(pg.astype(jnp.float32)).astype(h.dtype)
    gates = gates.reshape(*pg.shape[:-1], N_BRANCH, D_MODEL)
    merged = gates[..., 0, :] * y_a + gates[..., 1, :] * y_b + gates[..., 2, :] * y_c
    return merged @ w_out


def setup_inputs(seed: int = 0) -> dict:
    key = jax.random.key(seed)
    ks = iter(jax.random.split(key, 48))
    L = DEPTH

    def w(shape, fan_in):
        return jax.random.normal(next(ks), shape, jnp.float32) * fan_in ** -0.5

    def gain(shape):
        return 1.0 + 0.02 * jax.random.normal(next(ks), shape, jnp.float32)

    def bias(shape):
        return 0.02 * jax.random.normal(next(ks), shape, jnp.float32)

    x = jax.random.normal(next(ks), (BATCH, SEQ, D_MODEL), jnp.float32)
    offsets = jax.random.randint(next(ks), (BATCH, 1), 0, MAX_POS_OFFSET, dtype=jnp.int32)
    positions = offsets + jnp.arange(SEQ, dtype=jnp.int32)[None, :]
    u = jax.random.uniform(next(ks), (L, LRU_WIDTH), jnp.float32, 0.9, 0.999)
    a0 = u ** (1.0 / LRU_C)
    lru_lambda = jnp.log(a0) - jnp.log1p(-a0)
    return {
        'x': x,
        'positions': positions,
        'ffn1_norm': gain((L, D_MODEL)),
        'ffn1_w1': w((L, D_MODEL, 2 * D_FF), D_MODEL),
        'ffn1_w2': w((L, D_FF, D_MODEL), D_FF),
        'mix_norm': gain((L, D_MODEL)),
        'w_in': w((L, D_MODEL, D_IN), D_MODEL),
        'b_in': bias((L, D_IN)),
        'lru_conv_w': w((L, LRU_CONV_WIDTH, LRU_WIDTH), LRU_CONV_WIDTH),
        'lru_conv_b': bias((L, LRU_WIDTH)),
        'lru_w_gate': w((L, LRU_HEADS, LRU_HEAD_DIM, 2 * LRU_HEAD_DIM), LRU_HEAD_DIM),
        'lru_b_gate': bias((L, LRU_HEADS, 2 * LRU_HEAD_DIM)),
        'lru_lambda': lru_lambda,
        'lru_w_out': w((L, LRU_WIDTH, D_MODEL), LRU_WIDTH),
        'q_norm': gain((L, Q_LORA_RANK)),
        'w_uq': w((L, Q_LORA_RANK, MLA_HEADS * (QK_NOPE_DIM + QK_ROPE_DIM)), Q_LORA_RANK),
        'kv_norm': gain((L, KV_LORA_RANK)),
        'w_ukv': w((L, KV_LORA_RANK, MLA_HEADS * (QK_NOPE_DIM + V_HEAD_DIM)), KV_LORA_RANK),
        'mla_w_o': w((L, MLA_HEADS * V_HEAD_DIM, D_MODEL), MLA_HEADS * V_HEAD_DIM),
        'conv_dw_w': w((L, CONV_WIDTH, CONV_CH), CONV_WIDTH),
        'conv_dw_b': bias((L, CONV_CH)),
        'conv_ln_g': gain((L, CONV_CH)),
        'conv_ln_b': bias((L, CONV_CH)),
        'conv_w_out': w((L, CONV_CH, D_MODEL), CONV_CH),
        'conv_b_out': bias((L, D_MODEL)),
        'w_out': w((L, D_MODEL, D_MODEL), D_MODEL),
        'ffn2_norm': gain((L, D_MODEL)),
        'ffn2_w1': w((L, D_MODEL, 2 * D_FF), D_MODEL),
        'ffn2_w2': w((L, D_FF, D_MODEL), D_FF),
        'final_norm': gain((D_MODEL,)),
    }


def reference(x, positions, ffn1_norm, ffn1_w1, ffn1_w2, mix_norm, w_in, b_in,
              lru_conv_w, lru_conv_b, lru_w_gate, lru_b_gate, lru_lambda, lru_w_out,
              q_norm, w_uq, kv_norm, w_ukv, mla_w_o,
              conv_dw_w, conv_dw_b, conv_ln_g, conv_ln_b, conv_w_out, conv_b_out,
              w_out, ffn2_norm, ffn2_w1, ffn2_w2, final_norm):
    for l in range(DEPTH):
        x = x + 0.5 * swiglu(rms_norm(x, ffn1_norm[l]), ffn1_w1[l], ffn1_w2[l])
        x = x + hybrid_mixer(
            rms_norm(x, mix_norm[l]), positions, w_in[l], b_in[l],
            lru_conv_w[l], lru_conv_b[l], lru_w_gate[l], lru_b_gate[l], lru_lambda[l], lru_w_out[l],
            q_norm[l], w_uq[l], kv_norm[l], w_ukv[l], mla_w_o[l],
            conv_dw_w[l], conv_dw_b[l], conv_ln_g[l], conv_ln_b[l], conv_w_out[l], conv_b_out[l],
            w_out[l])
        x = x + 0.5 * swiglu(rms_norm(x, ffn2_norm[l]), ffn2_w1[l], ffn2_w2[l])
    return rms_norm(x, final_norm)
```

```cpp
#include <hip/hip_runtime.h>
#include <hip/hip_cooperative_groups.h>
#include <cstdio>
#include <cstdint>
namespace cg = cooperative_groups;

#define LAS __attribute__((address_space(3)))
typedef unsigned short bf16_t;
typedef short bf16x8 __attribute__((ext_vector_type(8)));
typedef short s16x4 __attribute__((ext_vector_type(4)));
typedef float f32x2 __attribute__((ext_vector_type(2)));
typedef float f32x4 __attribute__((ext_vector_type(4)));
typedef float f32x16 __attribute__((ext_vector_type(16)));
typedef unsigned u32x2 __attribute__((ext_vector_type(2)));
typedef unsigned u32x4 __attribute__((ext_vector_type(4)));

#ifndef REP_ATT
#define REP_ATT 1
#endif
#ifndef REP_F1UP
#define REP_F1UP 1
#endif
#ifndef REP_WIN
#define REP_WIN 1
#endif
#ifndef REP_S4G
#define REP_S4G 1
#endif
#ifndef REP_CONV
#define REP_CONV 1
#endif
#ifndef REP_MERGE
#define REP_MERGE 1
#endif
#ifndef REP_SYNC
#define REP_SYNC 1
#endif
#ifndef REP_CVT
#define REP_CVT 1
#endif
#ifndef REP_LRU
#define REP_LRU 1
#endif
constexpr int MROWS = 16384, DM = 1024, FF = 2816, SEQ = 2048, NB = 8;
constexpr int DIN = 5792, DINP = 5888;
constexpr float EPS = 1e-6f;
constexpr float QSCALE = 0.10206207261596577f * 1.4426950408889634f;

__device__ __forceinline__ unsigned cvt_pk_bf16(float lo, float hi) { unsigned r; asm volatile("v_cvt_pk_bf16_f32 %0, %1, %2" : "=v"(r) : "v"(lo), "v"(hi)); return r; }
__device__ __forceinline__ float bflo(unsigned w) { return __uint_as_float(w << 16); }
__device__ __forceinline__ float bfhi(unsigned w) { return __uint_as_float(w & 0xffff0000u); }
__device__ __forceinline__ float bf2f(bf16_t v) { return __uint_as_float(((unsigned)v) << 16); }
__device__ __forceinline__ bf16_t f2bf(float f) { return (bf16_t)(cvt_pk_bf16(f, 0.f) & 0xffffu); }
__device__ __forceinline__ float fast_sigmoid(float x) { return __builtin_amdgcn_rcpf(1.0f + __builtin_amdgcn_exp2f(-1.4426950408889634f * x)); }
__device__ __forceinline__ float wave_sum(float v) {
#pragma unroll
    for (int o = 1; o < 64; o <<= 1) v += __shfl_xor(v, o);
    return v;
}

__device__ __forceinline__ float sum_slots16(const float* p) { const f32x4 a = *(const f32x4*)p, b = *(const f32x4*)(p + 4), c = *(const f32x4*)(p + 8), d = *(const f32x4*)(p + 12);
    return (((a[0] + a[1]) + (a[2] + a[3])) + ((b[0] + b[1]) + (b[2] + b[3]))) + (((c[0] + c[1]) + (c[2] + c[3])) + ((d[0] + d[1]) + (d[2] + d[3]))); }
__device__ __forceinline__ float sum_slots12(const float* p) { const f32x4 a = *(const f32x4*)p, b = *(const f32x4*)(p + 4), c = *(const f32x4*)(p + 8);
    return (((a[0] + a[1]) + (a[2] + a[3])) + ((b[0] + b[1]) + (b[2] + b[3]))) + ((c[0] + c[1]) + (c[2] + c[3])); }
__device__ __forceinline__ float sum_slots8(const float* p) { const f32x4 a = *(const f32x4*)p, b = *(const f32x4*)(p + 4);
    return ((a[0] + a[1]) + (a[2] + a[3])) + ((b[0] + b[1]) + (b[2] + b[3])); }

namespace pg8 {
constexpr int BM = 256, BK = 64, HALF = 128, HTB = HALF * BK * 2, STAGE_BYTES = 8 * HTB, NXCD = 8, WGM = 4;
__host__ __device__ __forceinline__ int lds_byte(int r, int c) { const int st = (r >> 4) * 2 + (c >> 5), rr = r & 15, cc = c & 31, ob = rr * 64 + cc * 2; return st * 1024 + (ob ^ (((ob >> 9) & 1) << 5)); }
__host__ __device__ __forceinline__ void stage_rc(int b, int& R, int& C) { const int st = b / 1024, sb = b % 1024, swz = sb ^ (((sb >> 9) & 1) << 5); R = (st >> 1) * 16 + swz / 64; C = (st & 1) * 32 + (swz % 64) / 2; }
__host__ __device__ __forceinline__ int perm32(int rho) { const int n = rho >> 4, i = rho & 15; return 8 * (i >> 2) + 4 * n + (i & 3); }

struct Unit { int pm, pn, seg, split, slot; };
struct Gemm { const bf16_t *A0, *A1, *A2; const bf16_t *B0, *B1, *B2; int M, N, K, LD;
    __device__ __forceinline__ const char* a(int s) const { return (const char*)(s == 0 ? A0 : (s == 1 ? A1 : A2)); }
    __device__ __forceinline__ const char* b(int s) const { return (const char*)(s == 0 ? B0 : (s == 1 ? B1 : B2)); } };

__device__ __forceinline__ void unit_of(int L, int nwg, int nM, int nN, Unit& u) {
    int wgid = L; { const int q = nwg / NXCD, r = nwg % NXCD, xcd = wgid % NXCD, off = wgid / NXCD; wgid = (xcd < r ? xcd * (q + 1) : r * (q + 1) + (xcd - r) * q) + off; }
    const int nig = WGM * nN, gid = wgid / nig, fm = gid * WGM, gsz = (nM - fm) < WGM ? (nM - fm) : WGM;
    u.pm = fm + ((wgid % nig) % gsz); u.pn = (wgid % nig) / gsz;
}
struct StaticOrder {
    int nM, nN, nwg, G, c, nseg, nlim;
    __device__ __forceinline__ void init(int M, int N, int G_, int c_, int nseg_, bool split_tail = false) { nM = M / BM; nN = N / BM; nwg = nM * nN; G = G_; c = c_; nseg = nseg_;
        nlim = (split_tail && 2 * (nwg % G_) == G_) ? (nwg / G_) * G_ : nwg; }
    __device__ __forceinline__ bool next(int i, Unit& u) const {
        const int ti = i / nseg; u.seg = i - ti * nseg; u.split = 0; u.slot = 0;
        const long L = (long)ti * G + c; if (L >= nlim) return false;
        unit_of((int)L, nwg, nM, nN, u); return true;
    }
};
struct TailOrder {
    int nM, nN, nwg, G, c, on;
    __device__ __forceinline__ void init(int M, int N, int G_, int c_) { nM = M / BM; nN = N / BM; nwg = nM * nN; G = G_; c = c_; on = 0; (void)G_; }
    __device__ __forceinline__ int half() const { return (c >= (G >> 1)) ? 1 : 0; }
    __device__ __forceinline__ bool next(int i, Unit& u) const {
        if (!on || i != 0) return false;
        u.seg = 0; u.slot = c - half() * (G >> 1); u.split = 1 + half();
        unit_of((nwg / G) * G + u.slot, nwg, nM, nN, u); return true;
    }
};

template <class Epi, bool ALIGN_EPI, class Order = StaticOrder>
__device__ __forceinline__ void gemm_phase(LAS unsigned char* lds, const Gemm g, const Order& S, const Epi& E) {
    int tid_ = threadIdx.x; asm volatile("" : "+v"(tid_));
    const int tid = tid_, wid = __builtin_amdgcn_readfirstlane(tid >> 6), lane = tid & 63, wr = wid >> 2, wc = wid & 3, fr = lane & 15, fq = lane >> 4;
    const int K = g.LD, nt = g.K / BK;
    const char *gA0 = (const char*)g.A0, *gA1 = (const char*)g.A1, *gA2 = (const char*)g.A2, *gB0 = (const char*)g.B0, *gB1 = (const char*)g.B1, *gB2 = (const char*)g.B2;
    asm volatile("" : "+s"(gA0), "+s"(gA1), "+s"(gA2), "+s"(gB0), "+s"(gB1), "+s"(gB2));
#define PG8_SELA(s) ((s) == 0 ? gA0 : ((s) == 1 ? gA1 : gA2))
#define PG8_SELB(s) ((s) == 0 ? gB0 : ((s) == 1 ? gB1 : gB2))
    unsigned voffA[2], voffB[2];
#pragma unroll
    for (int i = 0; i < 2; ++i) { int R, C; stage_rc(tid * 16 + i * 8192, R, C); const int Rb = Epi::PERM ? ((R & ~31) + perm32(R & 31)) : R;
        voffA[i] = (unsigned)(R * K + C) * 2u; voffB[i] = (unsigned)(Rb * K + C) * 2u; }
    const size_t kstep = (size_t)(BK * 2);
    const size_t hstep = (size_t)HALF * K * 2;
    const size_t tstep = 2 * hstep;
    const unsigned ldsw = (unsigned)wid * 1024u;
    const int aoff = lds_byte(wr * 64 + fr, fq * 8), boff = lds_byte(wc * 32 + fr, fq * 8);
#define PG8_SA(b, h) (((b) * 2 + (h)) * HTB)
#define PG8_SB(b, h) ((4 + (b) * 2 + (h)) * HTB)
#define PG8_STAGE(bufoff, gbase, voff) do { _Pragma("unroll") for (int _i = 0; _i < 2; ++_i) \
        __builtin_amdgcn_global_load_lds((const unsigned*)((const char*)(gbase) + (voff)[_i]), (LAS unsigned*)(lds + (bufoff) + ldsw + _i * 8192), 16, 0, 0); } while (0)
#define PG8_LDA(dst, b, h) do { _Pragma("unroll") for (int m = 0; m < 4; ++m) _Pragma("unroll") for (int k = 0; k < 2; ++k) dst[m][k] = *(const LAS bf16x8*)(lds + PG8_SA(b, h) + aoff + m * 2048 + k * 1024); } while (0)
#define PG8_LDB(dst, b, h) do { _Pragma("unroll") for (int n = 0; n < 2; ++n) _Pragma("unroll") for (int k = 0; k < 2; ++k) dst[n][k] = *(const LAS bf16x8*)(lds + PG8_SB(b, h) + boff + n * 2048 + k * 1024); } while (0)
#define PG8_MMA(ai, bj, At, Bt) do { __builtin_amdgcn_s_setprio(1); _Pragma("unroll") for (int m = 0; m < 4; ++m) _Pragma("unroll") for (int n = 0; n < 2; ++n) _Pragma("unroll") for (int k = 0; k < 2; ++k) \
        acc[ai][bj][m][n] = __builtin_amdgcn_mfma_f32_16x16x32_bf16(Bt[n][k], At[m][k], acc[ai][bj][m][n], 0, 0, 0); __builtin_amdgcn_s_setprio(0); } while (0)
#define PG8_WAIT_V(n) asm volatile("s_waitcnt vmcnt(" #n ")" ::: "memory")
#define PG8_WAIT_L(n) asm volatile("s_waitcnt lgkmcnt(" #n ")" ::: "memory")
#define PG8_BAR __builtin_amdgcn_s_barrier()
#define PG8_SCHED __builtin_amdgcn_sched_barrier(0)
    Unit cur, nxt; int ui = 0;
    if (!S.next(0, cur)) return;
    f32x4 acc[2][2][4][2];
#pragma unroll
    for (int a = 0; a < 2; ++a)
#pragma unroll
        for (int b = 0; b < 2; ++b)
#pragma unroll
            for (int m = 0; m < 4; ++m)
#pragma unroll
                for (int n = 0; n < 2; ++n) acc[a][b][m][n] = (f32x4){0.f, 0.f, 0.f, 0.f};
    bf16x8 At[4][2], B0[2][2], B1[2][2];
    const char* cA = PG8_SELA(cur.seg) + (size_t)cur.pm * tstep; const char* cB = PG8_SELB(cur.seg) + (size_t)cur.pn * tstep;
    PG8_STAGE(PG8_SB(0, 0), cB, voffB); PG8_STAGE(PG8_SB(0, 1), cB + hstep, voffB); PG8_STAGE(PG8_SA(0, 0), cA, voffA); PG8_STAGE(PG8_SA(0, 1), cA + hstep, voffA);
    if (wr == 1) PG8_BAR;
    PG8_WAIT_V(2); PG8_BAR;
    PG8_STAGE(PG8_SB(1, 0), cB + kstep, voffB); PG8_STAGE(PG8_SA(1, 0), cA + kstep, voffA); PG8_STAGE(PG8_SB(1, 1), cB + hstep + kstep, voffB);
    PG8_WAIT_V(6); PG8_BAR;
    for (;;) {
        const bool has_next = S.next(ui + 1, nxt);
        const char* nA = has_next ? PG8_SELA(nxt.seg) + (size_t)nxt.pm * tstep : cA; const char* nB = has_next ? PG8_SELB(nxt.seg) + (size_t)nxt.pn * tstep : cB;
#pragma unroll 1
        for (int t = 0; t < nt; t += 2) {
            const bool last = (t == nt - 2);
            const char* a1 = cA + (size_t)(t + 1) * kstep;
            const char* a2 = last ? nA : cA + (size_t)(t + 2) * kstep; const char* b2 = last ? nB : cB + (size_t)(t + 2) * kstep;
            const char* a3 = a2 + kstep; const char* b3 = b2 + kstep;
            PG8_LDB(B0, 0, 0); PG8_LDB(B1, 0, 1); PG8_SCHED; PG8_LDA(At, 0, 0); PG8_STAGE(PG8_SA(1, 1), a1 + hstep, voffA);
            PG8_WAIT_V(8); PG8_WAIT_L(0); PG8_BAR; PG8_MMA(0, 0, At, B0); PG8_MMA(0, 1, At, B1); PG8_BAR; PG8_SCHED;
            PG8_LDA(At, 0, 1); PG8_STAGE(PG8_SB(0, 0), b2, voffB); PG8_STAGE(PG8_SB(0, 1), b2 + hstep, voffB); PG8_STAGE(PG8_SA(0, 0), a2, voffA);
            PG8_WAIT_V(8); PG8_WAIT_L(0); PG8_BAR; PG8_MMA(1, 0, At, B0); PG8_MMA(1, 1, At, B1); PG8_BAR; PG8_SCHED;
            PG8_LDB(B0, 1, 0); PG8_LDB(B1, 1, 1); PG8_SCHED; PG8_LDA(At, 1, 0); PG8_STAGE(PG8_SA(0, 1), a2 + hstep, voffA);
            PG8_WAIT_V(8); PG8_WAIT_L(0); PG8_BAR; PG8_MMA(0, 0, At, B0); PG8_MMA(0, 1, At, B1); PG8_BAR; PG8_SCHED;
            PG8_LDA(At, 1, 1); PG8_STAGE(PG8_SB(1, 0), b3, voffB); PG8_STAGE(PG8_SB(1, 1), b3 + hstep, voffB); PG8_STAGE(PG8_SA(1, 0), a3, voffA);
            PG8_WAIT_V(8); PG8_WAIT_L(0); PG8_BAR; PG8_MMA(1, 0, At, B0); PG8_MMA(1, 1, At, B1); PG8_BAR; PG8_SCHED;
        }
        if constexpr (ALIGN_EPI) { if (wr == 0) PG8_BAR; }
        const bool zero = E(acc, cur, wr, wc, fr, fq);
        if (!has_next) break;
        if (zero) {
#pragma unroll
            for (int a = 0; a < 2; ++a)
#pragma unroll
                for (int b = 0; b < 2; ++b)
#pragma unroll
                    for (int m = 0; m < 4; ++m)
#pragma unroll
                        for (int n = 0; n < 2; ++n) acc[a][b][m][n] = (f32x4){0.f, 0.f, 0.f, 0.f};
        }
        cur = nxt; cA = nA; cB = nB; ++ui;
        if constexpr (ALIGN_EPI) { if (wr == 1) PG8_BAR; }
    }
    PG8_WAIT_V(0);
    if constexpr (!ALIGN_EPI) { if (wr == 0) PG8_BAR; }
    PG8_BAR;
#undef PG8_SA
#undef PG8_SB
#undef PG8_STAGE
#undef PG8_LDA
#undef PG8_LDB
#undef PG8_MMA
#undef PG8_WAIT_V
#undef PG8_WAIT_L
#undef PG8_BAR
#undef PG8_SCHED
}

#define EPI_ROW(ai, m) (u.pm * BM + (ai) * HALF + wr * 64 + (m) * 16 + fr)
__device__ __forceinline__ u32x4 pack8(const f32x4 a, const f32x4 b) { u32x4 w; w.x = cvt_pk_bf16(a[0], a[1]); w.y = cvt_pk_bf16(a[2], a[3]); w.z = cvt_pk_bf16(b[0], b[1]); w.w = cvt_pk_bf16(b[2], b[3]); return w; }

struct EpiUp {
    static constexpr bool PERM = true;
    bf16_t* H; const float* ss;
    __device__ __forceinline__ bool operator()(f32x4 (&acc)[2][2][4][2], const Unit& u, int wr, int wc, int fr, int fq) const {
        asm volatile("" : "+v"(fr), "+v"(fq));
#pragma unroll
        for (int ai = 0; ai < 2; ++ai)
#pragma unroll
            for (int m = 0; m < 4; ++m) {
                const int row = EPI_ROW(ai, m);
                const float rs = rsqrtf(sum_slots16(ss + (size_t)row * 16) * (1.0f / DM) + EPS);
                f32x4 o[2];
#pragma unroll
                for (int n = 0; n < 2; ++n)
#pragma unroll
                    for (int i = 0; i < 4; ++i) { const float gv = acc[ai][0][m][n][i] * rs, uv = acc[ai][1][m][n][i] * rs; o[n][i] = gv * fast_sigmoid(gv) * uv; }
                *(u32x4*)(H + (size_t)row * FF + u.pn * 128 + wc * 32 + fq * 8) = pack8(o[0], o[1]);
            }
        return true;
    }
};

struct EpiUpTail {
    static constexpr bool PERM = true;
    bf16_t* H; const float* ss; float* P; unsigned* flg;
    __device__ __forceinline__ bool operator()(f32x4 (&acc)[2][2][4][2], const Unit& u, int wr, int wc, int fr, int fq) const {
        asm volatile("" : "+v"(fr), "+v"(fq));
        const int tid = threadIdx.x;
        float* pp = P + (size_t)u.slot * (32 * 2048) + tid * 4;
        if (u.split == 2) {
#pragma unroll
            for (int ai = 0; ai < 2; ++ai)
#pragma unroll
                for (int bj = 0; bj < 2; ++bj)
#pragma unroll
                    for (int m = 0; m < 4; ++m)
#pragma unroll
                        for (int n = 0; n < 2; ++n) *(f32x4*)(pp + (((ai * 2 + bj) * 4 + m) * 2 + n) * 2048) = acc[ai][bj][m][n];
            __threadfence();
            __syncthreads();
            if (tid == 0) __hip_atomic_store(flg + u.slot, 1u, __ATOMIC_RELEASE, __HIP_MEMORY_SCOPE_AGENT);
            return true;
        }
        if (tid == 0) { unsigned sp = 0; while (__hip_atomic_load(flg + u.slot, __ATOMIC_RELAXED, __HIP_MEMORY_SCOPE_AGENT) == 0u) { __builtin_amdgcn_s_sleep(2); if (++sp > (1u << 22)) break; } }
        __syncthreads();
        __builtin_amdgcn_fence(__ATOMIC_ACQUIRE, "agent");
#pragma unroll
        for (int ai = 0; ai < 2; ++ai)
#pragma unroll
            for (int m = 0; m < 4; ++m) {
                const int row = EPI_ROW(ai, m);
                const float rs = rsqrtf(sum_slots16(ss + (size_t)row * 16) * (1.0f / DM) + EPS);
                f32x4 o[2], ga[2], ua[2];
#pragma unroll
                for (int n = 0; n < 2; ++n) { ga[n] = acc[ai][0][m][n] + *(const f32x4*)(pp + (((ai * 2 + 0) * 4 + m) * 2 + n) * 2048); ua[n] = acc[ai][1][m][n] + *(const f32x4*)(pp + (((ai * 2 + 1) * 4 + m) * 2 + n) * 2048); }
#pragma unroll
                for (int n = 0; n < 2; ++n)
#pragma unroll
                    for (int i = 0; i < 4; ++i) { const float gv = ga[n][i] * rs, uv = ua[n][i] * rs; o[n][i] = gv * fast_sigmoid(gv) * uv; }
                *(u32x4*)(H + (size_t)row * FF + u.pn * 128 + wc * 32 + fq * 8) = pack8(o[0], o[1]);
                asm volatile("" ::: "memory");
            }
        return true;
    }
};

struct EpiRes {
    static constexpr bool PERM = true;
    bf16_t* XB; float alpha; float* ssn; float* outf;
    __device__ __forceinline__ bool operator()(f32x4 (&acc)[2][2][4][2], const Unit& u, int wr, int wc, int fr, int fq) const {
        asm volatile("" : "+v"(fr), "+v"(fq));
#pragma unroll
        for (int ai = 0; ai < 2; ++ai)
#pragma unroll
            for (int m = 0; m < 4; ++m) {
                const int row = EPI_ROW(ai, m);
                float sq = 0.f;
#pragma unroll
                for (int bj = 0; bj < 2; ++bj) {
                    const size_t off = (size_t)row * DM + u.pn * BM + bj * HALF + wc * 32 + fq * 8;
                    const u32x4 old = *(const u32x4*)(XB + off);
                    f32x4 a, b;
                    a[0] = bflo(old.x) + alpha * acc[ai][bj][m][0][0]; a[1] = bfhi(old.x) + alpha * acc[ai][bj][m][0][1];
                    a[2] = bflo(old.y) + alpha * acc[ai][bj][m][0][2]; a[3] = bfhi(old.y) + alpha * acc[ai][bj][m][0][3];
                    b[0] = bflo(old.z) + alpha * acc[ai][bj][m][1][0]; b[1] = bfhi(old.z) + alpha * acc[ai][bj][m][1][1];
                    b[2] = bflo(old.w) + alpha * acc[ai][bj][m][1][2]; b[3] = bfhi(old.w) + alpha * acc[ai][bj][m][1][3];
                    sq += (a[0] * a[0] + a[1] * a[1]) + (a[2] * a[2] + a[3] * a[3]) + (b[0] * b[0] + b[1] * b[1]) + (b[2] * b[2] + b[3] * b[3]);
                    *(u32x4*)(XB + off) = pack8(a, b);
                    if (outf) { *(f32x4*)(outf + off) = a; *(f32x4*)(outf + off + 4) = b; }
                }
                sq += __shfl_xor(sq, 16); sq += __shfl_xor(sq, 32);
                if (fq == 0) ssn[(size_t)row * 16 + u.pn * 4 + wc] = sq;
            }
        return true;
    }
};

struct EpiWin {
    static constexpr bool PERM = true;
    const float* ss; const float* biasP;
    bf16_t *XPRE, *GG, *CQ, *CKV, *KPE, *PC, *G; float *ssq, *sskv;
    __device__ __forceinline__ bool operator()(f32x4 (&acc)[2][2][4][2], const Unit& u, int wr, int wc, int fr, int fq) const {
        asm volatile("" : "+v"(fr), "+v"(fq));
        const int pn = u.pn;
        const int cl = wc * 32 + fq * 8;
        f32x4 bv[2][2];
#pragma unroll
        for (int bj = 0; bj < 2; ++bj)
#pragma unroll
            for (int n = 0; n < 2; ++n) bv[bj][n] = *(const f32x4*)(biasP + pn * BM + bj * HALF + cl + 4 * n);
#pragma unroll
        for (int ai = 0; ai < 2; ++ai)
#pragma unroll
            for (int m = 0; m < 4; ++m) {
                const int row = EPI_ROW(ai, m);
                const float rs = rsqrtf(sum_slots16(ss + (size_t)row * 16) * (1.0f / DM) + EPS);
                f32x4 v[2][2];
#pragma unroll
                for (int bj = 0; bj < 2; ++bj)
#pragma unroll
                    for (int n = 0; n < 2; ++n) v[bj][n] = acc[ai][bj][m][n] * rs + bv[bj][n];
                if (pn < 2) {
#pragma unroll
                    for (int bj = 0; bj < 2; ++bj) *(u32x4*)(XPRE + (size_t)row * 512 + pn * BM + bj * HALF + cl) = pack8(v[bj][0], v[bj][1]);
                } else if (pn < 4) {
#pragma unroll
                    for (int bj = 0; bj < 2; ++bj) {
#pragma unroll
                        for (int n = 0; n < 2; ++n)
#pragma unroll
                            for (int i = 0; i < 4; ++i) { const float x = v[bj][n][i]; const float z = 1.5957691216057308f * (x + 0.044715f * x * x * x); v[bj][n][i] = x * fast_sigmoid(z); }
                        *(u32x4*)(GG + (size_t)row * 512 + (pn - 2) * BM + bj * HALF + cl) = pack8(v[bj][0], v[bj][1]);
                    }
                } else if (pn < 7) {
#pragma unroll
                    for (int bj = 0; bj < 2; ++bj) {
                        const int seg = (pn - 4) * 2 + bj;
                        float sq = 0.f;
#pragma unroll
                        for (int n = 0; n < 2; ++n)
#pragma unroll
                            for (int i = 0; i < 4; ++i) sq += v[bj][n][i] * v[bj][n][i];
                        sq += __shfl_xor(sq, 16); sq += __shfl_xor(sq, 32);
                        const u32x4 w = pack8(v[bj][0], v[bj][1]);
                        if (seg < 3) { *(u32x4*)(CQ + (size_t)row * 384 + seg * 128 + cl) = w; if (fq == 0) ssq[(size_t)row * 16 + seg * 4 + wc] = sq; }
                        else if (seg < 5) { *(u32x4*)(CKV + (size_t)row * 256 + (seg - 3) * 128 + cl) = w; if (fq == 0) sskv[(size_t)row * 8 + (seg - 3) * 4 + wc] = sq; }
                        else if (wc == 0) { *(u32x4*)(KPE + (size_t)row * 32 + fq * 8) = w; }
                    }
                } else if (pn < 11) {
                    f32x4 o[2];
#pragma unroll
                    for (int n = 0; n < 2; ++n)
#pragma unroll
                        for (int i = 0; i < 4; ++i) o[n][i] = v[0][n][i] * fast_sigmoid(v[1][n][i]);
                    *(u32x4*)(PC + (size_t)row * 512 + (pn - 7) * 128 + cl) = pack8(o[0], o[1]);
                } else {
#pragma unroll
                    for (int bj = 0; bj < 2; ++bj) {
#pragma unroll
                        for (int n = 0; n < 2; ++n)
#pragma unroll
                            for (int i = 0; i < 4; ++i) v[bj][n][i] = fmaxf(fast_sigmoid(v[bj][n][i]), 1e-30f);
                        *(u32x4*)(G + (size_t)row * 3072 + (pn - 11) * BM + bj * HALF + cl) = pack8(v[bj][0], v[bj][1]);
                    }
                }
            }
        return true;
    }
};

struct EpiQ {
    static constexpr bool PERM = false;
    bf16_t* Q; const float* ssq; const float* CS;
    __device__ __forceinline__ bool operator()(f32x4 (&acc)[2][2][4][2], const Unit& u, int wr, int wc, int fr, int fq) const {
        asm volatile("" : "+v"(fr), "+v"(fq));
        float rsv[2][4];
#pragma unroll
        for (int ai = 0; ai < 2; ++ai) {
#pragma unroll
            for (int m = 0; m < 4; ++m) rsv[ai][m] = sum_slots12(ssq + (size_t)EPI_ROW(ai, m) * 16);
            asm volatile("" ::: "memory"); }
#pragma unroll
        for (int ai = 0; ai < 2; ++ai)
#pragma unroll
            for (int m = 0; m < 4; ++m) {
                const int row = EPI_ROW(ai, m);
                const float rs = rsqrtf(rsv[ai][m] * (1.0f / 384.0f) + EPS) * QSCALE;
                const f32x4 cs = *(const f32x4*)(CS + (size_t)row * 32 + 4 * fq), sn = *(const f32x4*)(CS + (size_t)row * 32 + 16 + 4 * fq);
#pragma unroll
                for (int bj = 0; bj < 2; ++bj) {
                    const int c0 = u.pn * BM + bj * HALF + wc * 32;
                    f32x4 x1 = acc[ai][bj][m][0] * rs, x2 = acc[ai][bj][m][1] * rs;
                    if ((c0 % 96) == 64) { const f32x4 y1 = x1 * cs - x2 * sn, y2 = x2 * cs + x1 * sn; x1 = y1; x2 = y2; }
                    u32x2 w1, w2; w1.x = cvt_pk_bf16(x1[0], x1[1]); w1.y = cvt_pk_bf16(x1[2], x1[3]); w2.x = cvt_pk_bf16(x2[0], x2[1]); w2.y = cvt_pk_bf16(x2[2], x2[3]);
                    *(u32x2*)(Q + (size_t)row * 768 + c0 + 4 * fq) = w1; *(u32x2*)(Q + (size_t)row * 768 + c0 + 16 + 4 * fq) = w2;
                }
            }
        return true;
    }
};

struct EpiKV {
    static constexpr bool PERM = true;
    bf16_t *KN, *V; const float* sskv;
    __device__ __forceinline__ bool operator()(f32x4 (&acc)[2][2][4][2], const Unit& u, int wr, int wc, int fr, int fq) const {
        asm volatile("" : "+v"(fr), "+v"(fq));
        float rsv[2][4];
#pragma unroll
        for (int ai = 0; ai < 2; ++ai)
#pragma unroll
            for (int m = 0; m < 4; ++m) rsv[ai][m] = sum_slots8(sskv + (size_t)EPI_ROW(ai, m) * 8);
#pragma unroll
        for (int ai = 0; ai < 2; ++ai)
#pragma unroll
            for (int m = 0; m < 4; ++m) {
                const int row = EPI_ROW(ai, m);
                const float rs = rsqrtf(rsv[ai][m] * (1.0f / 256.0f) + EPS);
#pragma unroll
                for (int bj = 0; bj < 2; ++bj) {
                    const int head = u.pn * 2 + bj; const int j = wc * 32 + fq * 8;
                    const u32x4 w = pack8(acc[ai][bj][m][0] * rs, acc[ai][bj][m][1] * rs);
                    if (wc < 2) *(u32x4*)(KN + (size_t)row * 512 + head * 64 + j) = w;
                    else        *(u32x4*)(V + (size_t)row * 512 + head * 64 + (j - 64)) = w;
                }
            }
        return true;
    }
};

struct EpiMerge {
    static constexpr bool PERM = true;
    const bf16_t* G; const float* bc; bf16_t* OUT;
    __device__ __forceinline__ bool operator()(f32x4 (&acc)[2][2][4][2], const Unit& u, int wr, int wc, int fr, int fq) const {
        asm volatile("" : "+v"(fr), "+v"(fq));
        const int seg = u.seg;
        const int colb = u.pn * BM + wc * 32 + fq * 8;
#pragma unroll
        for (int ai = 0; ai < 2; ++ai)
#pragma unroll
        for (int mh = 0; mh < 2; ++mh) {
            u32x4 ga[2][2], gb[2][2];
#pragma unroll
            for (int mm = 0; mm < 2; ++mm)
#pragma unroll
                for (int bj = 0; bj < 2; ++bj) {
                    const bf16_t* gp = G + (size_t)EPI_ROW(ai, 2 * mh + mm) * 3072 + seg * 1024 + colb + bj * HALF;
                    ga[mm][bj] = *(const u32x4*)gp;
                    gb[mm][bj] = (seg < 2) ? *(const u32x4*)(gp + 1024) : ga[mm][bj];
                }
            if (seg < 2) {
#pragma unroll
                for (int mm = 0; mm < 2; ++mm)
#pragma unroll
                    for (int bj = 0; bj < 2; ++bj) {
                        const int m = 2 * mh + mm; const u32x4 a = ga[mm][bj], b = gb[mm][bj];
                        const f32x4 r0 = {bflo(a.x) * __builtin_amdgcn_rcpf(bflo(b.x)), bfhi(a.x) * __builtin_amdgcn_rcpf(bfhi(b.x)), bflo(a.y) * __builtin_amdgcn_rcpf(bflo(b.y)), bfhi(a.y) * __builtin_amdgcn_rcpf(bfhi(b.y))};
                        const f32x4 r1 = {bflo(a.z) * __builtin_amdgcn_rcpf(bflo(b.z)), bfhi(a.z) * __builtin_amdgcn_rcpf(bfhi(b.z)), bflo(a.w) * __builtin_amdgcn_rcpf(bflo(b.w)), bfhi(a.w) * __builtin_amdgcn_rcpf(bfhi(b.w))};
                        acc[ai][bj][m][0] *= r0; acc[ai][bj][m][1] *= r1;
                    }
            } else {
#pragma unroll
                for (int bj = 0; bj < 2; ++bj) {
                    const f32x4 c0 = *(const f32x4*)(bc + colb + bj * HALF), c1 = *(const f32x4*)(bc + colb + bj * HALF + 4);
#pragma unroll
                    for (int mm = 0; mm < 2; ++mm) {
                        const int m = 2 * mh + mm; const u32x4 a = ga[mm][bj];
                        const f32x4 a0 = {bflo(a.x), bfhi(a.x), bflo(a.y), bfhi(a.y)}, a1 = {bflo(a.z), bfhi(a.z), bflo(a.w), bfhi(a.w)};
                        *(u32x4*)(OUT + (size_t)EPI_ROW(ai, m) * DM + colb + bj * HALF) = pack8((acc[ai][bj][m][0] + c0) * a0, (acc[ai][bj][m][1] + c1) * a1);
                    }
                }
            }
            asm volatile("" ::: "memory");
        }
        return seg == 2;
    }
};
}

namespace att {
__device__ __forceinline__ int crow(int r, int hi) { return (r & 3) + 8 * (r >> 2) + 4 * hi; }
constexpr int KSLOT = 12288, VSLOT = 8192;
constexpr int L_K = 0, L_V = 2 * KSLOT, L_WS = L_V + 2 * VSLOT, L_OST = L_WS + 2048, L_END = L_OST + 8 * 4096;

__device__ __forceinline__ float hmax(float m) { auto rr = __builtin_amdgcn_permlane32_swap(__float_as_uint(m), __float_as_uint(m), false, false); return fmaxf(__uint_as_float(rr[0]), __uint_as_float(rr[1])); }
__device__ __forceinline__ float hsum(float m) { auto rr = __builtin_amdgcn_permlane32_swap(__float_as_uint(m), __float_as_uint(m), false, false); return __uint_as_float(rr[0]) + __uint_as_float(rr[1]); }

__device__ __forceinline__ void pv(f32x16* o, unsigned vb, bf16x8 pa0, bf16x8 pa1, bf16x8 pa2, bf16x8 pa3) {
#pragma unroll
    for (int d0 = 0; d0 < 2; ++d0) { s16x4 lo[4], hi[4];
#pragma unroll
        for (int ks = 0; ks < 4; ++ks) {
            asm volatile("ds_read_b64_tr_b16 %0,%1 offset:%c2" : "=&v"(lo[ks]) : "v"(vb), "i"(d0 * 4096 + ks * 1024) : "memory");
            asm volatile("ds_read_b64_tr_b16 %0,%1 offset:%c2" : "=&v"(hi[ks]) : "v"(vb), "i"(d0 * 4096 + ks * 1024 + 512) : "memory"); }
        asm volatile("s_waitcnt lgkmcnt(0)" ::: "memory"); __builtin_amdgcn_sched_barrier(0);
#define PK(k) (bf16x8){lo[k][0], lo[k][1], lo[k][2], lo[k][3], hi[k][0], hi[k][1], hi[k][2], hi[k][3]}
        o[d0] = __builtin_amdgcn_mfma_f32_32x32x16_bf16(pa0, PK(0), o[d0], 0, 0, 0);
        o[d0] = __builtin_amdgcn_mfma_f32_32x32x16_bf16(pa1, PK(1), o[d0], 0, 0, 0);
        o[d0] = __builtin_amdgcn_mfma_f32_32x32x16_bf16(pa2, PK(2), o[d0], 0, 0, 0);
        o[d0] = __builtin_amdgcn_mfma_f32_32x32x16_bf16(pa3, PK(3), o[d0], 0, 0, 0);
#undef PK
    }
}

__device__ __forceinline__ void attn_block(int b, int h, int qb, const bf16_t* Q, const bf16_t* KN, const bf16_t* KR, const bf16_t* V, bf16_t* O, LAS unsigned char* lds) {
    int tid_ = threadIdx.x; asm volatile("" : "+v"(tid_));
    const int tid = tid_, lane = tid & 63, r32 = lane & 31, hi = lane >> 5;
    const int wid = __builtin_amdgcn_readfirstlane(tid >> 6);
    const size_t rowbase = (size_t)b * SEQ; const int q0 = qb * 256;
    const bf16_t* Qw = Q + (rowbase + q0 + wid * 32 + r32) * 768 + h * 96;
    bf16x8 qr[6];
#pragma unroll
    for (int d0 = 0; d0 < 6; ++d0) qr[d0] = *(const bf16x8*)(Qw + d0 * 16 + hi * 8);
    const int NT = 4 * qb + 4;
    const bf16_t* kg = KN + (rowbase + lane) * 512 + h * 64 + wid * 8;
    const bf16_t* krg = KR + (rowbase + lane) * 32 + (wid & 3) * 8;
    const bf16_t* vg = V + (rowbase + 16 * (wid & 3) + (lane >> 2)) * 512 + h * 64 + (wid >> 2) * 32 + (lane & 3) * 8;
    const int kdst = L_K + wid * 1024 + lane * 16, krdst = L_K + (8 + (wid & 3)) * 1024 + lane * 16, vdst = L_V + wid * 1024 + lane * 16;
    unsigned z0_ = 0u; asm volatile("" : "+v"(z0_)); u32x4 kreg, krreg = {z0_, z0_, z0_, z0_}, vreg;
    kreg = *(const u32x4*)kg; if (wid < 4) krreg = *(const u32x4*)krg; vreg = *(const u32x4*)vg;
    *(LAS u32x4*)(lds + kdst) = kreg; if (wid < 4) *(LAS u32x4*)(lds + krdst) = krreg; *(LAS u32x4*)(lds + vdst) = vreg;
    __syncthreads();
    float mrun = -INFINITY, lrun = 0.f; f32x16 o[2];
#pragma unroll
    for (int r = 0; r < 16; ++r) { o[0][r] = 0.f; o[1][r] = 0.f; }
    LAS float* wsf = (LAS float*)(lds + L_WS) + wid * 64;
    const int qabs = q0 + wid * 32 + r32;
    const unsigned vbl = (unsigned)(uintptr_t)(lds + L_V) + ((lane >> 4) & 1) * 32 + (lane & 3) * 8 + (4 * hi + ((lane & 15) >> 2)) * 64;
    for (int t = 0; t < NT; ++t) {
        const int cur = t & 1;
        if (t + 1 < NT) { const size_t adv = (size_t)(t + 1) * 64; kreg = *(const u32x4*)(kg + adv * 512); if (wid < 4) krreg = *(const u32x4*)(krg + adv * 32); vreg = *(const u32x4*)(vg + adv * 512); }
        const int jb = t - 4 * qb;
        if (jb <= (wid >> 1)) {
            f32x16 p0, p1;
#pragma unroll
            for (int r = 0; r < 16; ++r) { p0[r] = 0.f; p1[r] = 0.f; }
            const LAS unsigned char* kb = lds + L_K + cur * KSLOT + hi * 1024 + r32 * 16;
#pragma unroll
            for (int d0 = 0; d0 < 6; ++d0) {
                const bf16x8 b0 = *(const LAS bf16x8*)(kb + d0 * 2048), b1 = *(const LAS bf16x8*)(kb + d0 * 2048 + 512);
                p0 = __builtin_amdgcn_mfma_f32_32x32x16_bf16(b0, qr[d0], p0, 0, 0, 0);
                p1 = __builtin_amdgcn_mfma_f32_32x32x16_bf16(b1, qr[d0], p1, 0, 0, 0);
            }
            if (jb == (wid >> 1)) {
                const int kbase = 64 * t + 4 * hi;
#pragma unroll
                for (int r = 0; r < 16; ++r) { const int kv = kbase + (r & 3) + 8 * (r >> 2); if (kv > qabs) p0[r] = -INFINITY; if (kv + 32 > qabs) p1[r] = -INFINITY; }
            }
            float rm = fmaxf(p0[0], p1[0]);
#pragma unroll
            for (int r = 1; r < 16; ++r) rm = fmaxf(rm, fmaxf(p0[r], p1[r]));
            rm = hmax(rm);
            if (__any(rm > mrun + 8.0f)) {
                const float mn = fmaxf(mrun, rm);
                const float alpha = __builtin_amdgcn_exp2f(mrun - mn);
                mrun = mn; lrun *= alpha;
                if (hi == 0) wsf[r32] = alpha;
                asm volatile("s_waitcnt lgkmcnt(0)" ::: "memory");
#pragma unroll
                for (int r = 0; r < 16; ++r) { const float a = wsf[crow(r, hi)]; o[0][r] *= a; o[1][r] *= a; }
            }
            float sum = 0.f;
#pragma unroll
            for (int r = 0; r < 16; ++r) { p0[r] = __builtin_amdgcn_exp2f(p0[r] - mrun); p1[r] = __builtin_amdgcn_exp2f(p1[r] - mrun); sum += p0[r] + p1[r]; }
            lrun += sum;
            u32x4 pw0, pw1, pw2, pw3;
            pw0 = (u32x4){cvt_pk_bf16(p0[0], p0[1]), cvt_pk_bf16(p0[2], p0[3]), cvt_pk_bf16(p0[4], p0[5]), cvt_pk_bf16(p0[6], p0[7])};
            pw1 = (u32x4){cvt_pk_bf16(p0[8], p0[9]), cvt_pk_bf16(p0[10], p0[11]), cvt_pk_bf16(p0[12], p0[13]), cvt_pk_bf16(p0[14], p0[15])};
            pw2 = (u32x4){cvt_pk_bf16(p1[0], p1[1]), cvt_pk_bf16(p1[2], p1[3]), cvt_pk_bf16(p1[4], p1[5]), cvt_pk_bf16(p1[6], p1[7])};
            pw3 = (u32x4){cvt_pk_bf16(p1[8], p1[9]), cvt_pk_bf16(p1[10], p1[11]), cvt_pk_bf16(p1[12], p1[13]), cvt_pk_bf16(p1[14], p1[15])};
            pv(o, vbl + cur * VSLOT, __builtin_bit_cast(bf16x8, pw0), __builtin_bit_cast(bf16x8, pw1), __builtin_bit_cast(bf16x8, pw2), __builtin_bit_cast(bf16x8, pw3));
        }
        if (t + 1 < NT) { const int nb = (cur ^ 1); *(LAS u32x4*)(lds + kdst + nb * KSLOT) = kreg; if (wid < 4) *(LAS u32x4*)(lds + krdst + nb * KSLOT) = krreg; *(LAS u32x4*)(lds + vdst + nb * VSLOT) = vreg; }
        __syncthreads();
    }
    lrun = hsum(lrun);
    if (hi == 0) wsf[32 + r32] = lrun;
    asm volatile("s_waitcnt lgkmcnt(0)" ::: "memory");
    float rli[16];
#pragma unroll
    for (int r = 0; r < 16; ++r) rli[r] = __builtin_amdgcn_rcpf(wsf[32 + crow(r, hi)]);
    bf16_t* Ow = O + (rowbase + q0 + wid * 32) * 512 + h * 64;
    LAS bf16_t* stg = (LAS bf16_t*)(lds + L_OST) + wid * 2048;
#pragma unroll
    for (int r = 0; r < 16; ++r) { const int orow = crow(r, hi);
#pragma unroll
        for (int d0 = 0; d0 < 2; ++d0) stg[orow * 64 + d0 * 32 + r32] = f2bf(o[d0][r] * rli[r]); }
    asm volatile("s_waitcnt lgkmcnt(0)" ::: "memory");
#pragma unroll
    for (int i = 0; i < 4; ++i) { const int row = i * 8 + (lane >> 3), ch = lane & 7; const u32x4 v = *(const LAS u32x4*)(stg + row * 64 + ch * 8); *(u32x4*)(Ow + (size_t)row * 512 + ch * 8) = v; }
    __syncthreads();
}
}

namespace lru {
constexpr int XS_STRIDE = 144;
constexpr int L_XS = 0, L_BM = 74240, L_CW = L_BM + 24576, L_CB = L_CW + 1024, L_AGG = L_CB + 256, L_PRE = L_AGG + 4096, L_CIN = L_PRE + 4096, L_END = L_CIN + 128;
__device__ __forceinline__ void lru_unit(int u, int layer, const bf16_t* XPRE, bf16_t* GG, const float* conv_w, const float* conv_b, const float* wgate, const float* bgate, const float* lam,
                                         unsigned* flags, float* carry, LAS unsigned char* lds) {
    int tid_ = threadIdx.x; asm volatile("" : "+v"(tid_));
    const int tid = tid_, lane = tid & 63, r32 = lane & 31, hi = lane >> 5;
    const int wid = __builtin_amdgcn_readfirstlane(tid >> 6);
    const int ck = u >> 6, bh = u & 63, b = bh >> 3, h = bh & 7, s0 = ck * 512;
    LAS float* CW = (LAS float*)(lds + L_CW); LAS float* CB = (LAS float*)(lds + L_CB);
    LAS f32x2* AGG = (LAS f32x2*)(lds + L_AGG); LAS f32x2* PRE = (LAS f32x2*)(lds + L_PRE); LAS float* CIN = (LAS float*)(lds + L_CIN);
    if (tid < 256) CW[tid] = conv_w[(tid >> 6) * 512 + h * 64 + (tid & 63)];
    else if (tid < 320) CB[tid - 256] = conv_b[h * 64 + (tid - 256)];
    for (int f = tid; f < 1536; f += 512) {
        const int l = f & 63, g = f >> 6, kc = g & 3, nt = g >> 2, n = l & 31, hh = l >> 5, col = 32 * nt + n, d0 = 16 * kc + 8 * hh;
        float v[8];
#pragma unroll
        for (int i = 0; i < 8; ++i) v[i] = (nt < 4) ? wgate[(size_t)h * 8192 + (d0 + i) * 128 + col] : ((d0 + i) == (col - 128) ? 1.0f : 0.0f);
        *(LAS u32x4*)(lds + L_BM + g * 1024 + l * 16) = (u32x4){cvt_pk_bf16(v[0], v[1]), cvt_pk_bf16(v[2], v[3]), cvt_pk_bf16(v[4], v[5]), cvt_pk_bf16(v[6], v[7])};
    }
    unsigned z0_ = 0u; asm volatile("" : "+v"(z0_));
    { u32x4 st[9];
#pragma unroll
      for (int k = 0; k < 9; ++k) { const int i = (tid >> 3) + 64 * k, s = s0 - 3 + i; st[k] = (u32x4){z0_, z0_, z0_, z0_};
          if (i < 515 && s >= 0) st[k] = *(const u32x4*)(XPRE + ((size_t)b * SEQ + s) * 512 + h * 64 + (tid & 7) * 8); }
#pragma unroll
      for (int k = 0; k < 9; ++k) { const int i = (tid >> 3) + 64 * k; if (i < 515) *(LAS u32x4*)(lds + L_XS + i * XS_STRIDE + (tid & 7) * 16) = st[k]; } }
    __syncthreads();
    bf16x8 afr[2][4];
#pragma unroll
    for (int kc = 0; kc < 4; ++kc) {
        const int d0 = 16 * kc + 8 * hi;
        f32x4 w0[4], w1[4];
#pragma unroll
        for (int j = 0; j < 4; ++j) { w0[j] = *(const LAS f32x4*)(CW + j * 64 + d0); w1[j] = *(const LAS f32x4*)(CW + j * 64 + d0 + 4); }
        const f32x4 cb0 = *(const LAS f32x4*)(CB + d0), cb1 = *(const LAS f32x4*)(CB + d0 + 4);
#pragma unroll
        for (int mt = 0; mt < 2; ++mt) {
            const int sl = wid * 64 + mt * 32 + r32;
            f32x4 xa0 = cb0, xa1 = cb1;
#pragma unroll
            for (int j = 0; j < 4; ++j) {
                const u32x4 xv = *(const LAS u32x4*)(lds + L_XS + (sl + j) * XS_STRIDE + d0 * 2);
                xa0 += w0[j] * (f32x4){bflo(xv.x), bfhi(xv.x), bflo(xv.y), bfhi(xv.y)};
                xa1 += w1[j] * (f32x4){bflo(xv.z), bfhi(xv.z), bflo(xv.w), bfhi(xv.w)};
            }
            afr[mt][kc] = __builtin_bit_cast(bf16x8, (u32x4){cvt_pk_bf16(xa0[0], xa0[1]), cvt_pk_bf16(xa0[2], xa0[3]), cvt_pk_bf16(xa1[0], xa1[1]), cvt_pk_bf16(xa1[2], xa1[3])});
        }
    }
    __syncthreads();
    { u32x4 st[8];
#pragma unroll
      for (int k = 0; k < 8; ++k) st[k] = *(const u32x4*)(GG + ((size_t)b * SEQ + s0 + (tid >> 3) + 64 * k) * 512 + h * 64 + (tid & 7) * 8);
#pragma unroll
      for (int k = 0; k < 8; ++k) *(LAS u32x4*)(lds + L_XS + ((tid >> 3) + 64 * k) * XS_STRIDE + (tid & 7) * 16) = st[k]; }
    const int fbase = layer * 256;
#pragma unroll 1
    for (int ct = 0; ct < 2; ++ct) {
        const int c = 32 * ct + r32;
        const float spc = 8.0f * log1pf(expf(-lam[h * 64 + c]));
        const float br = bgate[h * 128 + c], bi = bgate[h * 128 + 64 + c];
        float hq[2][16], ac[2][16];
#pragma unroll
        for (int mt = 0; mt < 2; ++mt) {
            f32x16 R, I, X;
#pragma unroll
            for (int r = 0; r < 16; ++r) { R[r] = br; I[r] = bi; X[r] = 0.f; }
#pragma unroll
            for (int kc = 0; kc < 4; ++kc) {
                const bf16x8 b0 = *(const LAS bf16x8*)(lds + L_BM + ((ct) * 4 + kc) * 1024 + lane * 16);
                const bf16x8 b1 = *(const LAS bf16x8*)(lds + L_BM + ((2 + ct) * 4 + kc) * 1024 + lane * 16);
                const bf16x8 b2 = *(const LAS bf16x8*)(lds + L_BM + ((4 + ct) * 4 + kc) * 1024 + lane * 16);
                R = __builtin_amdgcn_mfma_f32_32x32x16_bf16(afr[mt][kc], b0, R, 0, 0, 0);
                I = __builtin_amdgcn_mfma_f32_32x32x16_bf16(afr[mt][kc], b1, I, 0, 0, 0);
                X = __builtin_amdgcn_mfma_f32_32x32x16_bf16(afr[mt][kc], b2, X, 0, 0, 0);
            }
            float Ar[4], Hr[4];
#pragma unroll
            for (int q = 0; q < 4; ++q) { float A = 1.f, H = 0.f;
#pragma unroll
                for (int k = 0; k < 4; ++k) { const int r = 4 * q + k;
                    const float rg = fast_sigmoid(R[r]), ig = fast_sigmoid(I[r]);
                    const float la = -rg * spc;
                    const float a = __builtin_amdgcn_exp2f(la * 1.4426950408889634f);
                    const float x2 = 2.0f * la;
                    float om = -x2 * (1.0f + x2 * (0.5f + x2 * (0.16666667f + x2 * (0.041666668f + x2 * (0.0083333338f + x2 * 0.0013888889f)))));
                    if (__builtin_expect(__any(x2 <= -0.25f), 0)) om = (x2 > -0.25f) ? om : (1.0f - a * a);
                    const float uu = __builtin_amdgcn_sqrtf(fmaxf(om, 0.f)) * (ig * X[r]);
                    H = a * H + uu; A *= a; ac[mt][r] = A; hq[mt][r] = H; }
                Ar[q] = A; Hr[q] = H; }
            float pA[4], pH[4];
#pragma unroll
            for (int q = 0; q < 4; ++q) { pA[q] = __shfl_xor(Ar[q], 32); pH[q] = __shfl_xor(Hr[q], 32); }
            float A = 1.f, H = 0.f;
#pragma unroll
            for (int q = 0; q < 4; ++q) {
                const float A0 = hi ? pA[q] : Ar[q], H0 = hi ? pH[q] : Hr[q], A1 = hi ? Ar[q] : pA[q], H1 = hi ? Hr[q] : pH[q];
                const float Hm = A0 * H + H0, Am = A * A0;
                const float cA = hi ? Am : A, cH = hi ? Hm : H;
#pragma unroll
                for (int k = 0; k < 4; ++k) { const int r = 4 * q + k; hq[mt][r] += ac[mt][r] * cH; ac[mt][r] *= cA; }
                H = A1 * Hm + H1; A = Am * A1;
            }
            if (hi == 0) AGG[(2 * wid + mt) * 32 + r32] = (f32x2){A, H};
            __builtin_amdgcn_sched_barrier(0);
        }
        __syncthreads();
        if (wid == 0 && lane < 32) {
            float A = 1.f, H = 0.f;
#pragma unroll
            for (int t = 0; t < 16; ++t) { PRE[t * 32 + lane] = (f32x2){A, H}; const f32x2 g = AGG[t * 32 + lane]; H = g.x * H + g.y; A *= g.x; }
            if (ck < 3) {
                __hip_atomic_store(carry + ((size_t)u * 64 + c) * 2, A, __ATOMIC_RELAXED, __HIP_MEMORY_SCOPE_AGENT);
                __hip_atomic_store(carry + ((size_t)u * 64 + c) * 2 + 1, H, __ATOMIC_RELAXED, __HIP_MEMORY_SCOPE_AGENT);
                asm volatile("s_waitcnt vmcnt(0)" ::: "memory");
                if (lane == 0) __hip_atomic_store(flags + (size_t)(fbase + u) * 2 + ct, 1u, __ATOMIC_RELEASE, __HIP_MEMORY_SCOPE_AGENT);
            }
            float cin = 0.f;
            for (int j = 0; j < ck; ++j) {
                const int uj = j * 64 + bh;
                unsigned* fp = flags + (size_t)(fbase + uj) * 2 + ct; unsigned sp = 0;
                while (__hip_atomic_load(fp, __ATOMIC_RELAXED, __HIP_MEMORY_SCOPE_AGENT) == 0u) { __builtin_amdgcn_s_sleep(2); if (++sp > (1u << 22)) break; }
                __builtin_amdgcn_fence(__ATOMIC_ACQUIRE, "agent");
                const float Aj = __hip_atomic_load(carry + ((size_t)uj * 64 + c) * 2, __ATOMIC_RELAXED, __HIP_MEMORY_SCOPE_AGENT);
                const float Hj = __hip_atomic_load(carry + ((size_t)uj * 64 + c) * 2 + 1, __ATOMIC_RELAXED, __HIP_MEMORY_SCOPE_AGENT);
                cin = Aj * cin + Hj;
            }
            CIN[lane] = cin;
        }
        __syncthreads();
        {
            const float cinc = CIN[r32];
#pragma unroll
            for (int mt = 0; mt < 2; ++mt) {
                const f32x2 p = PRE[(2 * wid + mt) * 32 + r32];
                const float cint = p.y + p.x * cinc;
                LAS bf16_t* gp = (LAS bf16_t*)(lds + L_XS + (wid * 64 + mt * 32) * XS_STRIDE) + c;
#pragma unroll
                for (int r = 0; r < 16; ++r) { LAS bf16_t* q = gp + att::crow(r, hi) * (XS_STRIDE / 2); const float hv = hq[mt][r] + ac[mt][r] * cint; *q = f2bf(hv * bf2f(*q)); }
            }
        }
    }
    __syncthreads();
    for (int i = tid >> 3; i < 512; i += 64)
        *(u32x4*)(GG + ((size_t)b * SEQ + s0 + i) * 512 + h * 64 + (tid & 7) * 8) = *(const LAS u32x4*)(lds + L_XS + i * XS_STRIDE + (tid & 7) * 16);
    __syncthreads();
}
}

namespace cv {
constexpr int L_XS = 0, L_YB = 63488, YB_STRIDE = 516, L_END = L_YB + 32 * YB_STRIDE * 4;
__device__ __forceinline__ void conv_unit(int u, const bf16_t* PC, bf16_t* AC, const float* dw_w, const float* dw_b, const float* ln_g, const float* ln_b,
                                          const bf16_t* KPE, bf16_t* KR, const float* CS, LAS unsigned char* lds) {
    int tid_ = threadIdx.x; asm volatile("" : "+v"(tid_));
    const int tid = tid_, lane = tid & 63;
    const int wid = __builtin_amdgcn_readfirstlane(tid >> 6);
    const int m0 = u * 32, b = m0 >> 11, s0 = m0 & 2047;
    unsigned z0_ = 0u; asm volatile("" : "+v"(z0_));
    { u32x4 st[8];
#pragma unroll
      for (int k = 0; k < 8; ++k) { const int i = (tid >> 6) + 8 * k, s = s0 - 30 + i; st[k] = (u32x4){z0_, z0_, z0_, z0_};
          if (i < 62 && s >= 0) st[k] = *(const u32x4*)(PC + ((size_t)b * SEQ + s) * 512 + (tid & 63) * 8); }
#pragma unroll
      for (int k = 0; k < 8; ++k) { const int i = (tid >> 6) + 8 * k; if (i < 62) *(LAS u32x4*)(lds + L_XS + i * 1024 + (tid & 63) * 16) = st[k]; } }
    { const int tok = tid >> 4, j = tid & 15; const size_t m = (size_t)m0 + tok;
      const float x1 = bf2f(KPE[m * 32 + j]), x2 = bf2f(KPE[m * 32 + 16 + j]); const float cs = CS[m * 32 + j], sn = CS[m * 32 + 16 + j];
      KR[m * 32 + j] = f2bf(x1 * cs - x2 * sn); KR[m * 32 + 16 + j] = f2bf(x2 * cs + x1 * sn); }
    __syncthreads();
    {
        const int ch = tid;
        float w[31];
#pragma unroll
        for (int j = 0; j < 31; ++j) w[j] = dw_w[j * 512 + ch];
        const float bias = dw_b[ch];
        const LAS bf16_t* xs = (const LAS bf16_t*)(lds + L_XS) + ch;
        LAS float* YB = (LAS float*)(lds + L_YB);
#pragma unroll 1
        for (int g = 0; g < 4; ++g) {
            float x[38];
#pragma unroll
            for (int k = 0; k < 38; ++k) x[k] = bf2f(xs[(8 * g + k) * 512]);
#pragma unroll
            for (int o = 0; o < 8; ++o) { float y = bias;
#pragma unroll
                for (int j = 0; j < 31; ++j) y += w[j] * x[o + j];
                YB[(8 * g + o) * YB_STRIDE + ch] = y; }
        }
    }
    __syncthreads();
    {
        const LAS float* YB = (const LAS float*)(lds + L_YB);
        const f32x4 g0 = *(const f32x4*)(ln_g + lane * 8), g1 = *(const f32x4*)(ln_g + lane * 8 + 4), b0 = *(const f32x4*)(ln_b + lane * 8), b1 = *(const f32x4*)(ln_b + lane * 8 + 4);
#pragma unroll
        for (int k = 0; k < 4; ++k) {
            const int tok = wid * 4 + k;
            f32x4 a = *(const LAS f32x4*)(YB + tok * YB_STRIDE + lane * 8), c = *(const LAS f32x4*)(YB + tok * YB_STRIDE + lane * 8 + 4);
            const float mean = wave_sum((a[0] + a[1]) + (a[2] + a[3]) + (c[0] + c[1]) + (c[2] + c[3])) * (1.0f / 512.0f);
            a = a - mean; c = c - mean;
            const float var = wave_sum((a[0] * a[0] + a[1] * a[1]) + (a[2] * a[2] + a[3] * a[3]) + (c[0] * c[0] + c[1] * c[1]) + (c[2] * c[2] + c[3] * c[3])) * (1.0f / 512.0f);
            const float rstd = rsqrtf(var + EPS);
            a = a * rstd * g0 + b0; c = c * rstd * g1 + b1;
#pragma unroll
            for (int i = 0; i < 4; ++i) { a[i] = a[i] * fast_sigmoid(a[i]); c[i] = c[i] * fast_sigmoid(c[i]); }
            *(u32x4*)(AC + ((size_t)m0 + tok) * 512 + lane * 8) = pg8::pack8(a, c);
        }
    }
    __syncthreads();
}
}

#define XB_TMO      128
#define XB_XCNT(j)  (256  + 64 * (j))
#define XB_XSUB(j)  (1280 + 64 * (j))
#define XB_XGEN(j)  (2304 + 64 * (j))
#define XB_TOP      3328
#define XB_TOPGEN   3392
#define XCD_BAR_WORDS 3456
#define XB_SPIN_CAP (1u << 18)
__device__ __forceinline__ unsigned xb_ld(unsigned* p)              { return __hip_atomic_load(p, __ATOMIC_RELAXED, __HIP_MEMORY_SCOPE_AGENT); }
__device__ __forceinline__ unsigned xb_add(unsigned* p, unsigned v) { return __hip_atomic_fetch_add(p, v, __ATOMIC_RELAXED, __HIP_MEMORY_SCOPE_AGENT); }
__device__ __forceinline__ unsigned xb_xcc_id() { return (unsigned)__builtin_amdgcn_s_getreg((3 << 11) | 20) & 0xFu; }
#define XB_SPIN(cond, bar) do { unsigned _sp = 0; while (cond) { __builtin_amdgcn_s_sleep(1); \
    if ((++_sp & 255u) == 0u) { if (xb_ld(&(bar)[XB_TMO])) break; if (_sp > XB_SPIN_CAP) { atomicAdd(&(bar)[XB_TMO], 1u); break; } } } } while (0)
struct XcdBarrier { unsigned* bar; unsigned x; volatile LAS unsigned* st; };
__device__ __forceinline__ XcdBarrier xcd_barrier_post(unsigned* bar, volatile LAS unsigned* st) {
    XcdBarrier b; b.bar = bar; b.x = xb_xcc_id(); b.st = st;
    if (threadIdx.x == 0) (void)xb_add(&bar[XB_XCNT(b.x)], 1u);
    return b;
}
__device__ __forceinline__ void xcd_barrier_complete(unsigned* bar, unsigned x, unsigned& nloc, unsigned& nx) {
    const unsigned G = gridDim.x * gridDim.y * gridDim.z;
    unsigned sum, cnt, mine, sp = 0u;
    for (;;) {
        sum = 0u; cnt = 0u; mine = 0u;
#pragma unroll 1
        for (unsigned j = 0; j < 16; ++j) { const unsigned c = xb_ld(&bar[XB_XCNT(j)]); sum += c; cnt += (c > 0u) ? 1u : 0u; mine = (j == x) ? c : mine; }
        if (sum == G) break;
        __builtin_amdgcn_s_sleep(1);
        if ((++sp & 255u) == 0u) { if (xb_ld(&bar[XB_TMO])) break; if (sp > XB_SPIN_CAP) { atomicAdd(&bar[XB_TMO], 1u); break; } }
    }
    nloc = mine > 0u ? mine : 1u; nx = cnt > 0u ? cnt : 1u;
}
__device__ __forceinline__ void xcd_barrier(const XcdBarrier& b) {
    asm volatile("s_waitcnt vmcnt(0)" ::: "memory");
    __syncthreads();
    if (threadIdx.x == 0) {
        unsigned* bar = b.bar; asm volatile("" : "+s"(bar));
        __builtin_amdgcn_s_waitcnt(0);
        unsigned nloc = b.st[0], nx = b.st[1];
        if (nloc == 0u) { xcd_barrier_complete(bar, b.x, nloc, nx); b.st[0] = nloc; b.st[1] = nx; }
        const unsigned old = xb_add(&bar[XB_XSUB(b.x)], 1u);
        const unsigned gen = old / nloc;
        if (old + 1u == (gen + 1u) * nloc) {
            __builtin_amdgcn_fence(__ATOMIC_RELEASE, "agent");
            asm volatile("s_waitcnt vmcnt(0)" ::: "memory");
            const unsigned og = xb_add(&bar[XB_TOP], 1u);
            const unsigned tg = og / nx;
            if (og + 1u == (tg + 1u) * nx) xb_add(&bar[XB_TOPGEN], 1u);
            else XB_SPIN(xb_ld(&bar[XB_TOPGEN]) == tg, bar);
            __builtin_amdgcn_fence(__ATOMIC_ACQUIRE, "agent");
            xb_add(&bar[XB_XGEN(b.x)], 1u);
            asm volatile("s_waitcnt vmcnt(0)" ::: "memory");
        } else {
            XB_SPIN(xb_ld(&bar[XB_XGEN(b.x)]) == gen, bar);
            __builtin_amdgcn_fence(__ATOMIC_ACQUIRE, "agent");
            asm volatile("s_waitcnt vmcnt(0)" ::: "memory");
        }
    }
    __syncthreads();
}

constexpr size_t MiB = 1u << 20;
constexpr size_t WS_SSA = 0, WS_SSB = 1 * MiB, WS_SSQ = 2 * MiB, WS_SSKV = 3 * MiB, WS_BIASP = 3 * MiB + 512 * 1024, WS_BAR = 3 * MiB + 768 * 1024, BAR_ZERO_BYTES = 32768, WS_LFLAG = WS_BAR + 16384, WS_SPLITF = WS_BAR + 24576, WS_LCARRY = WS_BAR + 32768, WS_W = 4 * MiB, WS_XB = 55 * MiB, WS_R1 = 87 * MiB;
constexpr size_t WS_GG = 183 * MiB, WS_AC = 199 * MiB, WS_CQ = 215 * MiB, WS_Q = 227 * MiB, WS_KPE = 251 * MiB, WS_KR = 252 * MiB, WS_CS = 253 * MiB, WS_END = 255 * MiB;
constexpr size_t WS_CKV = WS_W;
constexpr size_t W_F1W1 = 0, W_F1W2 = 11 * MiB, W_F2W1 = 16 * MiB + 512 * 1024, W_F2W2 = 27 * MiB + 512 * 1024, W_IN = 33 * MiB, W_LRUO = 44 * MiB + 512 * 1024,
                 W_UQ = 45 * MiB + 512 * 1024, W_UKV = 46 * MiB + 256 * 1024, W_MLAO = 46 * MiB + 768 * 1024, W_CONVO = 47 * MiB + 768 * 1024, W_OUT = 48 * MiB + 768 * 1024;
constexpr size_t DO_XPRE = 0, DO_PC = 16 * MiB, DO_KN = 32 * MiB, DO_V = 48 * MiB, DO_O = 0, DO_MERGED = 32 * MiB;
constexpr int LDS_BYTES = 147456, LDS_BARST = LDS_BYTES - 64;
static_assert(att::L_END <= LDS_BARST && lru::L_END <= LDS_BARST && cv::L_END <= LDS_BARST && pg8::STAGE_BYTES <= LDS_BARST && XCD_BAR_WORDS * 4 <= BAR_ZERO_BYTES, "LDS / barrier map");
static_assert(att::L_END <= LDS_BYTES && lru::L_END <= LDS_BYTES && cv::L_END <= LDS_BYTES && pg8::STAGE_BYTES <= LDS_BYTES, "LDS");

__device__ const float INVF[16] = {1.0f, 0.5623413251903491f, 0.31622776601683794f, 0.1778279410038923f, 0.1f, 0.05623413251903491f, 0.031622776601683794f, 0.01778279410038923f,
                                   0.01f, 0.005623413251903491f, 0.0031622776601683794f, 0.001778279410038923f, 0.001f, 0.0005623413251903491f, 0.00031622776601683794f, 0.0001778279410038923f};

__device__ __forceinline__ int dest_row(int kind, int n0) {
    if (kind == 1) { if (n0 < FF) return 256 * (n0 / 128) + (n0 % 128); const int n1 = n0 - FF; return 256 * (n1 / 128) + 128 + (n1 % 128); }
    if (kind == 2) {
        if (n0 < 1696) return n0;
        if (n0 < 2208) { const int v = n0 - 1696; return 1792 + 256 * (v / 128) + (v % 128); }
        if (n0 < 2720) { const int v = n0 - 2208; return 1792 + 256 * (v / 128) + 128 + (v % 128); }
        return 2816 + (n0 - 2720);
    }
    return n0;
}
__device__ __forceinline__ void cvt_item(const float* W, int K, int N, bf16_t* WT, int kind, const float* gk, LAS float* scr, int item, int lane) {
    const int nblk = N / 32, kb = item / nblk, nb = item % nblk, k0 = 64 * kb, n0 = 32 * nb;
#pragma unroll 8
    for (int i = 0; i < 32; ++i) { const int kk = 2 * i + (lane >> 5); scr[kk * 33 + (lane & 31)] = W[(size_t)(k0 + kk) * N + n0 + (lane & 31)]; }
    asm volatile("s_waitcnt lgkmcnt(0)" ::: "memory");
    const int c = lane & 7; const int dr = dest_row(kind, n0);
    float gs[8];
#pragma unroll
    for (int i = 0; i < 8; ++i) gs[i] = gk ? gk[k0 + 8 * c + i] : 1.0f;
#pragma unroll
    for (int j = 0; j < 4; ++j) { const int n = (lane >> 3) + 8 * j; const LAS float* s = scr + (8 * c) * 33 + n;
        u32x4 o; o.x = cvt_pk_bf16(s[0 * 33] * gs[0], s[1 * 33] * gs[1]); o.y = cvt_pk_bf16(s[2 * 33] * gs[2], s[3 * 33] * gs[3]); o.z = cvt_pk_bf16(s[4 * 33] * gs[4], s[5 * 33] * gs[5]); o.w = cvt_pk_bf16(s[6 * 33] * gs[6], s[7 * 33] * gs[7]);
        *(u32x4*)(WT + (size_t)(dr + n) * K + k0 + 8 * c) = o; }
    asm volatile("s_waitcnt lgkmcnt(0)" ::: "memory");
}

#ifndef GASQ
#define GASQ __attribute__((address_space(1)))
#endif
__device__ __forceinline__ const float* gptr(const GASQ float* p) { asm volatile("" : "+s"(p)); return (const float*)p; }
struct KArgs { const void* in[30]; float* out; unsigned char* ws; int ph_lo, ph_hi; };

__global__ void __launch_bounds__(512, 2) fwd_kernel(KArgs a) {
    extern __shared__ __attribute__((aligned(16))) unsigned char lds_raw[];
    LAS unsigned char* lds = (LAS unsigned char*)lds_raw;
    cg::grid_group grid = cg::this_grid();
#define OPAQUE_TID int tid_ = threadIdx.x; asm volatile("" : "+v"(tid_)); const int tid = tid_, lane = tid & 63, wave = __builtin_amdgcn_readfirstlane(tid >> 6), gw = bid * 8 + wave;
#define CS ((float*)(ws_ + WS_CS))
#define BIASP ((float*)(ws_ + WS_BIASP))
#define XB ((bf16_t*)(ws_ + WS_XB))
#define HB ((bf16_t*)(ws_ + WS_R1))
#define GB ((bf16_t*)(ws_ + WS_R1))
#define GG ((bf16_t*)(ws_ + WS_GG))
#define AC ((bf16_t*)(ws_ + WS_AC))
#define CQ ((bf16_t*)(ws_ + WS_CQ))
#define CKV ((bf16_t*)(ws_ + WS_CKV))
#define QB ((bf16_t*)(ws_ + WS_Q))
#define KPE ((bf16_t*)(ws_ + WS_KPE))
#define KR ((bf16_t*)(ws_ + WS_KR))
#define XPRE ((bf16_t*)(do_ + DO_XPRE))
#define PC ((bf16_t*)(do_ + DO_PC))
#define KN ((bf16_t*)(do_ + DO_KN))
#define VB ((bf16_t*)(do_ + DO_V))
#define OB ((bf16_t*)(do_ + DO_O))
#define MG ((bf16_t*)(do_ + DO_MERGED))
#define WB (ws_ + WS_W)
    const int lo = a.ph_lo, hi = a.ph_hi;
    int ph = 0;
    if (threadIdx.x < 16) ((LAS unsigned*)(lds + LDS_BARST))[threadIdx.x] = 0u;
    __syncthreads();
    XcdBarrier xbar = xcd_barrier_post((unsigned*)(a.ws + WS_BAR), (volatile LAS unsigned*)(lds + LDS_BARST));
    if (hi < 0) grid.sync();
typedef const float* cfp_t; typedef unsigned char* ucp_t;
#define KAS __attribute__((address_space(4)))
#define GASQ __attribute__((address_space(1)))
#define PHASE_BEGIN if (ph >= lo && ph < hi) { int G = gridDim.x, bid = blockIdx.x; asm volatile("" : "+s"(G), "+s"(bid)); const int NGW = G * 8; (void)NGW;     \
    const KAS void* kp_ = (const KAS void*)__builtin_amdgcn_kernarg_segment_ptr(); asm volatile("" : "+s"(kp_)); \
    GASQ unsigned char* wsg_ = (GASQ unsigned char*)(((const KAS ucp_t*)kp_)[31]); GASQ unsigned char* dog_ = (GASQ unsigned char*)(((const KAS ucp_t*)kp_)[30]); asm volatile("" : "+s"(wsg_), "+s"(dog_)); \
    unsigned char* ws_ = (unsigned char*)wsg_; unsigned char* do_ = (unsigned char*)dog_;
#define PHASE_END   if (ph + 1 < hi) { for (int r_ = 0; r_ < REP_SYNC; ++r_) xcd_barrier(xbar); } } ++ph;
#define INF(i) (gptr((const GASQ float*)(((const KAS cfp_t*)kp_)[i])))

    for (int l = 0; l < 2; ++l) {
        PHASE_BEGIN
        {
            OPAQUE_TID
            LAS float* scr = (LAS float*)(lds + wave * 16384);
            const float* w1a = INF(3) + (size_t)l * DM * 5632; const float* w2a = INF(4) + (size_t)l * FF * DM;
            const float* w1b = INF(27) + (size_t)l * DM * 5632; const float* w2b = INF(28) + (size_t)l * FF * DM;
            const float* win = INF(6) + (size_t)l * DM * DIN;
            constexpr int I_W1 = 16 * 176, I_W2 = 44 * 32, I_IN = 16 * 181, I_LO = 8 * 32, I_UQ = 6 * 24, I_UKV = 4 * 32, I_OUT = 16 * 32;
            constexpr int NITEMS = 2 * I_W1 + 2 * I_W2 + I_IN + 3 * I_LO + I_UQ + I_UKV + I_OUT;
            for (int r_ = 0; r_ < REP_CVT; ++r_)
            for (int it = gw; it < NITEMS; it += NGW) {
                int r = it;
                if (r < I_W1) { cvt_item(w1a, DM, 5632, (bf16_t*)(WB + W_F1W1), 1, INF(2) + l * DM, scr, r, lane); continue; } r -= I_W1;
                if (r < I_W1) { cvt_item(w1b, DM, 5632, (bf16_t*)(WB + W_F2W1), 1, INF(26) + l * DM, scr, r, lane); continue; } r -= I_W1;
                if (r < I_IN) { cvt_item(win, DM, DIN, (bf16_t*)(WB + W_IN), 2, INF(5) + l * DM, scr, r, lane); continue; } r -= I_IN;
                if (r < I_W2) { cvt_item(w2a, FF, DM, (bf16_t*)(WB + W_F1W2), 0, nullptr, scr, r, lane); continue; } r -= I_W2;
                if (r < I_W2) { cvt_item(w2b, FF, DM, (bf16_t*)(WB + W_F2W2), 0, nullptr, scr, r, lane); continue; } r -= I_W2;
                if (r < I_OUT) { cvt_item(INF(25) + (size_t)l * DM * DM, DM, DM, (bf16_t*)(WB + W_OUT), 0, nullptr, scr, r, lane); continue; } r -= I_OUT;
                if (r < I_LO) { cvt_item(INF(13) + (size_t)l * 512 * DM, 512, DM, (bf16_t*)(WB + W_LRUO), 0, nullptr, scr, r, lane); continue; } r -= I_LO;
                if (r < I_LO) { cvt_item(INF(18) + (size_t)l * 512 * DM, 512, DM, (bf16_t*)(WB + W_MLAO), 0, nullptr, scr, r, lane); continue; } r -= I_LO;
                if (r < I_LO) { cvt_item(INF(23) + (size_t)l * 512 * DM, 512, DM, (bf16_t*)(WB + W_CONVO), 0, nullptr, scr, r, lane); continue; } r -= I_LO;
                if (r < I_UQ) { cvt_item(INF(15) + (size_t)l * 384 * 768, 384, 768, (bf16_t*)(WB + W_UQ), 0, INF(14) + l * 384, scr, r, lane); continue; } r -= I_UQ;
                cvt_item(INF(17) + (size_t)l * 256 * 1024, 256, 1024, (bf16_t*)(WB + W_UKV), 0, INF(16) + l * 256, scr, r, lane);
            }
            { u32x4* z = (u32x4*)((bf16_t*)(WB + W_IN) + (size_t)1696 * DM); for (int i = bid * 512 + tid; i < 96 * DM / 8; i += G * 512) { unsigned zz = 0u; asm volatile("" : "+v"(zz)); z[i] = (u32x4){zz, zz, zz, zz}; } }
            if (l == 0) {
                const float* x = INF(0);
                for (int m = gw; m < MROWS; m += NGW) {
                    const f32x4* xr = (const f32x4*)(x + (size_t)m * DM) + lane; float s = 0.f; f32x4 v[4];
#pragma unroll
                    for (int j = 0; j < 4; ++j) { v[j] = xr[64 * j]; s += (v[j][0] * v[j][0] + v[j][1] * v[j][1]) + (v[j][2] * v[j][2] + v[j][3] * v[j][3]); }
                    s = wave_sum(s);
                    u32x2* o8 = (u32x2*)(XB + (size_t)m * DM) + lane;
#pragma unroll
                    for (int j = 0; j < 4; ++j) o8[64 * j] = (u32x2){cvt_pk_bf16(v[j][0], v[j][1]), cvt_pk_bf16(v[j][2], v[j][3])};
                    if (lane < 16) ((float*)(ws_ + WS_SSA))[(size_t)m * 16 + lane] = (lane == 0) ? s : 0.f;
                }
                const int* pos = (const int*)INF(1);
                for (int i = bid * 512 + tid; i < MROWS * 16; i += G * 512) { const int m = i >> 4, j = i & 15;
                    const float ang = (float)pos[m] * INVF[j];
                    double t = (double)ang * 0.15915494309189535; t -= rint(t); const float tf = (float)t;
                    CS[(size_t)m * 32 + j] = __builtin_amdgcn_cosf(tf); CS[(size_t)m * 32 + 16 + j] = __builtin_amdgcn_sinf(tf); }
                for (int i = bid * 512 + tid; i < 2 * DINP; i += G * 512) { const int ll = i / DINP, d = i % DINP; int n = -1;
                    if (d < 1696) n = d; else if (d < 1792) n = -1; else if (d < 2816) { const int t = d - 1792, p = t / 256, r = t % 256; n = (r < 128) ? (1696 + p * 128 + r) : (2208 + p * 128 + (r - 128)); } else n = 2720 + (d - 2816);
                    BIASP[i] = (n >= 0) ? INF(7)[(size_t)ll * DIN + n] : 0.f; }
            }
            __syncthreads();
        }
        PHASE_END

#define SSX(k) ((float*)(ws_ + ((((k) & 1) != 0) ? WS_SSB : WS_SSA)))
#define ss0 SSX(3 * l)
#define ss1 SSX(3 * l + 1)
#define ss2 SSX(3 * l + 2)
#define ss3 SSX(3 * l + 3)
#define ssq ((float*)(ws_ + WS_SSQ))
#define sskv ((float*)(ws_ + WS_SSKV))

        PHASE_BEGIN
#ifndef NO_G1
        for (int r_ = 0; r_ < REP_F1UP; ++r_) { pg8::Gemm g{XB, XB, XB, (bf16_t*)(WB + W_F1W1), nullptr, nullptr, MROWS, 5632, DM, DM}; pg8::StaticOrder S; S.init(MROWS, 5632, G, bid, 1, false);
          pg8::EpiUp E{HB, ss0}; pg8::gemm_phase<pg8::EpiUp, true>(lds, g, S, E);
          pg8::TailOrder T; T.init(MROWS, 5632, G, bid);
          if (T.on) { const int kh = T.half() * 512; pg8::Gemm gt{XB + kh, XB + kh, XB + kh, (bf16_t*)(WB + W_F1W1) + kh, nullptr, nullptr, MROWS, 5632, 512, DM};
              pg8::EpiUpTail Et{HB, ss0, (float*)do_, (unsigned*)(ws_ + WS_SPLITF) + (l * 2 + 0) * 128}; pg8::gemm_phase<pg8::EpiUpTail, true, pg8::TailOrder>(lds, gt, T, Et); } }
#endif
        PHASE_END
        PHASE_BEGIN
#ifndef NO_G2
        { pg8::Gemm g{HB, HB, HB, (bf16_t*)(WB + W_F1W2), nullptr, nullptr, MROWS, DM, FF, FF}; pg8::StaticOrder S; S.init(MROWS, DM, G, bid, 1);
          pg8::EpiRes E{XB, 0.5f, ss1, nullptr}; pg8::gemm_phase<pg8::EpiRes, true>(lds, g, S, E); }
#endif
        PHASE_END
        PHASE_BEGIN
#ifndef NO_G3
        for (int r_ = 0; r_ < REP_WIN; ++r_) { pg8::Gemm g{XB, XB, XB, (bf16_t*)(WB + W_IN), nullptr, nullptr, MROWS, DINP, DM, DM}; pg8::StaticOrder S; S.init(MROWS, DINP, G, bid, 1);
          pg8::EpiWin E{ss1, BIASP + l * DINP, XPRE, GG, CQ, CKV, KPE, PC, GB, ssq, sskv}; pg8::gemm_phase<pg8::EpiWin, true>(lds, g, S, E); }
#endif
        PHASE_END
        PHASE_BEGIN
#ifndef NO_G4
        for (int r_ = 0; r_ < REP_S4G; ++r_) { pg8::Gemm g{CQ, CQ, CQ, (bf16_t*)(WB + W_UQ), nullptr, nullptr, MROWS, 768, 384, 384}; pg8::StaticOrder S; S.init(MROWS, 768, G, bid, 1);
          pg8::EpiQ E{QB, ssq, CS}; pg8::gemm_phase<pg8::EpiQ, true>(lds, g, S, E); }
#endif
#ifndef NO_G4B
        for (int r_ = 0; r_ < REP_S4G; ++r_) { pg8::Gemm g{CKV, CKV, CKV, (bf16_t*)(WB + W_UKV), nullptr, nullptr, MROWS, 1024, 256, 256}; pg8::StaticOrder S; S.init(MROWS, 1024, G, bid, 1);
          pg8::EpiKV E{KN, VB, sskv}; pg8::gemm_phase<pg8::EpiKV, true>(lds, g, S, E); }
#endif
#ifndef NO_LRU
        for (int u = bid; u < 256; u += G)
            lru::lru_unit(u, l, XPRE, GG, INF(8) + l * 4 * 512, INF(9) + l * 512, INF(10) + (size_t)l * 8 * 64 * 128, INF(11) + l * 8 * 128, INF(12) + l * 512, (unsigned*)(ws_ + WS_LFLAG), (float*)(ws_ + WS_LCARRY), lds);
#endif
#ifndef NO_CONV
        for (int r_ = 0; r_ < REP_CONV; ++r_)
        for (int u = bid; u < 512; u += G)
            cv::conv_unit(u, PC, AC, INF(19) + l * 31 * 512, INF(20) + l * 512, INF(21) + l * 512, INF(22) + l * 512, KPE, KR, CS, lds);
#endif
        PHASE_END
        PHASE_BEGIN
#ifndef NO_ATT
        for (int r_ = 0; r_ < REP_ATT; ++r_)
        for (int u = ((G & 7) == 0 ? (bid & 7) * (G >> 3) + (bid >> 3) : bid); u < 256; u += G) { const int bh = u >> 2, s = u & 3;
            att::attn_block(bh >> 3, bh & 7, 7 - s, QB, KN, KR, VB, OB, lds);
            att::attn_block(bh >> 3, bh & 7, s, QB, KN, KR, VB, OB, lds); }
#endif
        PHASE_END
        PHASE_BEGIN
#ifndef NO_G6
        for (int r_ = 0; r_ < REP_MERGE; ++r_) { pg8::Gemm g{GG, OB, AC, (bf16_t*)(WB + W_LRUO), (bf16_t*)(WB + W_MLAO), (bf16_t*)(WB + W_CONVO), MROWS, DM, 512, 512}; pg8::StaticOrder S; S.init(MROWS, DM, G, bid, 3);
          pg8::EpiMerge E{GB, INF(24) + l * DM, MG}; pg8::gemm_phase<pg8::EpiMerge, true>(lds, g, S, E); }
#endif
        PHASE_END
        PHASE_BEGIN
#ifndef NO_G7
        { pg8::Gemm g{MG, MG, MG, (bf16_t*)(WB + W_OUT), nullptr, nullptr, MROWS, DM, DM, DM}; pg8::StaticOrder S; S.init(MROWS, DM, G, bid, 1);
          pg8::EpiRes E{XB, 1.0f, ss2, nullptr}; pg8::gemm_phase<pg8::EpiRes, true>(lds, g, S, E); }
#endif
        PHASE_END
        PHASE_BEGIN
#ifndef NO_G8
        { pg8::Gemm g{XB, XB, XB, (bf16_t*)(WB + W_F2W1), nullptr, nullptr, MROWS, 5632, DM, DM}; pg8::StaticOrder S; S.init(MROWS, 5632, G, bid, 1, false);
          pg8::EpiUp E{HB, ss2}; pg8::gemm_phase<pg8::EpiUp, true>(lds, g, S, E);
          pg8::TailOrder T; T.init(MROWS, 5632, G, bid);
          if (T.on) { const int kh = T.half() * 512; pg8::Gemm gt{XB + kh, XB + kh, XB + kh, (bf16_t*)(WB + W_F2W1) + kh, nullptr, nullptr, MROWS, 5632, 512, DM};
              pg8::EpiUpTail Et{HB, ss2, (float*)do_, (unsigned*)(ws_ + WS_SPLITF) + (l * 2 + 1) * 128}; pg8::gemm_phase<pg8::EpiUpTail, true, pg8::TailOrder>(lds, gt, T, Et); } }
#endif
        PHASE_END
        PHASE_BEGIN
#ifndef NO_G9
        { pg8::Gemm g{HB, HB, HB, (bf16_t*)(WB + W_F2W2), nullptr, nullptr, MROWS, DM, FF, FF}; pg8::StaticOrder S; S.init(MROWS, DM, G, bid, 1);
          pg8::EpiRes E{XB, 0.5f, ss3, (l == 1) ? (float*)do_ : nullptr}; pg8::gemm_phase<pg8::EpiRes, true>(lds, g, S, E); }
#endif
        PHASE_END
    }
    PHASE_BEGIN
    {
        OPAQUE_TID
        const float* ssf = (const float*)(ws_ + WS_SSA); const float* gf = INF(29);
        for (int m = gw; m < MROWS; m += NGW) {
            const float rs = rsqrtf(sum_slots16(ssf + (size_t)m * 16) * (1.0f / DM) + EPS);
            f32x4* xr = (f32x4*)((float*)do_ + (size_t)m * DM) + lane; const f32x4* gr = (const f32x4*)gf + lane;
#pragma unroll
            for (int j = 0; j < 4; ++j) xr[64 * j] = xr[64 * j] * rs * gr[64 * j];
        }
    }
    PHASE_END
}

constexpr int N_PHASES = 21;
#ifndef MK_PER_PHASE
#define MK_PER_PHASE 0
#endif

extern "C" void kernel_launch(void* const* d_in, const int* in_sizes, int n_in, void* d_out, int out_size, void* d_ws, size_t ws_size, hipStream_t stream) {
    static int grid = 0;
    if (grid == 0) {
        if (n_in != 30 || out_size != MROWS * DM || ws_size < WS_END) { fprintf(stderr, "kernel_launch: unexpected problem (n_in %d out %d ws %zu)\n", n_in, out_size, ws_size); grid = -1; return; }
        int dev = 0, cus = 0, per_cu = 0;
        hipGetDevice(&dev); hipDeviceGetAttribute(&cus, hipDeviceAttributeMultiprocessorCount, dev);
        hipFuncSetAttribute((const void*)fwd_kernel, hipFuncAttributeMaxDynamicSharedMemorySize, LDS_BYTES);
        hipOccupancyMaxActiveBlocksPerMultiprocessor(&per_cu, (const void*)fwd_kernel, 512, LDS_BYTES);
        if (per_cu < 1) { fprintf(stderr, "kernel_launch: occupancy query says %d blocks per CU\n", per_cu); per_cu = 1; }
        (void)hipGetLastError();
        grid = cus * 1;
    }
    if (grid < 0) return;
    hipMemsetAsync((char*)d_ws + WS_BAR, 0, BAR_ZERO_BYTES, stream);
    KArgs a{};
    for (int i = 0; i < 30; ++i) a.in[i] = d_in[i];
    a.out = (float*)d_out; a.ws = (unsigned char*)d_ws;
#if MK_PER_PHASE
    for (int p = 0; p < N_PHASES; ++p) { a.ph_lo = p; a.ph_hi = p + 1; hipLaunchKernelGGL(fwd_kernel, dim3(grid), dim3(512), LDS_BYTES, stream, a); }
#else
    a.ph_lo = 0; a.ph_hi = N_PHASES;
    void* args[] = {&a};
    hipError_t e = hipLaunchCooperativeKernel((const void*)fwd_kernel, dim3(grid), dim3(512), args, LDS_BYTES, stream);
    if (e != hipSuccess) fprintf(stderr, "cooperative launch failed: %s (grid %d)\n", hipGetErrorString(e), grid);
#endif
}
```

```cpp
#include <hip/hip_runtime.h>
#include <hip/hip_cooperative_groups.h>
#include <cstdio>
#include <cstdint>
namespace cg = cooperative_groups;

#define LAS __attribute__((address_space(3)))
typedef unsigned short bf16_t;
typedef short bf16x8 __attribute__((ext_vector_type(8)));
typedef short s16x4 __attribute__((ext_vector_type(4)));
typedef float f32x2 __attribute__((ext_vector_type(2)));
typedef float f32x4 __attribute__((ext_vector_type(4)));
typedef float f32x16 __attribute__((ext_vector_type(16)));
typedef unsigned u32x2 __attribute__((ext_vector_type(2)));
typedef unsigned u32x4 __attribute__((ext_vector_type(4)));

#ifndef REP_ATT
#define REP_ATT 1
#endif
#ifndef REP_F1UP
#define REP_F1UP 1
#endif
#ifndef REP_WIN
#define REP_WIN 1
#endif
#ifndef REP_S4G
#define REP_S4G 1
#endif
#ifndef REP_CONV
#define REP_CONV 1
#endif
#ifndef REP_MERGE
#define REP_MERGE 1
#endif
#ifndef REP_SYNC
#define REP_SYNC 1
#endif
#ifndef REP_CVT
#define REP_CVT 1
#endif
#ifndef REP_LRU
#define REP_LRU 1
#endif
constexpr int MROWS = 16384, DM = 1024, FF = 2816, SEQ = 2048, NB = 8;
constexpr int DIN = 5792, DINP = 5888;
constexpr float EPS = 1e-6f;
constexpr float QSCALE = 0.10206207261596577f * 1.4426950408889634f;

__device__ __forceinline__ unsigned cvt_pk_bf16(float lo, float hi) { unsigned r; asm volatile("v_cvt_pk_bf16_f32 %0, %1, %2" : "=v"(r) : "v"(lo), "v"(hi)); return r; }
__device__ __forceinline__ float bflo(unsigned w) { return __uint_as_float(w << 16); }
__device__ __forceinline__ float bfhi(unsigned w) { return __uint_as_float(w & 0xffff0000u); }
__device__ __forceinline__ float bf2f(bf16_t v) { return __uint_as_float(((unsigned)v) << 16); }
__device__ __forceinline__ bf16_t f2bf(float f) { return (bf16_t)(cvt_pk_bf16(f, 0.f) & 0xffffu); }
__device__ __forceinline__ float fast_sigmoid(float x) { return __builtin_amdgcn_rcpf(1.0f + __builtin_amdgcn_exp2f(-1.4426950408889634f * x)); }
__device__ __forceinline__ float wave_sum(float v) {
#pragma unroll
    for (int o = 1; o < 64; o <<= 1) v += __shfl_xor(v, o);
    return v;
}

__device__ __forceinline__ float sum_slots16(const float* p) { const f32x4 a = *(const f32x4*)p, b = *(const f32x4*)(p + 4), c = *(const f32x4*)(p + 8), d = *(const f32x4*)(p + 12);
    return (((a[0] + a[1]) + (a[2] + a[3])) + ((b[0] + b[1]) + (b[2] + b[3]))) + (((c[0] + c[1]) + (c[2] + c[3])) + ((d[0] + d[1]) + (d[2] + d[3]))); }
__device__ __forceinline__ float sum_slots12(const float* p) { const f32x4 a = *(const f32x4*)p, b = *(const f32x4*)(p + 4), c = *(const f32x4*)(p + 8);
    return (((a[0] + a[1]) + (a[2] + a[3])) + ((b[0] + b[1]) + (b[2] + b[3]))) + ((c[0] + c[1]) + (c[2] + c[3])); }
__device__ __forceinline__ float sum_slots8(const float* p) { const f32x4 a = *(const f32x4*)p, b = *(const f32x4*)(p + 4);
    return ((a[0] + a[1]) + (a[2] + a[3])) + ((b[0] + b[1]) + (b[2] + b[3])); }

namespace pg8 {
constexpr int BM = 256, BK = 64, HALF = 128, HTB = HALF * BK * 2, STAGE_BYTES = 8 * HTB, NXCD = 8, WGM = 4;
__host__ __device__ __forceinline__ int lds_byte(int r, int c) { const int st = (r >> 4) * 2 + (c >> 5), rr = r & 15, cc = c & 31, ob = rr * 64 + cc * 2; return st * 1024 + (ob ^ (((ob >> 9) & 1) << 5)); }
__host__ __device__ __forceinline__ void stage_rc(int b, int& R, int& C) { const int st = b / 1024, sb = b % 1024, swz = sb ^ (((sb >> 9) & 1) << 5); R = (st >> 1) * 16 + swz / 64; C = (st & 1) * 32 + (swz % 64) / 2; }
__host__ __device__ __forceinline__ int perm32(int rho) { const int n = rho >> 4, i = rho & 15; return 8 * (i >> 2) + 4 * n + (i & 3); }

struct Unit { int pm, pn, seg, split, slot; };
struct Gemm { const bf16_t *A0, *A1, *A2; const bf16_t *B0, *B1, *B2; int M, N, K, LD;
    __device__ __forceinline__ const char* a(int s) const { return (const char*)(s == 0 ? A0 : (s == 1 ? A1 : A2)); }
    __device__ __forceinline__ const char* b(int s) const { return (const char*)(s == 0 ? B0 : (s == 1 ? B1 : B2)); } };

__device__ __forceinline__ void unit_of(int L, int nwg, int nM, int nN, Unit& u) {
    int wgid = L; { const int q = nwg / NXCD, r = nwg % NXCD, xcd = wgid % NXCD, off = wgid / NXCD; wgid = (xcd < r ? xcd * (q + 1) : r * (q + 1) + (xcd - r) * q) + off; }
    const int nig = WGM * nN, gid = wgid / nig, fm = gid * WGM, gsz = (nM - fm) < WGM ? (nM - fm) : WGM;
    u.pm = fm + ((wgid % nig) % gsz); u.pn = (wgid % nig) / gsz;
}
struct StaticOrder {
    int nM, nN, nwg, G, c, nseg, nlim;
    __device__ __forceinline__ void init(int M, int N, int G_, int c_, int nseg_, bool split_tail = false) { nM = M / BM; nN = N / BM; nwg = nM * nN; G = G_; c = c_; nseg = nseg_;
        nlim = (split_tail && 2 * (nwg % G_) == G_) ? (nwg / G_) * G_ : nwg; }
    __device__ __forceinline__ bool next(int i, Unit& u) const {
        const int ti = i / nseg; u.seg = i - ti * nseg; u.split = 0; u.slot = 0;
        const long L = (long)ti * G + c; if (L >= nlim) return false;
        unit_of((int)L, nwg, nM, nN, u); return true;
    }
};
struct TailOrder {
    int nM, nN, nwg, G, c, on;
    __device__ __forceinline__ void init(int M, int N, int G_, int c_) { nM = M / BM; nN = N / BM; nwg = nM * nN; G = G_; c = c_; on = 0; (void)G_; }
    __device__ __forceinline__ int half() const { return (c >= (G >> 1)) ? 1 : 0; }
    __device__ __forceinline__ bool next(int i, Unit& u) const {
        if (!on || i != 0) return false;
        u.seg = 0; u.slot = c - half() * (G >> 1); u.split = 1 + half();
        unit_of((nwg / G) * G + u.slot, nwg, nM, nN, u); return true;
    }
};

template <class Epi, bool ALIGN_EPI, class Order = StaticOrder>
__device__ __forceinline__ void gemm_phase(LAS unsigned char* lds, const Gemm g, const Order& S, const Epi& E) {
    int tid_ = threadIdx.x; asm volatile("" : "+v"(tid_));
    const int tid = tid_, wid = __builtin_amdgcn_readfirstlane(tid >> 6), lane = tid & 63, wr = wid >> 2, wc = wid & 3, fr = lane & 15, fq = lane >> 4;
    const int K = g.LD, nt = g.K / BK;
    const char *gA0 = (const char*)g.A0, *gA1 = (const char*)g.A1, *gA2 = (const char*)g.A2, *gB0 = (const char*)g.B0, *gB1 = (const char*)g.B1, *gB2 = (const char*)g.B2;
    asm volatile("" : "+s"(gA0), "+s"(gA1), "+s"(gA2), "+s"(gB0), "+s"(gB1), "+s"(gB2));
#define PG8_SELA(s) ((s) == 0 ? gA0 : ((s) == 1 ? gA1 : gA2))
#define PG8_SELB(s) ((s) == 0 ? gB0 : ((s) == 1 ? gB1 : gB2))
    unsigned voffA[2], voffB[2];
#pragma unroll
    for (int i = 0; i < 2; ++i) { int R, C; stage_rc(tid * 16 + i * 8192, R, C); const int Rb = Epi::PERM ? ((R & ~31) + perm32(R & 31)) : R;
        voffA[i] = (unsigned)(R * K + C) * 2u; voffB[i] = (unsigned)(Rb * K + C) * 2u; }
    const size_t kstep = (size_t)(BK * 2);
    const size_t hstep = (size_t)HALF * K * 2;
    const size_t tstep = 2 * hstep;
    const unsigned ldsw = (unsigned)wid * 1024u;
    const int aoff = lds_byte(wr * 64 + fr, fq * 8), boff = lds_byte(wc * 32 + fr, fq * 8);
#define PG8_SA(b, h) (((b) * 2 + (h)) * HTB)
#define PG8_SB(b, h) ((4 + (b) * 2 + (h)) * HTB)
#define PG8_STAGE(bufoff, gbase, voff) do { _Pragma("unroll") for (int _i = 0; _i < 2; ++_i) \
        __builtin_amdgcn_global_load_lds((const unsigned*)((const char*)(gbase) + (voff)[_i]), (LAS unsigned*)(lds + (bufoff) + ldsw + _i * 8192), 16, 0, 0); } while (0)
#define PG8_LDA(dst, b, h) do { _Pragma("unroll") for (int m = 0; m < 4; ++m) _Pragma("unroll") for (int k = 0; k < 2; ++k) dst[m][k] = *(const LAS bf16x8*)(lds + PG8_SA(b, h) + aoff + m * 2048 + k * 1024); } while (0)
#define PG8_LDB(dst, b, h) do { _Pragma("unroll") for (int n = 0; n < 2; ++n) _Pragma("unroll") for (int k = 0; k < 2; ++k) dst[n][k] = *(const LAS bf16x8*)(lds + PG8_SB(b, h) + boff + n * 2048 + k * 1024); } while (0)
#define PG8_MMA(ai, bj, At, Bt) do { __builtin_amdgcn_s_setprio(1); _Pragma("unroll") for (int m = 0; m < 4; ++m) _Pragma("unroll") for (int n = 0; n < 2; ++n) _Pragma("unroll") for (int k = 0; k < 2; ++k) \
        acc[ai][bj][m][n] = __builtin_amdgcn_mfma_f32_16x16x32_bf16(Bt[n][k], At[m][k], acc[ai][bj][m][n], 0, 0, 0); __builtin_amdgcn_s_setprio(0); } while (0)
#define PG8_WAIT_V(n) asm volatile("s_waitcnt vmcnt(" #n ")" ::: "memory")
#define PG8_WAIT_L(n) asm volatile("s_waitcnt lgkmcnt(" #n ")" ::: "memory")
#define PG8_BAR __builtin_amdgcn_s_barrier()
#define PG8_SCHED __builtin_amdgcn_sched_barrier(0)
    Unit cur, nxt; int ui = 0;
    if (!S.next(0, cur)) return;
    f32x4 acc[2][2][4][2];
#pragma unroll
    for (int a = 0; a < 2; ++a)
#pragma unroll
        for (int b = 0; b < 2; ++b)
#pragma unroll
            for (int m = 0; m < 4; ++m)
#pragma unroll
                for (int n = 0; n < 2; ++n) acc[a][b][m][n] = (f32x4){0.f, 0.f, 0.f, 0.f};
    bf16x8 At[4][2], B0[2][2], B1[2][2];
    const char* cA = PG8_SELA(cur.seg) + (size_t)cur.pm * tstep; const char* cB = PG8_SELB(cur.seg) + (size_t)cur.pn * tstep;
    PG8_STAGE(PG8_SB(0, 0), cB, voffB); PG8_STAGE(PG8_SB(0, 1), cB + hstep, voffB); PG8_STAGE(PG8_SA(0, 0), cA, voffA); PG8_STAGE(PG8_SA(0, 1), cA + hstep, voffA);
    if (wr == 1) PG8_BAR;
    PG8_WAIT_V(2); PG8_BAR;
    PG8_STAGE(PG8_SB(1, 0), cB + kstep, voffB); PG8_STAGE(PG8_SA(1, 0), cA + kstep, voffA); PG8_STAGE(PG8_SB(1, 1), cB + hstep + kstep, voffB);
    PG8_WAIT_V(6); PG8_BAR;
    for (;;) {
        const bool has_next = S.next(ui + 1, nxt);
        const char* nA = has_next ? PG8_SELA(nxt.seg) + (size_t)nxt.pm * tstep : cA; const char* nB = has_next ? PG8_SELB(nxt.seg) + (size_t)nxt.pn * tstep : cB;
#pragma unroll 1
        for (int t = 0; t < nt; t += 2) {
            const bool last = (t == nt - 2);
            const char* a1 = cA + (size_t)(t + 1) * kstep;
            const char* a2 = last ? nA : cA + (size_t)(t + 2) * kstep; const char* b2 = last ? nB : cB + (size_t)(t + 2) * kstep;
            const char* a3 = a2 + kstep; const char* b3 = b2 + kstep;
            PG8_LDB(B0, 0, 0); PG8_LDB(B1, 0, 1); PG8_SCHED; PG8_LDA(At, 0, 0); PG8_STAGE(PG8_SA(1, 1), a1 + hstep, voffA);
            PG8_WAIT_V(8); PG8_WAIT_L(0); PG8_BAR; PG8_MMA(0, 0, At, B0); PG8_MMA(0, 1, At, B1); PG8_BAR; PG8_SCHED;
            PG8_LDA(At, 0, 1); PG8_STAGE(PG8_SB(0, 0), b2, voffB); PG8_STAGE(PG8_SB(0, 1), b2 + hstep, voffB); PG8_STAGE(PG8_SA(0, 0), a2, voffA);
            PG8_WAIT_V(8); PG8_WAIT_L(0); PG8_BAR; PG8_MMA(1, 0, At, B0); PG8_MMA(1, 1, At, B1); PG8_BAR; PG8_SCHED;
            PG8_LDB(B0, 1, 0); PG8_LDB(B1, 1, 1); PG8_SCHED; PG8_LDA(At, 1, 0); PG8_STAGE(PG8_SA(0, 1), a2 + hstep, voffA);
            PG8_WAIT_V(8); PG8_WAIT_L(0); PG8_BAR; PG8_MMA(0, 0, At, B0); PG8_MMA(0, 1, At, B1); PG8_BAR; PG8_SCHED;
            PG8_LDA(At, 1, 1); PG8_STAGE(PG8_SB(1, 0), b3, voffB); PG8_STAGE(PG8_SB(1, 1), b3 + hstep, voffB); PG8_STAGE(PG8_SA(1, 0), a3, voffA);
            PG8_WAIT_V(8); PG8_WAIT_L(0); PG8_BAR; PG8_MMA(1, 0, At, B0); PG8_MMA(1, 1, At, B1); PG8_BAR; PG8_SCHED;
        }
        if constexpr (ALIGN_EPI) { if (wr == 0) PG8_BAR; }
        const bool zero = E(acc, cur, wr, wc, fr, fq);
        if (!has_next) break;
        if (zero) {
#pragma unroll
            for (int a = 0; a < 2; ++a)
#pragma unroll
                for (int b = 0; b < 2; ++b)
#pragma unroll
                    for (int m = 0; m < 4; ++m)
#pragma unroll
                        for (int n = 0; n < 2; ++n) acc[a][b][m][n] = (f32x4){0.f, 0.f, 0.f, 0.f};
        }
        cur = nxt; cA = nA; cB = nB; ++ui;
        if constexpr (ALIGN_EPI) { if (wr == 1) PG8_BAR; }
    }
    PG8_WAIT_V(0);
    if constexpr (!ALIGN_EPI) { if (wr == 0) PG8_BAR; }
    PG8_BAR;
#undef PG8_SA
#undef PG8_SB
#undef PG8_STAGE
#undef PG8_LDA
#undef PG8_LDB
#undef PG8_MMA
#undef PG8_WAIT_V
#undef PG8_WAIT_L
#undef PG8_BAR
#undef PG8_SCHED
}

#define EPI_ROW(ai, m) (u.pm * BM + (ai) * HALF + wr * 64 + (m) * 16 + fr)
__device__ __forceinline__ u32x4 pack8(const f32x4 a, const f32x4 b) { u32x4 w; w.x = cvt_pk_bf16(a[0], a[1]); w.y = cvt_pk_bf16(a[2], a[3]); w.z = cvt_pk_bf16(b[0], b[1]); w.w = cvt_pk_bf16(b[2], b[3]); return w; }

struct EpiUp {
    static constexpr bool PERM = true;
    bf16_t* H; const float* ss;
    __device__ __forceinline__ bool operator()(f32x4 (&acc)[2][2][4][2], const Unit& u, int wr, int wc, int fr, int fq) const {
        asm volatile("" : "+v"(fr), "+v"(fq));
#pragma unroll
        for (int ai = 0; ai < 2; ++ai)
#pragma unroll
            for (int m = 0; m < 4; ++m) {
                const int row = EPI_ROW(ai, m);
                const float rs = rsqrtf(sum_slots16(ss + (size_t)row * 16) * (1.0f / DM) + EPS);
                f32x4 o[2];
#pragma unroll
                for (int n = 0; n < 2; ++n)
#pragma unroll
                    for (int i = 0; i < 4; ++i) { const float gv = acc[ai][0][m][n][i] * rs, uv = acc[ai][1][m][n][i] * rs; o[n][i] = gv * fast_sigmoid(gv) * uv; }
                *(u32x4*)(H + (size_t)row * FF + u.pn * 128 + wc * 32 + fq * 8) = pack8(o[0], o[1]);
            }
        return true;
    }
};

struct EpiUpTail {
    static constexpr bool PERM = true;
    bf16_t* H; const float* ss; float* P; unsigned* flg;
    __device__ __forceinline__ bool operator()(f32x4 (&acc)[2][2][4][2], const Unit& u, int wr, int wc, int fr, int fq) const {
        asm volatile("" : "+v"(fr), "+v"(fq));
        const int tid = threadIdx.x;
        float* pp = P + (size_t)u.slot * (32 * 2048) + tid * 4;
        if (u.split == 2) {
#pragma unroll
            for (int ai = 0; ai < 2; ++ai)
#pragma unroll
                for (int bj = 0; bj < 2; ++bj)
#pragma unroll
                    for (int m = 0; m < 4; ++m)
#pragma unroll
                        for (int n = 0; n < 2; ++n) *(f32x4*)(pp + (((ai * 2 + bj) * 4 + m) * 2 + n) * 2048) = acc[ai][bj][m][n];
            __threadfence();
            __syncthreads();
            if (tid == 0) __hip_atomic_store(flg + u.slot, 1u, __ATOMIC_RELEASE, __HIP_MEMORY_SCOPE_AGENT);
            return true;
        }
        if (tid == 0) { unsigned sp = 0; while (__hip_atomic_load(flg + u.slot, __ATOMIC_RELAXED, __HIP_MEMORY_SCOPE_AGENT) == 0u) { __builtin_amdgcn_s_sleep(2); if (++sp > (1u << 22)) break; } }
        __syncthreads();
        __builtin_amdgcn_fence(__ATOMIC_ACQUIRE, "agent");
#pragma unroll
        for (int ai = 0; ai < 2; ++ai)
#pragma unroll
            for (int m = 0; m < 4; ++m) {
                const int row = EPI_ROW(ai, m);
                const float rs = rsqrtf(sum_slots16(ss + (size_t)row * 16) * (1.0f / DM) + EPS);
                f32x4 o[2], ga[2], ua[2];
#pragma unroll
                for (int n = 0; n < 2; ++n) { ga[n] = acc[ai][0][m][n] + *(const f32x4*)(pp + (((ai * 2 + 0) * 4 + m) * 2 + n) * 2048); ua[n] = acc[ai][1][m][n] + *(const f32x4*)(pp + (((ai * 2 + 1) * 4 + m) * 2 + n) * 2048); }
#pragma unroll
                for (int n = 0; n < 2; ++n)
#pragma unroll
                    for (int i = 0; i < 4; ++i) { const float gv = ga[n][i] * rs, uv = ua[n][i] * rs; o[n][i] = gv * fast_sigmoid(gv) * uv; }
                *(u32x4*)(H + (size_t)row * FF + u.pn * 128 + wc * 32 + fq * 8) = pack8(o[0], o[1]);
                asm volatile("" ::: "memory");
            }
        return true;
    }
};

struct EpiRes {
    static constexpr bool PERM = true;
    bf16_t* XB; float alpha; float* ssn; float* outf;
    __device__ __forceinline__ bool operator()(f32x4 (&acc)[2][2][4][2], const Unit& u, int wr, int wc, int fr, int fq) const {
        asm volatile("" : "+v"(fr), "+v"(fq));
#pragma unroll
        for (int ai = 0; ai < 2; ++ai)
#pragma unroll
            for (int m = 0; m < 4; ++m) {
                const int row = EPI_ROW(ai, m);
                float sq = 0.f;
#pragma unroll
                for (int bj = 0; bj < 2; ++bj) {
                    const size_t off = (size_t)row * DM + u.pn * BM + bj * HALF + wc * 32 + fq * 8;
                    const u32x4 old = *(const u32x4*)(XB + off);
                    f32x4 a, b;
                    a[0] = bflo(old.x) + alpha * acc[ai][bj][m][0][0]; a[1] = bfhi(old.x) + alpha * acc[ai][bj][m][0][1];
                    a[2] = bflo(old.y) + alpha * acc[ai][bj][m][0][2]; a[3] = bfhi(old.y) + alpha * acc[ai][bj][m][0][3];
                    b[0] = bflo(old.z) + alpha * acc[ai][bj][m][1][0]; b[1] = bfhi(old.z) + alpha * acc[ai][bj][m][1][1];
                    b[2] = bflo(old.w) + alpha * acc[ai][bj][m][1][2]; b[3] = bfhi(old.w) + alpha * acc[ai][bj][m][1][3];
                    sq += (a[0] * a[0] + a[1] * a[1]) + (a[2] * a[2] + a[3] * a[3]) + (b[0] * b[0] + b[1] * b[1]) + (b[2] * b[2] + b[3] * b[3]);
                    *(u32x4*)(XB + off) = pack8(a, b);
                    if (outf) { *(f32x4*)(outf + off) = a; *(f32x4*)(outf + off + 4) = b; }
                }
                sq += __shfl_xor(sq, 16); sq += __shfl_xor(sq, 32);
                if (fq == 0) ssn[(size_t)row * 16 + u.pn * 4 + wc] = sq;
            }
        return true;
    }
};

struct EpiWin {
    static constexpr bool PERM = true;
    const float* ss; const float* biasP;
    bf16_t *XPRE, *GG, *CQ, *CKV, *KPE, *PC, *G; float *ssq, *sskv;
    __device__ __forceinline__ bool operator()(f32x4 (&acc)[2][2][4][2], const Unit& u, int wr, int wc, int fr, int fq) const {
        asm volatile("" : "+v"(fr), "+v"(fq));
        const int pn = u.pn;
        const int cl = wc * 32 + fq * 8;
        f32x4 bv[2][2];
#pragma unroll
        for (int bj = 0; bj < 2; ++bj)
#pragma unroll
            for (int n = 0; n < 2; ++n) bv[bj][n] = *(const f32x4*)(biasP + pn * BM + bj * HALF + cl + 4 * n);
#pragma unroll
        for (int ai = 0; ai < 2; ++ai)
#pragma unroll
            for (int m = 0; m < 4; ++m) {
                const int row = EPI_ROW(ai, m);
                const float rs = rsqrtf(sum_slots16(ss + (size_t)row * 16) * (1.0f / DM) + EPS);
                f32x4 v[2][2];
#pragma unroll
                for (int bj = 0; bj < 2; ++bj)
#pragma unroll
                    for (int n = 0; n < 2; ++n) v[bj][n] = acc[ai][bj][m][n] * rs + bv[bj][n];
                if (pn < 2) {
#pragma unroll
                    for (int bj = 0; bj < 2; ++bj) *(u32x4*)(XPRE + (size_t)row * 512 + pn * BM + bj * HALF + cl) = pack8(v[bj][0], v[bj][1]);
                } else if (pn < 4) {
#pragma unroll
                    for (int bj = 0; bj < 2; ++bj) {
#pragma unroll
                        for (int n = 0; n < 2; ++n)
#pragma unroll
                            for (int i = 0; i < 4; ++i) { const float x = v[bj][n][i]; const float z = 1.5957691216057308f * (x + 0.044715f * x * x * x); v[bj][n][i] = x * fast_sigmoid(z); }
                        *(u32x4*)(GG + (size_t)row * 512 + (pn - 2) * BM + bj * HALF + cl) = pack8(v[bj][0], v[bj][1]);
                    }
                } else if (pn < 7) {
#pragma unroll
                    for (int bj = 0; bj < 2; ++bj) {
                        const int seg = (pn - 4) * 2 + bj;
                        float sq = 0.f;
#pragma unroll
                        for (int n = 0; n < 2; ++n)
#pragma unroll
                            for (int i = 0; i < 4; ++i) sq += v[bj][n][i] * v[bj][n][i];
                        sq += __shfl_xor(sq, 16); sq += __shfl_xor(sq, 32);
                        const u32x4 w = pack8(v[bj][0], v[bj][1]);
                        if (seg < 3) { *(u32x4*)(CQ + (size_t)row * 384 + seg * 128 + cl) = w; if (fq == 0) ssq[(size_t)row * 16 + seg * 4 + wc] = sq; }
                        else if (seg < 5) { *(u32x4*)(CKV + (size_t)row * 256 + (seg - 3) * 128 + cl) = w; if (fq == 0) sskv[(size_t)row * 8 + (seg - 3) * 4 + wc] = sq; }
                        else if (wc == 0) { *(u32x4*)(KPE + (size_t)row * 32 + fq * 8) = w; }
                    }
                } else if (pn < 11) {
                    f32x4 o[2];
#pragma unroll
                    for (int n = 0; n < 2; ++n)
#pragma unroll
                        for (int i = 0; i < 4; ++i) o[n][i] = v[0][n][i] * fast_sigmoid(v[1][n][i]);
                    *(u32x4*)(PC + (size_t)row * 512 + (pn - 7) * 128 + cl) = pack8(o[0], o[1]);
                } else {
#pragma unroll
                    for (int bj = 0; bj < 2; ++bj) {
#pragma unroll
                        for (int n = 0; n < 2; ++n)
#pragma unroll
                            for (int i = 0; i < 4; ++i) v[bj][n][i] = fmaxf(fast_sigmoid(v[bj][n][i]), 1e-30f);
                        *(u32x4*)(G + (size_t)row * 3072 + (pn - 11) * BM + bj * HALF + cl) = pack8(v[bj][0], v[bj][1]);
                    }
                }
            }
        return true;
    }
};

struct EpiQ {
    static constexpr bool PERM = false;
    bf16_t* Q; const float* ssq; const float* CS;
    __device__ __forceinline__ bool operator()(f32x4 (&acc)[2][2][4][2], const Unit& u, int wr, int wc, int fr, int fq) const {
        asm volatile("" : "+v"(fr), "+v"(fq));
        float rsv[2][4];
#pragma unroll
        for (int ai = 0; ai < 2; ++ai) {
#pragma unroll
            for (int m = 0; m < 4; ++m) rsv[ai][m] = sum_slots12(ssq + (size_t)EPI_ROW(ai, m) * 16);
            asm volatile("" ::: "memory"); }
#pragma unroll
        for (int ai = 0; ai < 2; ++ai)
#pragma unroll
            for (int m = 0; m < 4; ++m) {
                const int row = EPI_ROW(ai, m);
                const float rs = rsqrtf(rsv[ai][m] * (1.0f / 384.0f) + EPS) * QSCALE;
                const f32x4 cs = *(const f32x4*)(CS + (size_t)row * 32 + 4 * fq), sn = *(const f32x4*)(CS + (size_t)row * 32 + 16 + 4 * fq);
#pragma unroll
                for (int bj = 0; bj < 2; ++bj) {
                    const int c0 = u.pn * BM + bj * HALF + wc * 32;
                    f32x4 x1 = acc[ai][bj][m][0] * rs, x2 = acc[ai][bj][m][1] * rs;
                    if ((c0 % 96) == 64) { const f32x4 y1 = x1 * cs - x2 * sn, y2 = x2 * cs + x1 * sn; x1 = y1; x2 = y2; }
                    u32x2 w1, w2; w1.x = cvt_pk_bf16(x1[0], x1[1]); w1.y = cvt_pk_bf16(x1[2], x1[3]); w2.x = cvt_pk_bf16(x2[0], x2[1]); w2.y = cvt_pk_bf16(x2[2], x2[3]);
                    *(u32x2*)(Q + (size_t)row * 768 + c0 + 4 * fq) = w1; *(u32x2*)(Q + (size_t)row * 768 + c0 + 16 + 4 * fq) = w2;
                }
            }
        return true;
    }
};

struct EpiKV {
    static constexpr bool PERM = true;
    bf16_t *KN, *V; const float* sskv;
    __device__ __forceinline__ bool operator()(f32x4 (&acc)[2][2][4][2], const Unit& u, int wr, int wc, int fr, int fq) const {
        asm volatile("" : "+v"(fr), "+v"(fq));
        float rsv[2][4];
#pragma unroll
        for (int ai = 0; ai < 2; ++ai)
#pragma unroll
            for (int m = 0; m < 4; ++m) rsv[ai][m] = sum_slots8(sskv + (size_t)EPI_ROW(ai, m) * 8);
#pragma unroll
        for (int ai = 0; ai < 2; ++ai)
#pragma unroll
            for (int m = 0; m < 4; ++m) {
                const int row = EPI_ROW(ai, m);
                const float rs = rsqrtf(rsv[ai][m] * (1.0f / 256.0f) + EPS);
#pragma unroll
                for (int bj = 0; bj < 2; ++bj) {
                    const int head = u.pn * 2 + bj; const int j = wc * 32 + fq * 8;
                    const u32x4 w = pack8(acc[ai][bj][m][0] * rs, acc[ai][bj][m][1] * rs);
                    if (wc < 2) *(u32x4*)(KN + (size_t)row * 512 + head * 64 + j) = w;
                    else        *(u32x4*)(V + (size_t)row * 512 + head * 64 + (j - 64)) = w;
                }
            }
        return true;
    }
};

struct EpiMerge {
    static constexpr bool PERM = true;
    const bf16_t* G; const float* bc; bf16_t* OUT;
    __device__ __forceinline__ bool operator()(f32x4 (&acc)[2][2][4][2], const Unit& u, int wr, int wc, int fr, int fq) const {
        asm volatile("" : "+v"(fr), "+v"(fq));
        const int seg = u.seg;
        const int colb = u.pn * BM + wc * 32 + fq * 8;
#pragma unroll
        for (int ai = 0; ai < 2; ++ai)
#pragma unroll
        for (int mh = 0; mh < 2; ++mh) {
            u32x4 ga[2][2], gb[2][2];
#pragma unroll
            for (int mm = 0; mm < 2; ++mm)
#pragma unroll
                for (int bj = 0; bj < 2; ++bj) {
                    const bf16_t* gp = G + (size_t)EPI_ROW(ai, 2 * mh + mm) * 3072 + seg * 1024 + colb + bj * HALF;
                    ga[mm][bj] = *(const u32x4*)gp;
                    gb[mm][bj] = (seg < 2) ? *(const u32x4*)(gp + 1024) : ga[mm][bj];
                }
            if (seg < 2) {
#pragma unroll
                for (int mm = 0; mm < 2; ++mm)
#pragma unroll
                    for (int bj = 0; bj < 2; ++bj) {
                        const int m = 2 * mh + mm; const u32x4 a = ga[mm][bj], b = gb[mm][bj];
                        const f32x4 r0 = {bflo(a.x) * __builtin_amdgcn_rcpf(bflo(b.x)), bfhi(a.x) * __builtin_amdgcn_rcpf(bfhi(b.x)), bflo(a.y) * __builtin_amdgcn_rcpf(bflo(b.y)), bfhi(a.y) * __builtin_amdgcn_rcpf(bfhi(b.y))};
                        const f32x4 r1 = {bflo(a.z) * __builtin_amdgcn_rcpf(bflo(b.z)), bfhi(a.z) * __builtin_amdgcn_rcpf(bfhi(b.z)), bflo(a.w) * __builtin_amdgcn_rcpf(bflo(b.w)), bfhi(a.w) * __builtin_amdgcn_rcpf(bfhi(b.w))};
                        acc[ai][bj][m][0] *= r0; acc[ai][bj][m][1] *= r1;
                    }
            } else {
#pragma unroll
                for (int bj = 0; bj < 2; ++bj) {
                    const f32x4 c0 = *(const f32x4*)(bc + colb + bj * HALF), c1 = *(const f32x4*)(bc + colb + bj * HALF + 4);
#pragma unroll
                    for (int mm = 0; mm < 2; ++mm) {
                        const int m = 2 * mh + mm; const u32x4 a = ga[mm][bj];
                        const f32x4 a0 = {bflo(a.x), bfhi(a.x), bflo(a.y), bfhi(a.y)}, a1 = {bflo(a.z), bfhi(a.z), bflo(a.w), bfhi(a.w)};
                        *(u32x4*)(OUT + (size_t)EPI_ROW(ai, m) * DM + colb + bj * HALF) = pack8((acc[ai][bj][m][0] + c0) * a0, (acc[ai][bj][m][1] + c1) * a1);
                    }
                }
            }
            asm volatile("" ::: "memory");
        }
        return seg == 2;
    }
};
}

namespace att {
__device__ __forceinline__ int crow(int r, int hi) { return (r & 3) + 8 * (r >> 2) + 4 * hi; }
constexpr int KSLOT = 12288, VSLOT = 8192;
constexpr int L_K = 0, L_V = 2 * KSLOT, L_WS = L_V + 2 * VSLOT, L_OST = L_WS + 2048, L_END = L_OST + 8 * 4096;

__device__ __forceinline__ float hmax(float m) { auto rr = __builtin_amdgcn_permlane32_swap(__float_as_uint(m), __float_as_uint(m), false, false); return fmaxf(__uint_as_float(rr[0]), __uint_as_float(rr[1])); }
__device__ __forceinline__ float hsum(float m) { auto rr = __builtin_amdgcn_permlane32_swap(__float_as_uint(m), __float_as_uint(m), false, false); return __uint_as_float(rr[0]) + __uint_as_float(rr[1]); }

__device__ __forceinline__ void pv(f32x16* o, unsigned vb, bf16x8 pa0, bf16x8 pa1, bf16x8 pa2, bf16x8 pa3) {
    s16x4 lo[2][4], hi[2][4];
#pragma unroll
    for (int d0 = 0; d0 < 2; ++d0)
#pragma unroll
        for (int ks = 0; ks < 4; ++ks) {
            asm volatile("ds_read_b64_tr_b16 %0,%1 offset:%c2" : "=&v"(lo[d0][ks]) : "v"(vb), "i"(d0 * 4096 + ks * 1024) : "memory");
            asm volatile("ds_read_b64_tr_b16 %0,%1 offset:%c2" : "=&v"(hi[d0][ks]) : "v"(vb), "i"(d0 * 4096 + ks * 1024 + 512) : "memory"); }
#define PK(d, k) (bf16x8){lo[d][k][0], lo[d][k][1], lo[d][k][2], lo[d][k][3], hi[d][k][0], hi[d][k][1], hi[d][k][2], hi[d][k][3]}
    asm volatile("s_waitcnt lgkmcnt(8)" ::: "memory"); __builtin_amdgcn_sched_barrier(0);
    o[0] = __builtin_amdgcn_mfma_f32_32x32x16_bf16(pa0, PK(0, 0), o[0], 0, 0, 0);
    o[0] = __builtin_amdgcn_mfma_f32_32x32x16_bf16(pa1, PK(0, 1), o[0], 0, 0, 0);
    o[0] = __builtin_amdgcn_mfma_f32_32x32x16_bf16(pa2, PK(0, 2), o[0], 0, 0, 0);
    o[0] = __builtin_amdgcn_mfma_f32_32x32x16_bf16(pa3, PK(0, 3), o[0], 0, 0, 0);
    asm volatile("s_waitcnt lgkmcnt(0)" ::: "memory"); __builtin_amdgcn_sched_barrier(0);
    o[1] = __builtin_amdgcn_mfma_f32_32x32x16_bf16(pa0, PK(1, 0), o[1], 0, 0, 0);
    o[1] = __builtin_amdgcn_mfma_f32_32x32x16_bf16(pa1, PK(1, 1), o[1], 0, 0, 0);
    o[1] = __builtin_amdgcn_mfma_f32_32x32x16_bf16(pa2, PK(1, 2), o[1], 0, 0, 0);
    o[1] = __builtin_amdgcn_mfma_f32_32x32x16_bf16(pa3, PK(1, 3), o[1], 0, 0, 0);
#undef PK
}

__device__ __forceinline__ void attn_block(int b, int h, int qb, const bf16_t* Q, const bf16_t* KN, const bf16_t* KR, const bf16_t* V, bf16_t* O, LAS unsigned char* lds) {
    int tid_ = threadIdx.x; asm volatile("" : "+v"(tid_));
    const int tid = tid_, lane = tid & 63, r32 = lane & 31, hi = lane >> 5;
    const int wid = __builtin_amdgcn_readfirstlane(tid >> 6);
    const size_t rowbase = (size_t)b * SEQ; const int q0 = qb * 256;
    const bf16_t* Qw = Q + (rowbase + q0 + wid * 32 + r32) * 768 + h * 96;
    bf16x8 qr[6];
#pragma unroll
    for (int d0 = 0; d0 < 6; ++d0) qr[d0] = *(const bf16x8*)(Qw + d0 * 16 + hi * 8);
    const int NT = 4 * qb + 4;
    const bf16_t* kg = KN + (rowbase + lane) * 512 + h * 64 + wid * 8;
    const bf16_t* krg = KR + (rowbase + lane) * 32 + (wid & 3) * 8;
    const bf16_t* vg = V + (rowbase + 16 * (wid & 3) + (lane >> 2)) * 512 + h * 64 + (wid >> 2) * 32 + (lane & 3) * 8;
    const int kdst = L_K + wid * 1024 + lane * 16, krdst = L_K + (8 + (wid & 3)) * 1024 + lane * 16, vdst = L_V + wid * 1024 + lane * 16;
    unsigned z0_ = 0u; asm volatile("" : "+v"(z0_)); u32x4 kreg, krreg = {z0_, z0_, z0_, z0_}, vreg;
    kreg = *(const u32x4*)kg; if (wid < 4) krreg = *(const u32x4*)krg; vreg = *(const u32x4*)vg;
    *(LAS u32x4*)(lds + kdst) = kreg; if (wid < 4) *(LAS u32x4*)(lds + krdst) = krreg; *(LAS u32x4*)(lds + vdst) = vreg;
    __syncthreads();
    float mrun = -INFINITY, lrun = 0.f; f32x16 o[2];
#pragma unroll
    for (int r = 0; r < 16; ++r) { o[0][r] = 0.f; o[1][r] = 0.f; }
    LAS float* wsf = (LAS float*)(lds + L_WS) + wid * 64;
    const int qabs = q0 + wid * 32 + r32;
    const unsigned vbl = (unsigned)(uintptr_t)(lds + L_V) + ((lane >> 4) & 1) * 32 + (lane & 3) * 8 + (4 * hi + ((lane & 15) >> 2)) * 64;
    for (int t = 0; t < NT; ++t) {
        const int cur = t & 1;
        if (t + 1 < NT) { const size_t adv = (size_t)(t + 1) * 64; kreg = *(const u32x4*)(kg + adv * 512); if (wid < 4) krreg = *(const u32x4*)(krg + adv * 32); vreg = *(const u32x4*)(vg + adv * 512); }
        const int jb = t - 4 * qb;
        if (jb <= (wid >> 1)) {
            f32x16 p0, p1;
#pragma unroll
            for (int r = 0; r < 16; ++r) { p0[r] = 0.f; p1[r] = 0.f; }
            const LAS unsigned char* kb = lds + L_K + cur * KSLOT + hi * 1024 + r32 * 16;
            bf16x8 kf[12];
#pragma unroll
            for (int d0 = 0; d0 < 6; ++d0) { kf[2 * d0] = *(const LAS bf16x8*)(kb + d0 * 2048); kf[2 * d0 + 1] = *(const LAS bf16x8*)(kb + d0 * 2048 + 512); }
            __builtin_amdgcn_sched_barrier(0);
#pragma unroll
            for (int d0 = 0; d0 < 6; ++d0) {
                p0 = __builtin_amdgcn_mfma_f32_32x32x16_bf16(kf[2 * d0], qr[d0], p0, 0, 0, 0);
                p1 = __builtin_amdgcn_mfma_f32_32x32x16_bf16(kf[2 * d0 + 1], qr[d0], p1, 0, 0, 0);
            }
            if (jb == (wid >> 1)) {
                const int kbase = 64 * t + 4 * hi;
#pragma unroll
                for (int r = 0; r < 16; ++r) { const int kv = kbase + (r & 3) + 8 * (r >> 2); if (kv > qabs) p0[r] = -INFINITY; if (kv + 32 > qabs) p1[r] = -INFINITY; }
            }
            float rm = fmaxf(p0[0], p1[0]);
#pragma unroll
            for (int r = 1; r < 16; ++r) rm = fmaxf(rm, fmaxf(p0[r], p1[r]));
            rm = hmax(rm);
            if (__any(rm > mrun + 8.0f)) {
                const float mn = fmaxf(mrun, rm);
                const float alpha = __builtin_amdgcn_exp2f(mrun - mn);
                mrun = mn; lrun *= alpha;
                if (hi == 0) wsf[r32] = alpha;
                asm volatile("s_waitcnt lgkmcnt(0)" ::: "memory");
#pragma unroll
                for (int r = 0; r < 16; ++r) { const float a = wsf[crow(r, hi)]; o[0][r] *= a; o[1][r] *= a; }
            }
            float sum = 0.f;
#pragma unroll
            for (int r = 0; r < 16; ++r) { p0[r] = __builtin_amdgcn_exp2f(p0[r] - mrun); p1[r] = __builtin_amdgcn_exp2f(p1[r] - mrun); sum += p0[r] + p1[r]; }
            lrun += sum;
            u32x4 pw0, pw1, pw2, pw3;
            pw0 = (u32x4){cvt_pk_bf16(p0[0], p0[1]), cvt_pk_bf16(p0[2], p0[3]), cvt_pk_bf16(p0[4], p0[5]), cvt_pk_bf16(p0[6], p0[7])};
            pw1 = (u32x4){cvt_pk_bf16(p0[8], p0[9]), cvt_pk_bf16(p0[10], p0[11]), cvt_pk_bf16(p0[12], p0[13]), cvt_pk_bf16(p0[14], p0[15])};
            pw2 = (u32x4){cvt_pk_bf16(p1[0], p1[1]), cvt_pk_bf16(p1[2], p1[3]), cvt_pk_bf16(p1[4], p1[5]), cvt_pk_bf16(p1[6], p1[7])};
            pw3 = (u32x4){cvt_pk_bf16(p1[8], p1[9]), cvt_pk_bf16(p1[10], p1[11]), cvt_pk_bf16(p1[12], p1[13]), cvt_pk_bf16(p1[14], p1[15])};
            pv(o, vbl + cur * VSLOT, __builtin_bit_cast(bf16x8, pw0), __builtin_bit_cast(bf16x8, pw1), __builtin_bit_cast(bf16x8, pw2), __builtin_bit_cast(bf16x8, pw3));
        }
        if (t + 1 < NT) { const int nb = (cur ^ 1); *(LAS u32x4*)(lds + kdst + nb * KSLOT) = kreg; if (wid < 4) *(LAS u32x4*)(lds + krdst + nb * KSLOT) = krreg; *(LAS u32x4*)(lds + vdst + nb * VSLOT) = vreg; }
        __syncthreads();
    }
    lrun = hsum(lrun);
    if (hi == 0) wsf[32 + r32] = lrun;
    asm volatile("s_waitcnt lgkmcnt(0)" ::: "memory");
    float rli[16];
#pragma unroll
    for (int r = 0; r < 16; ++r) rli[r] = __builtin_amdgcn_rcpf(wsf[32 + crow(r, hi)]);
    bf16_t* Ow = O + (rowbase + q0 + wid * 32) * 512 + h * 64;
    LAS bf16_t* stg = (LAS bf16_t*)(lds + L_OST) + wid * 2048;
#pragma unroll
    for (int r = 0; r < 16; ++r) { const int orow = crow(r, hi);
#pragma unroll
        for (int d0 = 0; d0 < 2; ++d0) stg[orow * 64 + d0 * 32 + r32] = f2bf(o[d0][r] * rli[r]); }
    asm volatile("s_waitcnt lgkmcnt(0)" ::: "memory");
#pragma unroll
    for (int i = 0; i < 4; ++i) { const int row = i * 8 + (lane >> 3), ch = lane & 7; const u32x4 v = *(const LAS u32x4*)(stg + row * 64 + ch * 8); *(u32x4*)(Ow + (size_t)row * 512 + ch * 8) = v; }
    __syncthreads();
}
}

namespace lru {
constexpr int XS_STRIDE = 144;
constexpr int L_XS = 0, L_BM = 74240, L_CW = L_BM + 24576, L_CB = L_CW + 1024, L_AGG = L_CB + 256, L_PRE = L_AGG + 4096, L_CIN = L_PRE + 4096, L_END = L_CIN + 128;
__device__ __forceinline__ void lru_unit(int u, int layer, const bf16_t* XPRE, bf16_t* GG, const float* conv_w, const float* conv_b, const float* wgate, const float* bgate, const float* lam,
                                         unsigned* flags, float* carry, LAS unsigned char* lds) {
    int tid_ = threadIdx.x; asm volatile("" : "+v"(tid_));
    const int tid = tid_, lane = tid & 63, r32 = lane & 31, hi = lane >> 5;
    const int wid = __builtin_amdgcn_readfirstlane(tid >> 6);
    const int ck = u >> 6, bh = u & 63, b = bh >> 3, h = bh & 7, s0 = ck * 512;
    LAS float* CW = (LAS float*)(lds + L_CW); LAS float* CB = (LAS float*)(lds + L_CB);
    LAS f32x2* AGG = (LAS f32x2*)(lds + L_AGG); LAS f32x2* PRE = (LAS f32x2*)(lds + L_PRE); LAS float* CIN = (LAS float*)(lds + L_CIN);
    if (tid < 256) CW[tid] = conv_w[(tid >> 6) * 512 + h * 64 + (tid & 63)];
    else if (tid < 320) CB[tid - 256] = conv_b[h * 64 + (tid - 256)];
    for (int f = tid; f < 1536; f += 512) {
        const int l = f & 63, g = f >> 6, kc = g & 3, nt = g >> 2, n = l & 31, hh = l >> 5, col = 32 * nt + n, d0 = 16 * kc + 8 * hh;
        float v[8];
#pragma unroll
        for (int i = 0; i < 8; ++i) v[i] = (nt < 4) ? wgate[(size_t)h * 8192 + (d0 + i) * 128 + col] : ((d0 + i) == (col - 128) ? 1.0f : 0.0f);
        *(LAS u32x4*)(lds + L_BM + g * 1024 + l * 16) = (u32x4){cvt_pk_bf16(v[0], v[1]), cvt_pk_bf16(v[2], v[3]), cvt_pk_bf16(v[4], v[5]), cvt_pk_bf16(v[6], v[7])};
    }
    unsigned z0_ = 0u; asm volatile("" : "+v"(z0_));
    { u32x4 st[9];
#pragma unroll
      for (int k = 0; k < 9; ++k) { const int i = (tid >> 3) + 64 * k, s = s0 - 3 + i; st[k] = (u32x4){z0_, z0_, z0_, z0_};
          if (i < 515 && s >= 0) st[k] = *(const u32x4*)(XPRE + ((size_t)b * SEQ + s) * 512 + h * 64 + (tid & 7) * 8); }
#pragma unroll
      for (int k = 0; k < 9; ++k) { const int i = (tid >> 3) + 64 * k; if (i < 515) *(LAS u32x4*)(lds + L_XS + i * XS_STRIDE + (tid & 7) * 16) = st[k]; } }
    __syncthreads();
    bf16x8 afr[2][4];
#pragma unroll
    for (int kc = 0; kc < 4; ++kc) {
        const int d0 = 16 * kc + 8 * hi;
        f32x4 w0[4], w1[4];
#pragma unroll
        for (int j = 0; j < 4; ++j) { w0[j] = *(const LAS f32x4*)(CW + j * 64 + d0); w1[j] = *(const LAS f32x4*)(CW + j * 64 + d0 + 4); }
        const f32x4 cb0 = *(const LAS f32x4*)(CB + d0), cb1 = *(const LAS f32x4*)(CB + d0 + 4);
#pragma unroll
        for (int mt = 0; mt < 2; ++mt) {
            const int sl = wid * 64 + mt * 32 + r32;
            f32x4 xa0 = cb0, xa1 = cb1;
#pragma unroll
            for (int j = 0; j < 4; ++j) {
                const u32x4 xv = *(const LAS u32x4*)(lds + L_XS + (sl + j) * XS_STRIDE + d0 * 2);
                xa0 += w0[j] * (f32x4){bflo(xv.x), bfhi(xv.x), bflo(xv.y), bfhi(xv.y)};
                xa1 += w1[j] * (f32x4){bflo(xv.z), bfhi(xv.z), bflo(xv.w), bfhi(xv.w)};
            }
            afr[mt][kc] = __builtin_bit_cast(bf16x8, (u32x4){cvt_pk_bf16(xa0[0], xa0[1]), cvt_pk_bf16(xa0[2], xa0[3]), cvt_pk_bf16(xa1[0], xa1[1]), cvt_pk_bf16(xa1[2], xa1[3])});
        }
    }
    __syncthreads();
    { u32x4 st[8];
#pragma unroll
      for (int k = 0; k < 8; ++k) st[k] = *(const u32x4*)(GG + ((size_t)b * SEQ + s0 + (tid >> 3) + 64 * k) * 512 + h * 64 + (tid & 7) * 8);
#pragma unroll
      for (int k = 0; k < 8; ++k) *(LAS u32x4*)(lds + L_XS + ((tid >> 3) + 64 * k) * XS_STRIDE + (tid & 7) * 16) = st[k]; }
    const int fbase = layer * 256;
#pragma unroll 1
    for (int ct = 0; ct < 2; ++ct) {
        const int c = 32 * ct + r32;
        const float spc = 8.0f * log1pf(expf(-lam[h * 64 + c]));
        const float br = bgate[h * 128 + c], bi = bgate[h * 128 + 64 + c];
        float hq[2][16], ac[2][16];
#pragma unroll
        for (int mt = 0; mt < 2; ++mt) {
            f32x16 R, I, X;
#pragma unroll
            for (int r = 0; r < 16; ++r) { R[r] = br; I[r] = bi; X[r] = 0.f; }
#pragma unroll
            for (int kc = 0; kc < 4; ++kc) {
                const bf16x8 b0 = *(const LAS bf16x8*)(lds + L_BM + ((ct) * 4 + kc) * 1024 + lane * 16);
                const bf16x8 b1 = *(const LAS bf16x8*)(lds + L_BM + ((2 + ct) * 4 + kc) * 1024 + lane * 16);
                const bf16x8 b2 = *(const LAS bf16x8*)(lds + L_BM + ((4 + ct) * 4 + kc) * 1024 + lane * 16);
                R = __builtin_amdgcn_mfma_f32_32x32x16_bf16(afr[mt][kc], b0, R, 0, 0, 0);
                I = __builtin_amdgcn_mfma_f32_32x32x16_bf16(afr[mt][kc], b1, I, 0, 0, 0);
                X = __builtin_amdgcn_mfma_f32_32x32x16_bf16(afr[mt][kc], b2, X, 0, 0, 0);
            }
            float Ar[4], Hr[4];
#pragma unroll
            for (int q = 0; q < 4; ++q) { float A = 1.f, H = 0.f;
#pragma unroll
                for (int k = 0; k < 4; ++k) { const int r = 4 * q + k;
                    const float rg = fast_sigmoid(R[r]), ig = fast_sigmoid(I[r]);
                    const float la = -rg * spc;
                    const float a = __builtin_amdgcn_exp2f(la * 1.4426950408889634f);
                    const float x2 = 2.0f * la;
                    float om = -x2 * (1.0f + x2 * (0.5f + x2 * (0.16666667f + x2 * (0.041666668f + x2 * (0.0083333338f + x2 * 0.0013888889f)))));
                    if (__builtin_expect(__any(x2 <= -0.25f), 0)) om = (x2 > -0.25f) ? om : (1.0f - a * a);
                    const float uu = __builtin_amdgcn_sqrtf(fmaxf(om, 0.f)) * (ig * X[r]);
                    H = a * H + uu; A *= a; ac[mt][r] = A; hq[mt][r] = H; }
                Ar[q] = A; Hr[q] = H; }
            float pA[4], pH[4];
#pragma unroll
            for (int q = 0; q < 4; ++q) { pA[q] = __shfl_xor(Ar[q], 32); pH[q] = __shfl_xor(Hr[q], 32); }
            float A = 1.f, H = 0.f;
#pragma unroll
            for (int q = 0; q < 4; ++q) {
                const float A0 = hi ? pA[q] : Ar[q], H0 = hi ? pH[q] : Hr[q], A1 = hi ? Ar[q] : pA[q], H1 = hi ? Hr[q] : pH[q];
                const float Hm = A0 * H + H0, Am = A * A0;
                const float cA = hi ? Am : A, cH = hi ? Hm : H;
#pragma unroll
                for (int k = 0; k < 4; ++k) { const int r = 4 * q + k; hq[mt][r] += ac[mt][r] * cH; ac[mt][r] *= cA; }
                H = A1 * Hm + H1; A = Am * A1;
            }
            if (hi == 0) AGG[(2 * wid + mt) * 32 + r32] = (f32x2){A, H};
            __builtin_amdgcn_sched_barrier(0);
        }
        __syncthreads();
        if (wid == 0 && lane < 32) {
            float A = 1.f, H = 0.f;
#pragma unroll
            for (int t = 0; t < 16; ++t) { PRE[t * 32 + lane] = (f32x2){A, H}; const f32x2 g = AGG[t * 32 + lane]; H = g.x * H + g.y; A *= g.x; }
            if (ck < 3) {
                __hip_atomic_store(carry + ((size_t)u * 64 + c) * 2, A, __ATOMIC_RELAXED, __HIP_MEMORY_SCOPE_AGENT);
                __hip_atomic_store(carry + ((size_t)u * 64 + c) * 2 + 1, H, __ATOMIC_RELAXED, __HIP_MEMORY_SCOPE_AGENT);
                asm volatile("s_waitcnt vmcnt(0)" ::: "memory");
                if (lane == 0) __hip_atomic_store(flags + (size_t)(fbase + u) * 2 + ct, 1u, __ATOMIC_RELEASE, __HIP_MEMORY_SCOPE_AGENT);
            }
            float cin = 0.f;
            for (int j = 0; j < ck; ++j) {
                const int uj = j * 64 + bh;
                unsigned* fp = flags + (size_t)(fbase + uj) * 2 + ct; unsigned sp = 0;
                while (__hip_atomic_load(fp, __ATOMIC_RELAXED, __HIP_MEMORY_SCOPE_AGENT) == 0u) { __builtin_amdgcn_s_sleep(2); if (++sp > (1u << 22)) break; }
                __builtin_amdgcn_fence(__ATOMIC_ACQUIRE, "agent");
                const float Aj = __hip_atomic_load(carry + ((size_t)uj * 64 + c) * 2, __ATOMIC_RELAXED, __HIP_MEMORY_SCOPE_AGENT);
                const float Hj = __hip_atomic_load(carry + ((size_t)uj * 64 + c) * 2 + 1, __ATOMIC_RELAXED, __HIP_MEMORY_SCOPE_AGENT);
                cin = Aj * cin + Hj;
            }
            CIN[lane] = cin;
        }
        __syncthreads();
        {
            const float cinc = CIN[r32];
#pragma unroll
            for (int mt = 0; mt < 2; ++mt) {
                const f32x2 p = PRE[(2 * wid + mt) * 32 + r32];
                const float cint = p.y + p.x * cinc;
                LAS bf16_t* gp = (LAS bf16_t*)(lds + L_XS + (wid * 64 + mt * 32) * XS_STRIDE) + c;
#pragma unroll
                for (int r = 0; r < 16; ++r) { LAS bf16_t* q = gp + att::crow(r, hi) * (XS_STRIDE / 2); const float hv = hq[mt][r] + ac[mt][r] * cint; *q = f2bf(hv * bf2f(*q)); }
            }
        }
    }
    __syncthreads();
    for (int i = tid >> 3; i < 512; i += 64)
        *(u32x4*)(GG + ((size_t)b * SEQ + s0 + i) * 512 + h * 64 + (tid & 7) * 8) = *(const LAS u32x4*)(lds + L_XS + i * XS_STRIDE + (tid & 7) * 16);
    __syncthreads();
}
}

namespace cv {
constexpr int L_XS = 0, L_YB = 63488, YB_STRIDE = 516, L_END = L_YB + 32 * YB_STRIDE * 4;
__device__ __forceinline__ void conv_unit(int u, const bf16_t* PC, bf16_t* AC, const float* dw_w, const float* dw_b, const float* ln_g, const float* ln_b,
                                          const bf16_t* KPE, bf16_t* KR, const float* CS, LAS unsigned char* lds) {
    int tid_ = threadIdx.x; asm volatile("" : "+v"(tid_));
    const int tid = tid_, lane = tid & 63;
    const int wid = __builtin_amdgcn_readfirstlane(tid >> 6);
    const int m0 = u * 32, b = m0 >> 11, s0 = m0 & 2047;
    unsigned z0_ = 0u; asm volatile("" : "+v"(z0_));
    { u32x4 st[8];
#pragma unroll
      for (int k = 0; k < 8; ++k) { const int i = (tid >> 6) + 8 * k, s = s0 - 30 + i; st[k] = (u32x4){z0_, z0_, z0_, z0_};
          if (i < 62 && s >= 0) st[k] = *(const u32x4*)(PC + ((size_t)b * SEQ + s) * 512 + (tid & 63) * 8); }
#pragma unroll
      for (int k = 0; k < 8; ++k) { const int i = (tid >> 6) + 8 * k; if (i < 62) *(LAS u32x4*)(lds + L_XS + i * 1024 + (tid & 63) * 16) = st[k]; } }
    { const int tok = tid >> 4, j = tid & 15; const size_t m = (size_t)m0 + tok;
      const float x1 = bf2f(KPE[m * 32 + j]), x2 = bf2f(KPE[m * 32 + 16 + j]); const float cs = CS[m * 32 + j], sn = CS[m * 32 + 16 + j];
      KR[m * 32 + j] = f2bf(x1 * cs - x2 * sn); KR[m * 32 + 16 + j] = f2bf(x2 * cs + x1 * sn); }
    __syncthreads();
    {
        const int ch = tid;
        float w[31];
#pragma unroll
        for (int j = 0; j < 31; ++j) w[j] = dw_w[j * 512 + ch];
        const float bias = dw_b[ch];
        const LAS bf16_t* xs = (const LAS bf16_t*)(lds + L_XS) + ch;
        LAS float* YB = (LAS float*)(lds + L_YB);
#pragma unroll 1
        for (int g = 0; g < 4; ++g) {
            float x[38];
#pragma unroll
            for (int k = 0; k < 38; ++k) x[k] = bf2f(xs[(8 * g + k) * 512]);
#pragma unroll
            for (int o = 0; o < 8; ++o) { float y = bias;
#pragma unroll
                for (int j = 0; j < 31; ++j) y += w[j] * x[o + j];
                YB[(8 * g + o) * YB_STRIDE + ch] = y; }
        }
    }
    __syncthreads();
    {
        const LAS float* YB = (const LAS float*)(lds + L_YB);
        const f32x4 g0 = *(const f32x4*)(ln_g + lane * 8), g1 = *(const f32x4*)(ln_g + lane * 8 + 4), b0 = *(const f32x4*)(ln_b + lane * 8), b1 = *(const f32x4*)(ln_b + lane * 8 + 4);
#pragma unroll
        for (int k = 0; k < 4; ++k) {
            const int tok = wid * 4 + k;
            f32x4 a = *(const LAS f32x4*)(YB + tok * YB_STRIDE + lane * 8), c = *(const LAS f32x4*)(YB + tok * YB_STRIDE + lane * 8 + 4);
            const float mean = wave_sum((a[0] + a[1]) + (a[2] + a[3]) + (c[0] + c[1]) + (c[2] + c[3])) * (1.0f / 512.0f);
            a = a - mean; c = c - mean;
            const float var = wave_sum((a[0] * a[0] + a[1] * a[1]) + (a[2] * a[2] + a[3] * a[3]) + (c[0] * c[0] + c[1] * c[1]) + (c[2] * c[2] + c[3] * c[3])) * (1.0f / 512.0f);
            const float rstd = rsqrtf(var + EPS);
            a = a * rstd * g0 + b0; c = c * rstd * g1 + b1;
#pragma unroll
            for (int i = 0; i < 4; ++i) { a[i] = a[i] * fast_sigmoid(a[i]); c[i] = c[i] * fast_sigmoid(c[i]); }
            *(u32x4*)(AC + ((size_t)m0 + tok) * 512 + lane * 8) = pg8::pack8(a, c);
        }
    }
    __syncthreads();
}
}

#define XB_TMO      128
#define XB_XCNT(j)  (256  + 64 * (j))
#define XB_XSUB(j)  (1280 + 64 * (j))
#define XB_XGEN(j)  (2304 + 64 * (j))
#define XB_TOP      3328
#define XB_TOPGEN   3392
#define XCD_BAR_WORDS 3456
#define XB_SPIN_CAP (1u << 18)
__device__ __forceinline__ unsigned xb_ld(unsigned* p)              { return __hip_atomic_load(p, __ATOMIC_RELAXED, __HIP_MEMORY_SCOPE_AGENT); }
__device__ __forceinline__ unsigned xb_add(unsigned* p, unsigned v) { return __hip_atomic_fetch_add(p, v, __ATOMIC_RELAXED, __HIP_MEMORY_SCOPE_AGENT); }
__device__ __forceinline__ unsigned xb_xcc_id() { return (unsigned)__builtin_amdgcn_s_getreg((3 << 11) | 20) & 0xFu; }
#define XB_SPIN(cond, bar) do { unsigned _sp = 0; while (cond) { __builtin_amdgcn_s_sleep(1); \
    if ((++_sp & 255u) == 0u) { if (xb_ld(&(bar)[XB_TMO])) break; if (_sp > XB_SPIN_CAP) { atomicAdd(&(bar)[XB_TMO], 1u); break; } } } } while (0)
struct XcdBarrier { unsigned* bar; unsigned x; volatile LAS unsigned* st; };
__device__ __forceinline__ XcdBarrier xcd_barrier_post(unsigned* bar, volatile LAS unsigned* st) {
    XcdBarrier b; b.bar = bar; b.x = xb_xcc_id(); b.st = st;
    if (threadIdx.x == 0) (void)xb_add(&bar[XB_XCNT(b.x)], 1u);
    return b;
}
__device__ __forceinline__ void xcd_barrier_complete(unsigned* bar, unsigned x, unsigned& nloc, unsigned& nx) {
    const unsigned G = gridDim.x * gridDim.y * gridDim.z;
    unsigned sum, cnt, mine, sp = 0u;
    for (;;) {
        sum = 0u; cnt = 0u; mine = 0u;
#pragma unroll 1
        for (unsigned j = 0; j < 16; ++j) { const unsigned c = xb_ld(&bar[XB_XCNT(j)]); sum += c; cnt += (c > 0u) ? 1u : 0u; mine = (j == x) ? c : mine; }
        if (sum == G) break;
        __builtin_amdgcn_s_sleep(1);
        if ((++sp & 255u) == 0u) { if (xb_ld(&bar[XB_TMO])) break; if (sp > XB_SPIN_CAP) { atomicAdd(&bar[XB_TMO], 1u); break; } }
    }
    nloc = mine > 0u ? mine : 1u; nx = cnt > 0u ? cnt : 1u;
}
__device__ __forceinline__ void xcd_barrier(const XcdBarrier& b) {
    asm volatile("s_waitcnt vmcnt(0)" ::: "memory");
    __syncthreads();
    if (threadIdx.x == 0) {
        unsigned* bar = b.bar; asm volatile("" : "+s"(bar));
        __builtin_amdgcn_s_waitcnt(0);
        unsigned nloc = b.st[0], nx = b.st[1];
        if (nloc == 0u) { xcd_barrier_complete(bar, b.x, nloc, nx); b.st[0] = nloc; b.st[1] = nx; }
        const unsigned old = xb_add(&bar[XB_XSUB(b.x)], 1u);
        const unsigned gen = old / nloc;
        if (old + 1u == (gen + 1u) * nloc) {
            __builtin_amdgcn_fence(__ATOMIC_RELEASE, "agent");
            asm volatile("s_waitcnt vmcnt(0)" ::: "memory");
            const unsigned og = xb_add(&bar[XB_TOP], 1u);
            const unsigned tg = og / nx;
            if (og + 1u == (tg + 1u) * nx) xb_add(&bar[XB_TOPGEN], 1u);
            else XB_SPIN(xb_ld(&bar[XB_TOPGEN]) == tg, bar);
            __builtin_amdgcn_fence(__ATOMIC_ACQUIRE, "agent");
            xb_add(&bar[XB_XGEN(b.x)], 1u);
            asm volatile("s_waitcnt vmcnt(0)" ::: "memory");
        } else {
            XB_SPIN(xb_ld(&bar[XB_XGEN(b.x)]) == gen, bar);
            __builtin_amdgcn_fence(__ATOMIC_ACQUIRE, "agent");
            asm volatile("s_waitcnt vmcnt(0)" ::: "memory");
        }
    }
    __syncthreads();
}

constexpr size_t MiB = 1u << 20;
constexpr size_t WS_SSA = 0, WS_SSB = 1 * MiB, WS_SSQ = 2 * MiB, WS_SSKV = 3 * MiB, WS_BIASP = 3 * MiB + 512 * 1024, WS_BAR = 3 * MiB + 768 * 1024, BAR_ZERO_BYTES = 32768, WS_LFLAG = WS_BAR + 16384, WS_SPLITF = WS_BAR + 24576, WS_LCARRY = WS_BAR + 32768, WS_W = 4 * MiB, WS_XB = 55 * MiB, WS_R1 = 87 * MiB;
constexpr size_t WS_GG = 183 * MiB, WS_AC = 199 * MiB, WS_CQ = 215 * MiB, WS_Q = 227 * MiB, WS_KPE = 251 * MiB, WS_KR = 252 * MiB, WS_CS = 253 * MiB, WS_END = 255 * MiB;
constexpr size_t WS_CKV = WS_W;
constexpr size_t W_F1W1 = 0, W_F1W2 = 11 * MiB, W_F2W1 = 16 * MiB + 512 * 1024, W_F2W2 = 27 * MiB + 512 * 1024, W_IN = 33 * MiB, W_LRUO = 44 * MiB + 512 * 1024,
                 W_UQ = 45 * MiB + 512 * 1024, W_UKV = 46 * MiB + 256 * 1024, W_MLAO = 46 * MiB + 768 * 1024, W_CONVO = 47 * MiB + 768 * 1024, W_OUT = 48 * MiB + 768 * 1024;
constexpr size_t DO_XPRE = 0, DO_PC = 16 * MiB, DO_KN = 32 * MiB, DO_V = 48 * MiB, DO_O = 0, DO_MERGED = 32 * MiB;
constexpr int LDS_BYTES = 147456, LDS_BARST = LDS_BYTES - 64;
static_assert(att::L_END <= LDS_BARST && lru::L_END <= LDS_BARST && cv::L_END <= LDS_BARST && pg8::STAGE_BYTES <= LDS_BARST && XCD_BAR_WORDS * 4 <= BAR_ZERO_BYTES, "LDS / barrier map");
static_assert(att::L_END <= LDS_BYTES && lru::L_END <= LDS_BYTES && cv::L_END <= LDS_BYTES && pg8::STAGE_BYTES <= LDS_BYTES, "LDS");

__device__ const float INVF[16] = {1.0f, 0.5623413251903491f, 0.31622776601683794f, 0.1778279410038923f, 0.1f, 0.05623413251903491f, 0.031622776601683794f, 0.01778279410038923f,
                                   0.01f, 0.005623413251903491f, 0.0031622776601683794f, 0.001778279410038923f, 0.001f, 0.0005623413251903491f, 0.00031622776601683794f, 0.0001778279410038923f};

__device__ __forceinline__ int dest_row(int kind, int n0) {
    if (kind == 1) { if (n0 < FF) return 256 * (n0 / 128) + (n0 % 128); const int n1 = n0 - FF; return 256 * (n1 / 128) + 128 + (n1 % 128); }
    if (kind == 2) {
        if (n0 < 1696) return n0;
        if (n0 < 2208) { const int v = n0 - 1696; return 1792 + 256 * (v / 128) + (v % 128); }
        if (n0 < 2720) { const int v = n0 - 2208; return 1792 + 256 * (v / 128) + 128 + (v % 128); }
        return 2816 + (n0 - 2720);
    }
    return n0;
}
__device__ __forceinline__ void cvt_item(const float* W, int K, int N, bf16_t* WT, int kind, const float* gk, LAS float* scr, int item, int lane) {
    const int nblk = N / 32, kb = item / nblk, nb = item % nblk, k0 = 64 * kb, n0 = 32 * nb;
#pragma unroll 8
    for (int i = 0; i < 32; ++i) { const int kk = 2 * i + (lane >> 5); scr[kk * 33 + (lane & 31)] = W[(size_t)(k0 + kk) * N + n0 + (lane & 31)]; }
    asm volatile("s_waitcnt lgkmcnt(0)" ::: "memory");
    const int c = lane & 7; const int dr = dest_row(kind, n0);
    float gs[8];
#pragma unroll
    for (int i = 0; i < 8; ++i) gs[i] = gk ? gk[k0 + 8 * c + i] : 1.0f;
#pragma unroll
    for (int j = 0; j < 4; ++j) { const int n = (lane >> 3) + 8 * j; const LAS float* s = scr + (8 * c) * 33 + n;
        u32x4 o; o.x = cvt_pk_bf16(s[0 * 33] * gs[0], s[1 * 33] * gs[1]); o.y = cvt_pk_bf16(s[2 * 33] * gs[2], s[3 * 33] * gs[3]); o.z = cvt_pk_bf16(s[4 * 33] * gs[4], s[5 * 33] * gs[5]); o.w = cvt_pk_bf16(s[6 * 33] * gs[6], s[7 * 33] * gs[7]);
        *(u32x4*)(WT + (size_t)(dr + n) * K + k0 + 8 * c) = o; }
    asm volatile("s_waitcnt lgkmcnt(0)" ::: "memory");
}

#ifndef GASQ
#define GASQ __attribute__((address_space(1)))
#endif
__device__ __forceinline__ const float* gptr(const GASQ float* p) { asm volatile("" : "+s"(p)); return (const float*)p; }
struct KArgs { const void* in[30]; float* out; unsigned char* ws; int ph_lo, ph_hi; };

__global__ void __launch_bounds__(512, 2) fwd_kernel(KArgs a) {
    extern __shared__ __attribute__((aligned(16))) unsigned char lds_raw[];
    LAS unsigned char* lds = (LAS unsigned char*)lds_raw;
    cg::grid_group grid = cg::this_grid();
#define OPAQUE_TID int tid_ = threadIdx.x; asm volatile("" : "+v"(tid_)); const int tid = tid_, lane = tid & 63, wave = __builtin_amdgcn_readfirstlane(tid >> 6), gw = bid * 8 + wave;
#define CS ((float*)(ws_ + WS_CS))
#define BIASP ((float*)(ws_ + WS_BIASP))
#define XB ((bf16_t*)(ws_ + WS_XB))
#define HB ((bf16_t*)(ws_ + WS_R1))
#define GB ((bf16_t*)(ws_ + WS_R1))
#define GG ((bf16_t*)(ws_ + WS_GG))
#define AC ((bf16_t*)(ws_ + WS_AC))
#define CQ ((bf16_t*)(ws_ + WS_CQ))
#define CKV ((bf16_t*)(ws_ + WS_CKV))
#define QB ((bf16_t*)(ws_ + WS_Q))
#define KPE ((bf16_t*)(ws_ + WS_KPE))
#define KR ((bf16_t*)(ws_ + WS_KR))
#define XPRE ((bf16_t*)(do_ + DO_XPRE))
#define PC ((bf16_t*)(do_ + DO_PC))
#define KN ((bf16_t*)(do_ + DO_KN))
#define VB ((bf16_t*)(do_ + DO_V))
#define OB ((bf16_t*)(do_ + DO_O))
#define MG ((bf16_t*)(do_ + DO_MERGED))
#define WB (ws_ + WS_W)
    const int lo = a.ph_lo, hi = a.ph_hi;
    int ph = 0;
    if (threadIdx.x < 16) ((LAS unsigned*)(lds + LDS_BARST))[threadIdx.x] = 0u;
    __syncthreads();
    XcdBarrier xbar = xcd_barrier_post((unsigned*)(a.ws + WS_BAR), (volatile LAS unsigned*)(lds + LDS_BARST));
    if (hi < 0) grid.sync();
typedef const float* cfp_t; typedef unsigned char* ucp_t;
#define KAS __attribute__((address_space(4)))
#define GASQ __attribute__((address_space(1)))
#define PHASE_BEGIN if (ph >= lo && ph < hi) { int G = gridDim.x, bid = blockIdx.x; asm volatile("" : "+s"(G), "+s"(bid)); const int NGW = G * 8; (void)NGW;     \
    const KAS void* kp_ = (const KAS void*)__builtin_amdgcn_kernarg_segment_ptr(); asm volatile("" : "+s"(kp_)); \
    GASQ unsigned char* wsg_ = (GASQ unsigned char*)(((const KAS ucp_t*)kp_)[31]); GASQ unsigned char* dog_ = (GASQ unsigned char*)(((const KAS ucp_t*)kp_)[30]); asm volatile("" : "+s"(wsg_), "+s"(dog_)); \
    unsigned char* ws_ = (unsigned char*)wsg_; unsigned char* do_ = (unsigned char*)dog_;
#define PHASE_END   if (ph + 1 < hi) { for (int r_ = 0; r_ < REP_SYNC; ++r_) xcd_barrier(xbar); } } ++ph;
#define INF(i) (gptr((const GASQ float*)(((const KAS cfp_t*)kp_)[i])))

    for (int l = 0; l < 2; ++l) {
        PHASE_BEGIN
        {
            OPAQUE_TID
            LAS float* scr = (LAS float*)(lds + wave * 16384);
            const float* w1a = INF(3) + (size_t)l * DM * 5632; const float* w2a = INF(4) + (size_t)l * FF * DM;
            const float* w1b = INF(27) + (size_t)l * DM * 5632; const float* w2b = INF(28) + (size_t)l * FF * DM;
            const float* win = INF(6) + (size_t)l * DM * DIN;
            constexpr int I_W1 = 16 * 176, I_W2 = 44 * 32, I_IN = 16 * 181, I_LO = 8 * 32, I_UQ = 6 * 24, I_UKV = 4 * 32, I_OUT = 16 * 32;
            constexpr int NITEMS = 2 * I_W1 + 2 * I_W2 + I_IN + 3 * I_LO + I_UQ + I_UKV + I_OUT;
            for (int r_ = 0; r_ < REP_CVT; ++r_)
            for (int it = gw; it < NITEMS; it += NGW) {
                int r = it;
                if (r < I_W1) { cvt_item(w1a, DM, 5632, (bf16_t*)(WB + W_F1W1), 1, INF(2) + l * DM, scr, r, lane); continue; } r -= I_W1;
                if (r < I_W1) { cvt_item(w1b, DM, 5632, (bf16_t*)(WB + W_F2W1), 1, INF(26) + l * DM, scr, r, lane); continue; } r -= I_W1;
                if (r < I_IN) { cvt_item(win, DM, DIN, (bf16_t*)(WB + W_IN), 2, INF(5) + l * DM, scr, r, lane); continue; } r -= I_IN;
                if (r < I_W2) { cvt_item(w2a, FF, DM, (bf16_t*)(WB + W_F1W2), 0, nullptr, scr, r, lane); continue; } r -= I_W2;
                if (r < I_W2) { cvt_item(w2b, FF, DM, (bf16_t*)(WB + W_F2W2), 0, nullptr, scr, r, lane); continue; } r -= I_W2;
                if (r < I_OUT) { cvt_item(INF(25) + (size_t)l * DM * DM, DM, DM, (bf16_t*)(WB + W_OUT), 0, nullptr, scr, r, lane); continue; } r -= I_OUT;
                if (r < I_LO) { cvt_item(INF(13) + (size_t)l * 512 * DM, 512, DM, (bf16_t*)(WB + W_LRUO), 0, nullptr, scr, r, lane); continue; } r -= I_LO;
                if (r < I_LO) { cvt_item(INF(18) + (size_t)l * 512 * DM, 512, DM, (bf16_t*)(WB + W_MLAO), 0, nullptr, scr, r, lane); continue; } r -= I_LO;
                if (r < I_LO) { cvt_item(INF(23) + (size_t)l * 512 * DM, 512, DM, (bf16_t*)(WB + W_CONVO), 0, nullptr, scr, r, lane); continue; } r -= I_LO;
                if (r < I_UQ) { cvt_item(INF(15) + (size_t)l * 384 * 768, 384, 768, (bf16_t*)(WB + W_UQ), 0, INF(14) + l * 384, scr, r, lane); continue; } r -= I_UQ;
                cvt_item(INF(17) + (size_t)l * 256 * 1024, 256, 1024, (bf16_t*)(WB + W_UKV), 0, INF(16) + l * 256, scr, r, lane);
            }
            { u32x4* z = (u32x4*)((bf16_t*)(WB + W_IN) + (size_t)1696 * DM); for (int i = bid * 512 + tid; i < 96 * DM / 8; i += G * 512) { unsigned zz = 0u; asm volatile("" : "+v"(zz)); z[i] = (u32x4){zz, zz, zz, zz}; } }
            if (l == 0) {
                const float* x = INF(0);
                for (int m = gw; m < MROWS; m += NGW) {
                    const f32x4* xr = (const f32x4*)(x + (size_t)m * DM) + lane; float s = 0.f; f32x4 v[4];
#pragma unroll
                    for (int j = 0; j < 4; ++j) { v[j] = xr[64 * j]; s += (v[j][0] * v[j][0] + v[j][1] * v[j][1]) + (v[j][2] * v[j][2] + v[j][3] * v[j][3]); }
                    s = wave_sum(s);
                    u32x2* o8 = (u32x2*)(XB + (size_t)m * DM) + lane;
#pragma unroll
                    for (int j = 0; j < 4; ++j) o8[64 * j] = (u32x2){cvt_pk_bf16(v[j][0], v[j][1]), cvt_pk_bf16(v[j][2], v[j][3])};
                    if (lane < 16) ((float*)(ws_ + WS_SSA))[(size_t)m * 16 + lane] = (lane == 0) ? s : 0.f;
                }
                const int* pos = (const int*)INF(1);
                for (int i = bid * 512 + tid; i < MROWS * 16; i += G * 512) { const int m = i >> 4, j = i & 15;
                    const float ang = (float)pos[m] * INVF[j];
                    double t = (double)ang * 0.15915494309189535; t -= rint(t); const float tf = (float)t;
                    CS[(size_t)m * 32 + j] = __builtin_amdgcn_cosf(tf); CS[(size_t)m * 32 + 16 + j] = __builtin_amdgcn_sinf(tf); }
                for (int i = bid * 512 + tid; i < 2 * DINP; i += G * 512) { const int ll = i / DINP, d = i % DINP; int n = -1;
                    if (d < 1696) n = d; else if (d < 1792) n = -1; else if (d < 2816) { const int t = d - 1792, p = t / 256, r = t % 256; n = (r < 128) ? (1696 + p * 128 + r) : (2208 + p * 128 + (r - 128)); } else n = 2720 + (d - 2816);
                    BIASP[i] = (n >= 0) ? INF(7)[(size_t)ll * DIN + n] : 0.f; }
            }
            __syncthreads();
        }
        PHASE_END

#define SSX(k) ((float*)(ws_ + ((((k) & 1) != 0) ? WS_SSB : WS_SSA)))
#define ss0 SSX(3 * l)
#define ss1 SSX(3 * l + 1)
#define ss2 SSX(3 * l + 2)
#define ss3 SSX(3 * l + 3)
#define ssq ((float*)(ws_ + WS_SSQ))
#define sskv ((float*)(ws_ + WS_SSKV))

        PHASE_BEGIN
#ifndef NO_G1
        for (int r_ = 0; r_ < REP_F1UP; ++r_) { pg8::Gemm g{XB, XB, XB, (bf16_t*)(WB + W_F1W1), nullptr, nullptr, MROWS, 5632, DM, DM}; pg8::StaticOrder S; S.init(MROWS, 5632, G, bid, 1, false);
          pg8::EpiUp E{HB, ss0}; pg8::gemm_phase<pg8::EpiUp, true>(lds, g, S, E);
          pg8::TailOrder T; T.init(MROWS, 5632, G, bid);
          if (T.on) { const int kh = T.half() * 512; pg8::Gemm gt{XB + kh, XB + kh, XB + kh, (bf16_t*)(WB + W_F1W1) + kh, nullptr, nullptr, MROWS, 5632, 512, DM};
              pg8::EpiUpTail Et{HB, ss0, (float*)do_, (unsigned*)(ws_ + WS_SPLITF) + (l * 2 + 0) * 128}; pg8::gemm_phase<pg8::EpiUpTail, true, pg8::TailOrder>(lds, gt, T, Et); } }
#endif
        PHASE_END
        PHASE_BEGIN
#ifndef NO_G2
        { pg8::Gemm g{HB, HB, HB, (bf16_t*)(WB + W_F1W2), nullptr, nullptr, MROWS, DM, FF, FF}; pg8::StaticOrder S; S.init(MROWS, DM, G, bid, 1);
          pg8::EpiRes E{XB, 0.5f, ss1, nullptr}; pg8::gemm_phase<pg8::EpiRes, true>(lds, g, S, E); }
#endif
        PHASE_END
        PHASE_BEGIN
#ifndef NO_G3
        for (int r_ = 0; r_ < REP_WIN; ++r_) { pg8::Gemm g{XB, XB, XB, (bf16_t*)(WB + W_IN), nullptr, nullptr, MROWS, DINP, DM, DM}; pg8::StaticOrder S; S.init(MROWS, DINP, G, bid, 1);
          pg8::EpiWin E{ss1, BIASP + l * DINP, XPRE, GG, CQ, CKV, KPE, PC, GB, ssq, sskv}; pg8::gemm_phase<pg8::EpiWin, true>(lds, g, S, E); }
#endif
        PHASE_END
        PHASE_BEGIN
#ifndef NO_G4
        for (int r_ = 0; r_ < REP_S4G; ++r_) { pg8::Gemm g{CQ, CQ, CQ, (bf16_t*)(WB + W_UQ), nullptr, nullptr, MROWS, 768, 384, 384}; pg8::StaticOrder S; S.init(MROWS, 768, G, bid, 1);
          pg8::EpiQ E{QB, ssq, CS}; pg8::gemm_phase<pg8::EpiQ, true>(lds, g, S, E); }
#endif
#ifndef NO_G4B
        for (int r_ = 0; r_ < REP_S4G; ++r_) { pg8::Gemm g{CKV, CKV, CKV, (bf16_t*)(WB + W_UKV), nullptr, nullptr, MROWS, 1024, 256, 256}; pg8::StaticOrder S; S.init(MROWS, 1024, G, bid, 1);
          pg8::EpiKV E{KN, VB, sskv}; pg8::gemm_phase<pg8::EpiKV, true>(lds, g, S, E); }
#endif
#ifndef NO_LRU
        for (int u = bid; u < 256; u += G)
            lru::lru_unit(u, l, XPRE, GG, INF(8) + l * 4 * 512, INF(9) + l * 512, INF(10) + (size_t)l * 8 * 64 * 128, INF(11) + l * 8 * 128, INF(12) + l * 512, (unsigned*)(ws_ + WS_LFLAG), (float*)(ws_ + WS_LCARRY), lds);
#endif
#ifndef NO_CONV
        for (int r_ = 0; r_ < REP_CONV; ++r_)
        for (int u = bid; u < 512; u += G)
            cv::conv_unit(u, PC, AC, INF(19) + l * 31 * 512, INF(20) + l * 512, INF(21) + l * 512, INF(22) + l * 512, KPE, KR, CS, lds);
#endif
        PHASE_END
        PHASE_BEGIN
#ifndef NO_ATT
        for (int r_ = 0; r_ < REP_ATT; ++r_)
        for (int u = ((G & 7) == 0 ? (bid & 7) * (G >> 3) + (bid >> 3) : bid); u < 256; u += G) { const int bh = u >> 2, s = u & 3;
            att::attn_block(bh >> 3, bh & 7, 7 - s, QB, KN, KR, VB, OB, lds);
            att::attn_block(bh >> 3, bh & 7, s, QB, KN, KR, VB, OB, lds); }
#endif
        PHASE_END
        PHASE_BEGIN
#ifndef NO_G6
        for (int r_ = 0; r_ < REP_MERGE; ++r_) { pg8::Gemm g{GG, OB, AC, (bf16_t*)(WB + W_LRUO), (bf16_t*)(WB + W_MLAO), (bf16_t*)(WB + W_CONVO), MROWS, DM, 512, 512}; pg8::StaticOrder S; S.init(MROWS, DM, G, bid, 3);
          pg8::EpiMerge E{GB, INF(24) + l * DM, MG}; pg8::gemm_phase<pg8::EpiMerge, true>(lds, g, S, E); }
#endif
        PHASE_END
        PHASE_BEGIN
#ifndef NO_G7
        { pg8::Gemm g{MG, MG, MG, (bf16_t*)(WB + W_OUT), nullptr, nullptr, MROWS, DM, DM, DM}; pg8::StaticOrder S; S.init(MROWS, DM, G, bid, 1);
          pg8::EpiRes E{XB, 1.0f, ss2, nullptr}; pg8::gemm_phase<pg8::EpiRes, true>(lds, g, S, E); }
#endif
        PHASE_END
        PHASE_BEGIN
#ifndef NO_G8
        { pg8::Gemm g{XB, XB, XB, (bf16_t*)(WB + W_F2W1), nullptr, nullptr, MROWS, 5632, DM, DM}; pg8::StaticOrder S; S.init(MROWS, 5632, G, bid, 1, false);
          pg8::EpiUp E{HB, ss2}; pg8::gemm_phase<pg8::EpiUp, true>(lds, g, S, E);
          pg8::TailOrder T; T.init(MROWS, 5632, G, bid);
          if (T.on) { const int kh = T.half() * 512; pg8::Gemm gt{XB + kh, XB + kh, XB + kh, (bf16_t*)(WB + W_F2W1) + kh, nullptr, nullptr, MROWS, 5632, 512, DM};
              pg8::EpiUpTail Et{HB, ss2, (float*)do_, (unsigned*)(ws_ + WS_SPLITF) + (l * 2 + 1) * 128}; pg8::gemm_phase<pg8::EpiUpTail, true, pg8::TailOrder>(lds, gt, T, Et); } }
#endif
        PHASE_END
        PHASE_BEGIN
#ifndef NO_G9
        { pg8::Gemm g{HB, HB, HB, (bf16_t*)(WB + W_F2W2), nullptr, nullptr, MROWS, DM, FF, FF}; pg8::StaticOrder S; S.init(MROWS, DM, G, bid, 1);
          pg8::EpiRes E{XB, 0.5f, ss3, (l == 1) ? (float*)do_ : nullptr}; pg8::gemm_phase<pg8::EpiRes, true>(lds, g, S, E); }
#endif
        PHASE_END
    }
    PHASE_BEGIN
    {
        OPAQUE_TID
        const float* ssf = (const float*)(ws_ + WS_SSA); const float* gf = INF(29);
        for (int m = gw; m < MROWS; m += NGW) {
            const float rs = rsqrtf(sum_slots16(ssf + (size_t)m * 16) * (1.0f / DM) + EPS);
            f32x4* xr = (f32x4*)((float*)do_ + (size_t)m * DM) + lane; const f32x4* gr = (const f32x4*)gf + lane;
#pragma unroll
            for (int j = 0; j < 4; ++j) xr[64 * j] = xr[64 * j] * rs * gr[64 * j];
        }
    }
    PHASE_END
}

constexpr int N_PHASES = 21;
#ifndef MK_PER_PHASE
#define MK_PER_PHASE 0
#endif

extern "C" void kernel_launch(void* const* d_in, const int* in_sizes, int n_in, void* d_out, int out_size, void* d_ws, size_t ws_size, hipStream_t stream) {
    static int grid = 0;
    if (grid == 0) {
        if (n_in != 30 || out_size != MROWS * DM || ws_size < WS_END) { fprintf(stderr, "kernel_launch: unexpected problem (n_in %d out %d ws %zu)\n", n_in, out_size, ws_size); grid = -1; return; }
        int dev = 0, cus = 0, per_cu = 0;
        hipGetDevice(&dev); hipDeviceGetAttribute(&cus, hipDeviceAttributeMultiprocessorCount, dev);
        hipFuncSetAttribute((const void*)fwd_kernel, hipFuncAttributeMaxDynamicSharedMemorySize, LDS_BYTES);
        hipOccupancyMaxActiveBlocksPerMultiprocessor(&per_cu, (const void*)fwd_kernel, 512, LDS_BYTES);
        if (per_cu < 1) { fprintf(stderr, "kernel_launch: occupancy query says %d blocks per CU\n", per_cu); per_cu = 1; }
        (void)hipGetLastError();
        grid = cus * 1;
    }
    if (grid < 0) return;
    hipMemsetAsync((char*)d_ws + WS_BAR, 0, BAR_ZERO_BYTES, stream);
    KArgs a{};
    for (int i = 0; i < 30; ++i) a.in[i] = d_in[i];
    a.out = (float*)d_out; a.ws = (unsigned char*)d_ws;
#if MK_PER_PHASE
    for (int p = 0; p < N_PHASES; ++p) { a.ph_lo = p; a.ph_hi = p + 1; hipLaunchKernelGGL(fwd_kernel, dim3(grid), dim3(512), LDS_BYTES, stream, a); }
#else
    a.ph_lo = 0; a.ph_hi = N_PHASES;
    void* args[] = {&a};
    hipError_t e = hipLaunchCooperativeKernel((const void*)fwd_kernel, dim3(grid), dim3(512), args, LDS_BYTES, stream);
    if (e != hipSuccess) fprintf(stderr, "cooperative launch failed: %s (grid %d)\n", hipGetErrorString(e), grid);
#endif
}
```

```cpp
#include <hip/hip_runtime.h>
#include <hip/hip_cooperative_groups.h>
#include <cstdio>
#include <cstdint>
namespace cg = cooperative_groups;

#define LAS __attribute__((address_space(3)))
typedef unsigned short bf16_t;
typedef short bf16x8 __attribute__((ext_vector_type(8)));
typedef short s16x4 __attribute__((ext_vector_type(4)));
typedef float f32x2 __attribute__((ext_vector_type(2)));
typedef float f32x4 __attribute__((ext_vector_type(4)));
typedef float f32x16 __attribute__((ext_vector_type(16)));
typedef unsigned u32x2 __attribute__((ext_vector_type(2)));
typedef unsigned u32x4 __attribute__((ext_vector_type(4)));

#ifndef REP_ATT
#define REP_ATT 1
#endif
#ifndef REP_F1UP
#define REP_F1UP 1
#endif
#ifndef REP_WIN
#define REP_WIN 1
#endif
#ifndef REP_S4G
#define REP_S4G 1
#endif
#ifndef REP_CONV
#define REP_CONV 1
#endif
#ifndef REP_MERGE
#define REP_MERGE 1
#endif
#ifndef REP_SYNC
#define REP_SYNC 1
#endif
#ifndef REP_CVT
#define REP_CVT 1
#endif
#ifndef REP_LRU
#define REP_LRU 1
#endif
constexpr int MROWS = 16384, DM = 1024, FF = 2816, SEQ = 2048, NB = 8;
constexpr int DIN = 5792, DINP = 5888;
constexpr float EPS = 1e-6f;
constexpr float QSCALE = 0.10206207261596577f * 1.4426950408889634f;

__device__ __forceinline__ unsigned cvt_pk_bf16(float lo, float hi) { unsigned r; asm volatile("v_cvt_pk_bf16_f32 %0, %1, %2" : "=v"(r) : "v"(lo), "v"(hi)); return r; }
__device__ __forceinline__ float bflo(unsigned w) { return __uint_as_float(w << 16); }
__device__ __forceinline__ float bfhi(unsigned w) { return __uint_as_float(w & 0xffff0000u); }
__device__ __forceinline__ float bf2f(bf16_t v) { return __uint_as_float(((unsigned)v) << 16); }
__device__ __forceinline__ bf16_t f2bf(float f) { return (bf16_t)(cvt_pk_bf16(f, 0.f) & 0xffffu); }
__device__ __forceinline__ float fast_sigmoid(float x) { return __builtin_amdgcn_rcpf(1.0f + __builtin_amdgcn_exp2f(-1.4426950408889634f * x)); }
__device__ __forceinline__ float wave_sum(float v) {
#pragma unroll
    for (int o = 1; o < 64; o <<= 1) v += __shfl_xor(v, o);
    return v;
}

__device__ __forceinline__ float sum_slots16(const float* p) { const f32x4 a = *(const f32x4*)p, b = *(const f32x4*)(p + 4), c = *(const f32x4*)(p + 8), d = *(const f32x4*)(p + 12);
    return (((a[0] + a[1]) + (a[2] + a[3])) + ((b[0] + b[1]) + (b[2] + b[3]))) + (((c[0] + c[1]) + (c[2] + c[3])) + ((d[0] + d[1]) + (d[2] + d[3]))); }
__device__ __forceinline__ float sum_slots12(const float* p) { const f32x4 a = *(const f32x4*)p, b = *(const f32x4*)(p + 4), c = *(const f32x4*)(p + 8);
    return (((a[0] + a[1]) + (a[2] + a[3])) + ((b[0] + b[1]) + (b[2] + b[3]))) + ((c[0] + c[1]) + (c[2] + c[3])); }
__device__ __forceinline__ float sum_slots8(const float* p) { const f32x4 a = *(const f32x4*)p, b = *(const f32x4*)(p + 4);
    return ((a[0] + a[1]) + (a[2] + a[3])) + ((b[0] + b[1]) + (b[2] + b[3])); }

namespace pg8 {
constexpr int BM = 256, BK = 64, HALF = 128, HTB = HALF * BK * 2, STAGE_BYTES = 8 * HTB, NXCD = 8, WGM = 4;
__host__ __device__ __forceinline__ int lds_byte(int r, int c) { const int st = (r >> 4) * 2 + (c >> 5), rr = r & 15, cc = c & 31, ob = rr * 64 + cc * 2; return st * 1024 + (ob ^ (((ob >> 9) & 1) << 5)); }
__host__ __device__ __forceinline__ void stage_rc(int b, int& R, int& C) { const int st = b / 1024, sb = b % 1024, swz = sb ^ (((sb >> 9) & 1) << 5); R = (st >> 1) * 16 + swz / 64; C = (st & 1) * 32 + (swz % 64) / 2; }
__host__ __device__ __forceinline__ int perm32(int rho) { const int n = rho >> 4, i = rho & 15; return 8 * (i >> 2) + 4 * n + (i & 3); }

struct Unit { int pm, pn, seg, split, slot; };
struct Gemm { const bf16_t *A0, *A1, *A2; const bf16_t *B0, *B1, *B2; int M, N, K, LD;
    __device__ __forceinline__ const char* a(int s) const { return (const char*)(s == 0 ? A0 : (s == 1 ? A1 : A2)); }
    __device__ __forceinline__ const char* b(int s) const { return (const char*)(s == 0 ? B0 : (s == 1 ? B1 : B2)); } };

__device__ __forceinline__ void unit_of(int L, int nwg, int nM, int nN, Unit& u) {
    int wgid = L; { const int q = nwg / NXCD, r = nwg % NXCD, xcd = wgid % NXCD, off = wgid / NXCD; wgid = (xcd < r ? xcd * (q + 1) : r * (q + 1) + (xcd - r) * q) + off; }
    const int nig = WGM * nN, gid = wgid / nig, fm = gid * WGM, gsz = (nM - fm) < WGM ? (nM - fm) : WGM;
    u.pm = fm + ((wgid % nig) % gsz); u.pn = (wgid % nig) / gsz;
}
struct StaticOrder {
    int nM, nN, nwg, G, c, nseg, nlim;
    __device__ __forceinline__ void init(int M, int N, int G_, int c_, int nseg_, bool split_tail = false) { nM = M / BM; nN = N / BM; nwg = nM * nN; G = G_; c = c_; nseg = nseg_;
        nlim = (split_tail && 2 * (nwg % G_) == G_) ? (nwg / G_) * G_ : nwg; }
    __device__ __forceinline__ bool next(int i, Unit& u) const {
        const int ti = i / nseg; u.seg = i - ti * nseg; u.split = 0; u.slot = 0;
        const long L = (long)ti * G + c; if (L >= nlim) return false;
        unit_of((int)L, nwg, nM, nN, u); return true;
    }
};
struct TailOrder {
    int nM, nN, nwg, G, c, on;
    __device__ __forceinline__ void init(int M, int N, int G_, int c_) { nM = M / BM; nN = N / BM; nwg = nM * nN; G = G_; c = c_; on = 0; (void)G_; }
    __device__ __forceinline__ int half() const { return (c >= (G >> 1)) ? 1 : 0; }
    __device__ __forceinline__ bool next(int i, Unit& u) const {
        if (!on || i != 0) return false;
        u.seg = 0; u.slot = c - half() * (G >> 1); u.split = 1 + half();
        unit_of((nwg / G) * G + u.slot, nwg, nM, nN, u); return true;
    }
};

template <class Epi, bool ALIGN_EPI, class Order = StaticOrder>
__device__ __forceinline__ void gemm_phase(LAS unsigned char* lds, const Gemm g, const Order& S, const Epi& E) {
    int tid_ = threadIdx.x; asm volatile("" : "+v"(tid_));
    const int tid = tid_, wid = __builtin_amdgcn_readfirstlane(tid >> 6), lane = tid & 63, wr = wid >> 2, wc = wid & 3, fr = lane & 15, fq = lane >> 4;
    const int K = g.LD, nt = g.K / BK;
    const char *gA0 = (const char*)g.A0, *gA1 = (const char*)g.A1, *gA2 = (const char*)g.A2, *gB0 = (const char*)g.B0, *gB1 = (const char*)g.B1, *gB2 = (const char*)g.B2;
    asm volatile("" : "+s"(gA0), "+s"(gA1), "+s"(gA2), "+s"(gB0), "+s"(gB1), "+s"(gB2));
#define PG8_SELA(s) ((s) == 0 ? gA0 : ((s) == 1 ? gA1 : gA2))
#define PG8_SELB(s) ((s) == 0 ? gB0 : ((s) == 1 ? gB1 : gB2))
    unsigned voffA[2], voffB[2];
#pragma unroll
    for (int i = 0; i < 2; ++i) { int R, C; stage_rc(tid * 16 + i * 8192, R, C); const int Rb = Epi::PERM ? ((R & ~31) + perm32(R & 31)) : R;
        voffA[i] = (unsigned)(R * K + C) * 2u; voffB[i] = (unsigned)(Rb * K + C) * 2u; }
    const size_t kstep = (size_t)(BK * 2);
    const size_t hstep = (size_t)HALF * K * 2;
    const size_t tstep = 2 * hstep;
    const unsigned ldsw = (unsigned)wid * 1024u;
    const int aoff = lds_byte(wr * 64 + fr, fq * 8), boff = lds_byte(wc * 32 + fr, fq * 8);
#define PG8_SA(b, h) (((b) * 2 + (h)) * HTB)
#define PG8_SB(b, h) ((4 + (b) * 2 + (h)) * HTB)
#define PG8_STAGE(bufoff, gbase, voff) do { _Pragma("unroll") for (int _i = 0; _i < 2; ++_i) \
        __builtin_amdgcn_global_load_lds((const unsigned*)((const char*)(gbase) + (voff)[_i]), (LAS unsigned*)(lds + (bufoff) + ldsw + _i * 8192), 16, 0, 0); } while (0)
#define PG8_LDA(dst, b, h) do { _Pragma("unroll") for (int m = 0; m < 4; ++m) _Pragma("unroll") for (int k = 0; k < 2; ++k) dst[m][k] = *(const LAS bf16x8*)(lds + PG8_SA(b, h) + aoff + m * 2048 + k * 1024); } while (0)
#define PG8_LDB(dst, b, h) do { _Pragma("unroll") for (int n = 0; n < 2; ++n) _Pragma("unroll") for (int k = 0; k < 2; ++k) dst[n][k] = *(const LAS bf16x8*)(lds + PG8_SB(b, h) + boff + n * 2048 + k * 1024); } while (0)
#define PG8_MMA(ai, bj, At, Bt) do { __builtin_amdgcn_s_setprio(1); _Pragma("unroll") for (int m = 0; m < 4; ++m) _Pragma("unroll") for (int n = 0; n < 2; ++n) _Pragma("unroll") for (int k = 0; k < 2; ++k) \
        acc[ai][bj][m][n] = __builtin_amdgcn_mfma_f32_16x16x32_bf16(Bt[n][k], At[m][k], acc[ai][bj][m][n], 0, 0, 0); __builtin_amdgcn_s_setprio(0); } while (0)
#define PG8_WAIT_V(n) asm volatile("s_waitcnt vmcnt(" #n ")" ::: "memory")
#define PG8_WAIT_L(n) asm volatile("s_waitcnt lgkmcnt(" #n ")" ::: "memory")
#define PG8_BAR __builtin_amdgcn_s_barrier()
#define PG8_SCHED __builtin_amdgcn_sched_barrier(0)
    Unit cur, nxt; int ui = 0;
    if (!S.next(0, cur)) return;
    f32x4 acc[2][2][4][2];
#pragma unroll
    for (int a = 0; a < 2; ++a)
#pragma unroll
        for (int b = 0; b < 2; ++b)
#pragma unroll
            for (int m = 0; m < 4; ++m)
#pragma unroll
                for (int n = 0; n < 2; ++n) acc[a][b][m][n] = (f32x4){0.f, 0.f, 0.f, 0.f};
    bf16x8 At[4][2], B0[2][2], B1[2][2];
    const char* cA = PG8_SELA(cur.seg) + (size_t)cur.pm * tstep; const char* cB = PG8_SELB(cur.seg) + (size_t)cur.pn * tstep;
    PG8_STAGE(PG8_SB(0, 0), cB, voffB); PG8_STAGE(PG8_SB(0, 1), cB + hstep, voffB); PG8_STAGE(PG8_SA(0, 0), cA, voffA); PG8_STAGE(PG8_SA(0, 1), cA + hstep, voffA);
    if (wr == 1) PG8_BAR;
    PG8_WAIT_V(2); PG8_BAR;
    PG8_STAGE(PG8_SB(1, 0), cB + kstep, voffB); PG8_STAGE(PG8_SA(1, 0), cA + kstep, voffA); PG8_STAGE(PG8_SB(1, 1), cB + hstep + kstep, voffB);
    PG8_WAIT_V(6); PG8_BAR;
    for (;;) {
        const bool has_next = S.next(ui + 1, nxt);
        const char* nA = has_next ? PG8_SELA(nxt.seg) + (size_t)nxt.pm * tstep : cA; const char* nB = has_next ? PG8_SELB(nxt.seg) + (size_t)nxt.pn * tstep : cB;
#pragma unroll 1
        for (int t = 0; t < nt; t += 2) {
            const bool last = (t == nt - 2);
            const char* a1 = cA + (size_t)(t + 1) * kstep;
            const char* a2 = last ? nA : cA + (size_t)(t + 2) * kstep; const char* b2 = last ? nB : cB + (size_t)(t + 2) * kstep;
            const char* a3 = a2 + kstep; const char* b3 = b2 + kstep;
            PG8_LDB(B0, 0, 0); PG8_LDB(B1, 0, 1); PG8_SCHED; PG8_LDA(At, 0, 0); PG8_STAGE(PG8_SA(1, 1), a1 + hstep, voffA);
            PG8_WAIT_V(8); PG8_WAIT_L(0); PG8_BAR; PG8_MMA(0, 0, At, B0); PG8_MMA(0, 1, At, B1); PG8_BAR; PG8_SCHED;
            PG8_LDA(At, 0, 1); PG8_STAGE(PG8_SB(0, 0), b2, voffB); PG8_STAGE(PG8_SB(0, 1), b2 + hstep, voffB); PG8_STAGE(PG8_SA(0, 0), a2, voffA);
            PG8_WAIT_V(8); PG8_WAIT_L(0); PG8_BAR; PG8_MMA(1, 0, At, B0); PG8_MMA(1, 1, At, B1); PG8_BAR; PG8_SCHED;
            PG8_LDB(B0, 1, 0); PG8_LDB(B1, 1, 1); PG8_SCHED; PG8_LDA(At, 1, 0); PG8_STAGE(PG8_SA(0, 1), a2 + hstep, voffA);
            PG8_WAIT_V(8); PG8_WAIT_L(0); PG8_BAR; PG8_MMA(0, 0, At, B0); PG8_MMA(0, 1, At, B1); PG8_BAR; PG8_SCHED;
            PG8_LDA(At, 1, 1); PG8_STAGE(PG8_SB(1, 0), b3, voffB); PG8_STAGE(PG8_SB(1, 1), b3 + hstep, voffB); PG8_STAGE(PG8_SA(1, 0), a3, voffA);
            PG8_WAIT_V(8); PG8_WAIT_L(0); PG8_BAR; PG8_MMA(1, 0, At, B0); PG8_MMA(1, 1, At, B1); PG8_BAR; PG8_SCHED;
        }
        if constexpr (ALIGN_EPI) { if (wr == 0) PG8_BAR; }
        const bool zero = E(acc, cur, wr, wc, fr, fq);
        if (!has_next) break;
        if (zero) {
#pragma unroll
            for (int a = 0; a < 2; ++a)
#pragma unroll
                for (int b = 0; b < 2; ++b)
#pragma unroll
                    for (int m = 0; m < 4; ++m)
#pragma unroll
                        for (int n = 0; n < 2; ++n) acc[a][b][m][n] = (f32x4){0.f, 0.f, 0.f, 0.f};
        }
        cur = nxt; cA = nA; cB = nB; ++ui;
        if constexpr (ALIGN_EPI) { if (wr == 1) PG8_BAR; }
    }
    PG8_WAIT_V(0);
    if constexpr (!ALIGN_EPI) { if (wr == 0) PG8_BAR; }
    PG8_BAR;
#undef PG8_SA
#undef PG8_SB
#undef PG8_STAGE
#undef PG8_LDA
#undef PG8_LDB
#undef PG8_MMA
#undef PG8_WAIT_V
#undef PG8_WAIT_L
#undef PG8_BAR
#undef PG8_SCHED
}

#define EPI_ROW(ai, m) (u.pm * BM + (ai) * HALF + wr * 64 + (m) * 16 + fr)
__device__ __forceinline__ u32x4 pack8(const f32x4 a, const f32x4 b) { u32x4 w; w.x = cvt_pk_bf16(a[0], a[1]); w.y = cvt_pk_bf16(a[2], a[3]); w.z = cvt_pk_bf16(b[0], b[1]); w.w = cvt_pk_bf16(b[2], b[3]); return w; }

struct EpiUp {
    static constexpr bool PERM = true;
    bf16_t* H; const float* ss;
    __device__ __forceinline__ bool operator()(f32x4 (&acc)[2][2][4][2], const Unit& u, int wr, int wc, int fr, int fq) const {
        asm volatile("" : "+v"(fr), "+v"(fq));
#pragma unroll
        for (int ai = 0; ai < 2; ++ai)
#pragma unroll
            for (int m = 0; m < 4; ++m) {
                const int row = EPI_ROW(ai, m);
                const float rs = rsqrtf(sum_slots16(ss + (size_t)row * 16) * (1.0f / DM) + EPS);
                f32x4 o[2];
#pragma unroll
                for (int n = 0; n < 2; ++n)
#pragma unroll
                    for (int i = 0; i < 4; ++i) { const float gv = acc[ai][0][m][n][i] * rs, uv = acc[ai][1][m][n][i] * rs; o[n][i] = gv * fast_sigmoid(gv) * uv; }
                *(u32x4*)(H + (size_t)row * FF + u.pn * 128 + wc * 32 + fq * 8) = pack8(o[0], o[1]);
            }
        return true;
    }
};

struct EpiUpTail {
    static constexpr bool PERM = true;
    bf16_t* H; const float* ss; float* P; unsigned* flg;
    __device__ __forceinline__ bool operator()(f32x4 (&acc)[2][2][4][2], const Unit& u, int wr, int wc, int fr, int fq) const {
        asm volatile("" : "+v"(fr), "+v"(fq));
        const int tid = threadIdx.x;
        float* pp = P + (size_t)u.slot * (32 * 2048) + tid * 4;
        if (u.split == 2) {
#pragma unroll
            for (int ai = 0; ai < 2; ++ai)
#pragma unroll
                for (int bj = 0; bj < 2; ++bj)
#pragma unroll
                    for (int m = 0; m < 4; ++m)
#pragma unroll
                        for (int n = 0; n < 2; ++n) *(f32x4*)(pp + (((ai * 2 + bj) * 4 + m) * 2 + n) * 2048) = acc[ai][bj][m][n];
            __threadfence();
            __syncthreads();
            if (tid == 0) __hip_atomic_store(flg + u.slot, 1u, __ATOMIC_RELEASE, __HIP_MEMORY_SCOPE_AGENT);
            return true;
        }
        if (tid == 0) { unsigned sp = 0; while (__hip_atomic_load(flg + u.slot, __ATOMIC_RELAXED, __HIP_MEMORY_SCOPE_AGENT) == 0u) { __builtin_amdgcn_s_sleep(2); if (++sp > (1u << 22)) break; } }
        __syncthreads();
        __builtin_amdgcn_fence(__ATOMIC_ACQUIRE, "agent");
#pragma unroll
        for (int ai = 0; ai < 2; ++ai)
#pragma unroll
            for (int m = 0; m < 4; ++m) {
                const int row = EPI_ROW(ai, m);
                const float rs = rsqrtf(sum_slots16(ss + (size_t)row * 16) * (1.0f / DM) + EPS);
                f32x4 o[2], ga[2], ua[2];
#pragma unroll
                for (int n = 0; n < 2; ++n) { ga[n] = acc[ai][0][m][n] + *(const f32x4*)(pp + (((ai * 2 + 0) * 4 + m) * 2 + n) * 2048); ua[n] = acc[ai][1][m][n] + *(const f32x4*)(pp + (((ai * 2 + 1) * 4 + m) * 2 + n) * 2048); }
#pragma unroll
                for (int n = 0; n < 2; ++n)
#pragma unroll
                    for (int i = 0; i < 4; ++i) { const float gv = ga[n][i] * rs, uv = ua[n][i] * rs; o[n][i] = gv * fast_sigmoid(gv) * uv; }
                *(u32x4*)(H + (size_t)row * FF + u.pn * 128 + wc * 32 + fq * 8) = pack8(o[0], o[1]);
                asm volatile("" ::: "memory");
            }
        return true;
    }
};

struct EpiRes {
    static constexpr bool PERM = true;
    bf16_t* XB; float alpha; float* ssn; float* outf;
    __device__ __forceinline__ bool operator()(f32x4 (&acc)[2][2][4][2], const Unit& u, int wr, int wc, int fr, int fq) const {
        asm volatile("" : "+v"(fr), "+v"(fq));
#pragma unroll
        for (int ai = 0; ai < 2; ++ai)
#pragma unroll
            for (int m = 0; m < 4; ++m) {
                const int row = EPI_ROW(ai, m);
                float sq = 0.f;
#pragma unroll
                for (int bj = 0; bj < 2; ++bj) {
                    const size_t off = (size_t)row * DM + u.pn * BM + bj * HALF + wc * 32 + fq * 8;
                    const u32x4 old = *(const u32x4*)(XB + off);
                    f32x4 a, b;
                    a[0] = bflo(old.x) + alpha * acc[ai][bj][m][0][0]; a[1] = bfhi(old.x) + alpha * acc[ai][bj][m][0][1];
                    a[2] = bflo(old.y) + alpha * acc[ai][bj][m][0][2]; a[3] = bfhi(old.y) + alpha * acc[ai][bj][m][0][3];
                    b[0] = bflo(old.z) + alpha * acc[ai][bj][m][1][0]; b[1] = bfhi(old.z) + alpha * acc[ai][bj][m][1][1];
                    b[2] = bflo(old.w) + alpha * acc[ai][bj][m][1][2]; b[3] = bfhi(old.w) + alpha * acc[ai][bj][m][1][3];
                    sq += (a[0] * a[0] + a[1] * a[1]) + (a[2] * a[2] + a[3] * a[3]) + (b[0] * b[0] + b[1] * b[1]) + (b[2] * b[2] + b[3] * b[3]);
                    *(u32x4*)(XB + off) = pack8(a, b);
                    if (outf) { *(f32x4*)(outf + off) = a; *(f32x4*)(outf + off + 4) = b; }
                }
                sq += __shfl_xor(sq, 16); sq += __shfl_xor(sq, 32);
                if (fq == 0) ssn[(size_t)row * 16 + u.pn * 4 + wc] = sq;
            }
        return true;
    }
};

struct EpiWin {
    static constexpr bool PERM = true;
    const float* ss; const float* biasP;
    bf16_t *XPRE, *GG, *CQ, *CKV, *KPE, *PC, *G; float *ssq, *sskv;
    __device__ __forceinline__ bool operator()(f32x4 (&acc)[2][2][4][2], const Unit& u, int wr, int wc, int fr, int fq) const {
        asm volatile("" : "+v"(fr), "+v"(fq));
        const int pn = u.pn;
        const int cl = wc * 32 + fq * 8;
        f32x4 bv[2][2];
#pragma unroll
        for (int bj = 0; bj < 2; ++bj)
#pragma unroll
            for (int n = 0; n < 2; ++n) bv[bj][n] = *(const f32x4*)(biasP + pn * BM + bj * HALF + cl + 4 * n);
#pragma unroll
        for (int ai = 0; ai < 2; ++ai)
#pragma unroll
            for (int m = 0; m < 4; ++m) {
                const int row = EPI_ROW(ai, m);
                const float rs = rsqrtf(sum_slots16(ss + (size_t)row * 16) * (1.0f / DM) + EPS);
                f32x4 v[2][2];
#pragma unroll
                for (int bj = 0; bj < 2; ++bj)
#pragma unroll
                    for (int n = 0; n < 2; ++n) v[bj][n] = acc[ai][bj][m][n] * rs + bv[bj][n];
                if (pn < 2) {
#pragma unroll
                    for (int bj = 0; bj < 2; ++bj) *(u32x4*)(XPRE + (size_t)row * 512 + pn * BM + bj * HALF + cl) = pack8(v[bj][0], v[bj][1]);
                } else if (pn < 4) {
#pragma unroll
                    for (int bj = 0; bj < 2; ++bj) {
#pragma unroll
                        for (int n = 0; n < 2; ++n)
#pragma unroll
                            for (int i = 0; i < 4; ++i) { const float x = v[bj][n][i]; const float z = 1.5957691216057308f * (x + 0.044715f * x * x * x); v[bj][n][i] = x * fast_sigmoid(z); }
                        *(u32x4*)(GG + (size_t)row * 512 + (pn - 2) * BM + bj * HALF + cl) = pack8(v[bj][0], v[bj][1]);
                    }
                } else if (pn < 7) {
#pragma unroll
                    for (int bj = 0; bj < 2; ++bj) {
                        const int seg = (pn - 4) * 2 + bj;
                        float sq = 0.f;
#pragma unroll
                        for (int n = 0; n < 2; ++n)
#pragma unroll
                            for (int i = 0; i < 4; ++i) sq += v[bj][n][i] * v[bj][n][i];
                        sq += __shfl_xor(sq, 16); sq += __shfl_xor(sq, 32);
                        const u32x4 w = pack8(v[bj][0], v[bj][1]);
                        if (seg < 3) { *(u32x4*)(CQ + (size_t)row * 384 + seg * 128 + cl) = w; if (fq == 0) ssq[(size_t)row * 16 + seg * 4 + wc] = sq; }
                        else if (seg < 5) { *(u32x4*)(CKV + (size_t)row * 256 + (seg - 3) * 128 + cl) = w; if (fq == 0) sskv[(size_t)row * 8 + (seg - 3) * 4 + wc] = sq; }
                        else if (wc == 0) { *(u32x4*)(KPE + (size_t)row * 32 + fq * 8) = w; }
                    }
                } else if (pn < 11) {
                    f32x4 o[2];
#pragma unroll
                    for (int n = 0; n < 2; ++n)
#pragma unroll
                        for (int i = 0; i < 4; ++i) o[n][i] = v[0][n][i] * fast_sigmoid(v[1][n][i]);
                    *(u32x4*)(PC + (size_t)row * 512 + (pn - 7) * 128 + cl) = pack8(o[0], o[1]);
                } else {
#pragma unroll
                    for (int bj = 0; bj < 2; ++bj) {
#pragma unroll
                        for (int n = 0; n < 2; ++n)
#pragma unroll
                            for (int i = 0; i < 4; ++i) v[bj][n][i] = fmaxf(fast_sigmoid(v[bj][n][i]), 1e-30f);
                        *(u32x4*)(G + (size_t)row * 3072 + (pn - 11) * BM + bj * HALF + cl) = pack8(v[bj][0], v[bj][1]);
                    }
                }
            }
        return true;
    }
};

struct EpiQ {
    static constexpr bool PERM = false;
    bf16_t* Q; const float* ssq; const float* CS;
    __device__ __forceinline__ bool operator()(f32x4 (&acc)[2][2][4][2], const Unit& u, int wr, int wc, int fr, int fq) const {
        asm volatile("" : "+v"(fr), "+v"(fq));
        float rsv[2][4];
#pragma unroll
        for (int ai = 0; ai < 2; ++ai) {
#pragma unroll
            for (int m = 0; m < 4; ++m) rsv[ai][m] = sum_slots12(ssq + (size_t)EPI_ROW(ai, m) * 16);
            asm volatile("" ::: "memory"); }
#pragma unroll
        for (int ai = 0; ai < 2; ++ai)
#pragma unroll
            for (int m = 0; m < 4; ++m) {
                const int row = EPI_ROW(ai, m);
                const float rs = rsqrtf(rsv[ai][m] * (1.0f / 384.0f) + EPS) * QSCALE;
                const f32x4 cs = *(const f32x4*)(CS + (size_t)row * 32 + 4 * fq), sn = *(const f32x4*)(CS + (size_t)row * 32 + 16 + 4 * fq);
#pragma unroll
                for (int bj = 0; bj < 2; ++bj) {
                    const int c0 = u.pn * BM + bj * HALF + wc * 32;
                    f32x4 x1 = acc[ai][bj][m][0] * rs, x2 = acc[ai][bj][m][1] * rs;
                    if ((c0 % 96) == 64) { const f32x4 y1 = x1 * cs - x2 * sn, y2 = x2 * cs + x1 * sn; x1 = y1; x2 = y2; }
                    u32x2 w1, w2; w1.x = cvt_pk_bf16(x1[0], x1[1]); w1.y = cvt_pk_bf16(x1[2], x1[3]); w2.x = cvt_pk_bf16(x2[0], x2[1]); w2.y = cvt_pk_bf16(x2[2], x2[3]);
                    *(u32x2*)(Q + (size_t)row * 768 + c0 + 4 * fq) = w1; *(u32x2*)(Q + (size_t)row * 768 + c0 + 16 + 4 * fq) = w2;
                }
            }
        return true;
    }
};

struct EpiKV {
    static constexpr bool PERM = true;
    bf16_t *KN, *V; const float* sskv;
    __device__ __forceinline__ bool operator()(f32x4 (&acc)[2][2][4][2], const Unit& u, int wr, int wc, int fr, int fq) const {
        asm volatile("" : "+v"(fr), "+v"(fq));
        float rsv[2][4];
#pragma unroll
        for (int ai = 0; ai < 2; ++ai)
#pragma unroll
            for (int m = 0; m < 4; ++m) rsv[ai][m] = sum_slots8(sskv + (size_t)EPI_ROW(ai, m) * 8);
#pragma unroll
        for (int ai = 0; ai < 2; ++ai)
#pragma unroll
            for (int m = 0; m < 4; ++m) {
                const int row = EPI_ROW(ai, m);
                const float rs = rsqrtf(rsv[ai][m] * (1.0f / 256.0f) + EPS);
#pragma unroll
                for (int bj = 0; bj < 2; ++bj) {
                    const int head = u.pn * 2 + bj; const int j = wc * 32 + fq * 8;
                    const u32x4 w = pack8(acc[ai][bj][m][0] * rs, acc[ai][bj][m][1] * rs);
                    if (wc < 2) *(u32x4*)(KN + (size_t)row * 512 + head * 64 + j) = w;
                    else        *(u32x4*)(V + (size_t)row * 512 + head * 64 + (j - 64)) = w;
                }
            }
        return true;
    }
};

struct EpiMerge {
    static constexpr bool PERM = true;
    const bf16_t* G; const float* bc; bf16_t* OUT;
    __device__ __forceinline__ bool operator()(f32x4 (&acc)[2][2][4][2], const Unit& u, int wr, int wc, int fr, int fq) const {
        asm volatile("" : "+v"(fr), "+v"(fq));
        const int seg = u.seg;
        const int colb = u.pn * BM + wc * 32 + fq * 8;
#pragma unroll
        for (int ai = 0; ai < 2; ++ai)
#pragma unroll
        for (int mh = 0; mh < 2; ++mh) {
            u32x4 ga[2][2], gb[2][2];
#pragma unroll
            for (int mm = 0; mm < 2; ++mm)
#pragma unroll
                for (int bj = 0; bj < 2; ++bj) {
                    const bf16_t* gp = G + (size_t)EPI_ROW(ai, 2 * mh + mm) * 3072 + seg * 1024 + colb + bj * HALF;
                    ga[mm][bj] = *(const u32x4*)gp;
                    gb[mm][bj] = (seg < 2) ? *(const u32x4*)(gp + 1024) : ga[mm][bj];
                }
            if (seg < 2) {
#pragma unroll
                for (int mm = 0; mm < 2; ++mm)
#pragma unroll
                    for (int bj = 0; bj < 2; ++bj) {
                        const int m = 2 * mh + mm; const u32x4 a = ga[mm][bj], b = gb[mm][bj];
                        const f32x4 r0 = {bflo(a.x) * __builtin_amdgcn_rcpf(bflo(b.x)), bfhi(a.x) * __builtin_amdgcn_rcpf(bfhi(b.x)), bflo(a.y) * __builtin_amdgcn_rcpf(bflo(b.y)), bfhi(a.y) * __builtin_amdgcn_rcpf(bfhi(b.y))};
                        const f32x4 r1 = {bflo(a.z) * __builtin_amdgcn_rcpf(bflo(b.z)), bfhi(a.z) * __builtin_amdgcn_rcpf(bfhi(b.z)), bflo(a.w) * __builtin_amdgcn_rcpf(bflo(b.w)), bfhi(a.w) * __builtin_amdgcn_rcpf(bfhi(b.w))};
                        acc[ai][bj][m][0] *= r0; acc[ai][bj][m][1] *= r1;
                    }
            } else {
#pragma unroll
                for (int bj = 0; bj < 2; ++bj) {
                    const f32x4 c0 = *(const f32x4*)(bc + colb + bj * HALF), c1 = *(const f32x4*)(bc + colb + bj * HALF + 4);
#pragma unroll
                    for (int mm = 0; mm < 2; ++mm) {
                        const int m = 2 * mh + mm; const u32x4 a = ga[mm][bj];
                        const f32x4 a0 = {bflo(a.x), bfhi(a.x), bflo(a.y), bfhi(a.y)}, a1 = {bflo(a.z), bfhi(a.z), bflo(a.w), bfhi(a.w)};
                        *(u32x4*)(OUT + (size_t)EPI_ROW(ai, m) * DM + colb + bj * HALF) = pack8((acc[ai][bj][m][0] + c0) * a0, (acc[ai][bj][m][1] + c1) * a1);
                    }
                }
            }
            asm volatile("" ::: "memory");
        }
        return seg == 2;
    }
};
}

namespace att {
__device__ __forceinline__ int crow(int r, int hi) { return (r & 3) + 8 * (r >> 2) + 4 * hi; }
constexpr int KSLOT = 12288, VSLOT = 8192;
constexpr int L_K = 0, L_V = 2 * KSLOT, L_WS = L_V + 2 * VSLOT, L_OST = L_WS + 2048, L_END = L_OST + 8 * 4096;

__device__ __forceinline__ float hmax(float m) { auto rr = __builtin_amdgcn_permlane32_swap(__float_as_uint(m), __float_as_uint(m), false, false); return fmaxf(__uint_as_float(rr[0]), __uint_as_float(rr[1])); }
__device__ __forceinline__ float hsum(float m) { auto rr = __builtin_amdgcn_permlane32_swap(__float_as_uint(m), __float_as_uint(m), false, false); return __uint_as_float(rr[0]) + __uint_as_float(rr[1]); }

__device__ __forceinline__ void pv(f32x16* o, unsigned vb, bf16x8 pa0, bf16x8 pa1, bf16x8 pa2, bf16x8 pa3) {
    s16x4 lo[2][4], hi[2][4];
#pragma unroll
    for (int d0 = 0; d0 < 2; ++d0)
#pragma unroll
        for (int ks = 0; ks < 4; ++ks) {
            asm volatile("ds_read_b64_tr_b16 %0,%1 offset:%c2" : "=&v"(lo[d0][ks]) : "v"(vb), "i"(d0 * 4096 + ks * 1024) : "memory");
            asm volatile("ds_read_b64_tr_b16 %0,%1 offset:%c2" : "=&v"(hi[d0][ks]) : "v"(vb), "i"(d0 * 4096 + ks * 1024 + 512) : "memory"); }
#define PK(d, k) (bf16x8){lo[d][k][0], lo[d][k][1], lo[d][k][2], lo[d][k][3], hi[d][k][0], hi[d][k][1], hi[d][k][2], hi[d][k][3]}
    asm volatile("s_waitcnt lgkmcnt(8)" ::: "memory"); __builtin_amdgcn_sched_barrier(0);
    o[0] = __builtin_amdgcn_mfma_f32_32x32x16_bf16(pa0, PK(0, 0), o[0], 0, 0, 0);
    o[0] = __builtin_amdgcn_mfma_f32_32x32x16_bf16(pa1, PK(0, 1), o[0], 0, 0, 0);
    o[0] = __builtin_amdgcn_mfma_f32_32x32x16_bf16(pa2, PK(0, 2), o[0], 0, 0, 0);
    o[0] = __builtin_amdgcn_mfma_f32_32x32x16_bf16(pa3, PK(0, 3), o[0], 0, 0, 0);
    asm volatile("s_waitcnt lgkmcnt(0)" ::: "memory"); __builtin_amdgcn_sched_barrier(0);
    o[1] = __builtin_amdgcn_mfma_f32_32x32x16_bf16(pa0, PK(1, 0), o[1], 0, 0, 0);
    o[1] = __builtin_amdgcn_mfma_f32_32x32x16_bf16(pa1, PK(1, 1), o[1], 0, 0, 0);
    o[1] = __builtin_amdgcn_mfma_f32_32x32x16_bf16(pa2, PK(1, 2), o[1], 0, 0, 0);
    o[1] = __builtin_amdgcn_mfma_f32_32x32x16_bf16(pa3, PK(1, 3), o[1], 0, 0, 0);
#undef PK
}

__device__ __forceinline__ void attn_block(int b, int h, int qb, const bf16_t* Q, const bf16_t* KN, const bf16_t* KR, const bf16_t* V, bf16_t* O, LAS unsigned char* lds) {
    int tid_ = threadIdx.x; asm volatile("" : "+v"(tid_));
    const int tid = tid_, lane = tid & 63, r32 = lane & 31, hi = lane >> 5;
    const int wid = __builtin_amdgcn_readfirstlane(tid >> 6);
    const size_t rowbase = (size_t)b * SEQ; const int q0 = qb * 256;
    const bf16_t* Qw = Q + (rowbase + q0 + wid * 32 + r32) * 768 + h * 96;
    bf16x8 qr[6];
#pragma unroll
    for (int d0 = 0; d0 < 6; ++d0) qr[d0] = *(const bf16x8*)(Qw + d0 * 16 + hi * 8);
    const int NT = 4 * qb + 4;
    const bf16_t* kg = KN + (rowbase + lane) * 512 + h * 64 + wid * 8;
    const bf16_t* krg = KR + (rowbase + lane) * 32 + (wid & 3) * 8;
    const bf16_t* vg = V + (rowbase + 16 * (wid & 3) + (lane >> 2)) * 512 + h * 64 + (wid >> 2) * 32 + (lane & 3) * 8;
    const int kdst = L_K + wid * 1024 + lane * 16, krdst = L_K + (8 + (wid & 3)) * 1024 + lane * 16, vdst = L_V + wid * 1024 + lane * 16;
    unsigned z0_ = 0u; asm volatile("" : "+v"(z0_)); u32x4 kreg, krreg = {z0_, z0_, z0_, z0_}, vreg;
    kreg = *(const u32x4*)kg; if (wid < 4) krreg = *(const u32x4*)krg; vreg = *(const u32x4*)vg;
    *(LAS u32x4*)(lds + kdst) = kreg; if (wid < 4) *(LAS u32x4*)(lds + krdst) = krreg; *(LAS u32x4*)(lds + vdst) = vreg;
    __syncthreads();
    float mrun = -INFINITY, lrun = 0.f; f32x16 o[2];
#pragma unroll
    for (int r = 0; r < 16; ++r) { o[0][r] = 0.f; o[1][r] = 0.f; }
    LAS float* wsf = (LAS float*)(lds + L_WS) + wid * 64;
    const int qabs = q0 + wid * 32 + r32;
    const unsigned vbl = (unsigned)(uintptr_t)(lds + L_V) + ((lane >> 4) & 1) * 32 + (lane & 3) * 8 + (4 * hi + ((lane & 15) >> 2)) * 64;
    for (int t = 0; t < NT; ++t) {
        const int cur = t & 1;
        if (t + 1 < NT) { const size_t adv = (size_t)(t + 1) * 64; kreg = *(const u32x4*)(kg + adv * 512); if (wid < 4) krreg = *(const u32x4*)(krg + adv * 32); vreg = *(const u32x4*)(vg + adv * 512); }
        const int jb = t - 4 * qb;
        if (jb <= (wid >> 1)) {
            f32x16 p0, p1;
#pragma unroll
            for (int r = 0; r < 16; ++r) { p0[r] = 0.f; p1[r] = 0.f; }
            const LAS unsigned char* kb = lds + L_K + cur * KSLOT + hi * 1024 + r32 * 16;
            bf16x8 kf[12];
#pragma unroll
            for (int d0 = 0; d0 < 6; ++d0) { kf[2 * d0] = *(const LAS bf16x8*)(kb + d0 * 2048); kf[2 * d0 + 1] = *(const LAS bf16x8*)(kb + d0 * 2048 + 512); }
            __builtin_amdgcn_sched_barrier(0);
#pragma unroll
            for (int d0 = 0; d0 < 6; ++d0) {
                p0 = __builtin_amdgcn_mfma_f32_32x32x16_bf16(kf[2 * d0], qr[d0], p0, 0, 0, 0);
                p1 = __builtin_amdgcn_mfma_f32_32x32x16_bf16(kf[2 * d0 + 1], qr[d0], p1, 0, 0, 0);
            }
            if (jb == (wid >> 1)) {
                const int kbase = 64 * t + 4 * hi;
#pragma unroll
                for (int r = 0; r < 16; ++r) { const int kv = kbase + (r & 3) + 8 * (r >> 2); if (kv > qabs) p0[r] = -INFINITY; if (kv + 32 > qabs) p1[r] = -INFINITY; }
            }
            float rm = fmaxf(p0[0], p1[0]);
#pragma unroll
            for (int r = 1; r < 16; ++r) rm = fmaxf(rm, fmaxf(p0[r], p1[r]));
            rm = hmax(rm);
            if (__any(rm > mrun + 8.0f)) {
                const float mn = fmaxf(mrun, rm);
                const float alpha = __builtin_amdgcn_exp2f(mrun - mn);
                mrun = mn; lrun *= alpha;
                if (hi == 0) wsf[r32] = alpha;
                asm volatile("s_waitcnt lgkmcnt(0)" ::: "memory");
#pragma unroll
                for (int r = 0; r < 16; ++r) { const float a = wsf[crow(r, hi)]; o[0][r] *= a; o[1][r] *= a; }
            }
            float sum = 0.f;
#pragma unroll
            for (int r = 0; r < 16; ++r) { p0[r] = __builtin_amdgcn_exp2f(p0[r] - mrun); p1[r] = __builtin_amdgcn_exp2f(p1[r] - mrun); sum += p0[r] + p1[r]; }
            lrun += sum;
            u32x4 pw0, pw1, pw2, pw3;
            pw0 = (u32x4){cvt_pk_bf16(p0[0], p0[1]), cvt_pk_bf16(p0[2], p0[3]), cvt_pk_bf16(p0[4], p0[5]), cvt_pk_bf16(p0[6], p0[7])};
            pw1 = (u32x4){cvt_pk_bf16(p0[8], p0[9]), cvt_pk_bf16(p0[10], p0[11]), cvt_pk_bf16(p0[12], p0[13]), cvt_pk_bf16(p0[14], p0[15])};
            pw2 = (u32x4){cvt_pk_bf16(p1[0], p1[1]), cvt_pk_bf16(p1[2], p1[3]), cvt_pk_bf16(p1[4], p1[5]), cvt_pk_bf16(p1[6], p1[7])};
            pw3 = (u32x4){cvt_pk_bf16(p1[8], p1[9]), cvt_pk_bf16(p1[10], p1[11]), cvt_pk_bf16(p1[12], p1[13]), cvt_pk_bf16(p1[14], p1[15])};
            pv(o, vbl + cur * VSLOT, __builtin_bit_cast(bf16x8, pw0), __builtin_bit_cast(bf16x8, pw1), __builtin_bit_cast(bf16x8, pw2), __builtin_bit_cast(bf16x8, pw3));
        }
        if (t + 1 < NT) { const int nb = (cur ^ 1); *(LAS u32x4*)(lds + kdst + nb * KSLOT) = kreg; if (wid < 4) *(LAS u32x4*)(lds + krdst + nb * KSLOT) = krreg; *(LAS u32x4*)(lds + vdst + nb * VSLOT) = vreg; }
        __syncthreads();
    }
    lrun = hsum(lrun);
    if (hi == 0) wsf[32 + r32] = lrun;
    asm volatile("s_waitcnt lgkmcnt(0)" ::: "memory");
    float rli[16];
#pragma unroll
    for (int r = 0; r < 16; ++r) rli[r] = __builtin_amdgcn_rcpf(wsf[32 + crow(r, hi)]);
    bf16_t* Ow = O + (rowbase + q0 + wid * 32) * 512 + h * 64;
    LAS bf16_t* stg = (LAS bf16_t*)(lds + L_OST) + wid * 2048;
#pragma unroll
    for (int r = 0; r < 16; ++r) { const int orow = crow(r, hi);
#pragma unroll
        for (int d0 = 0; d0 < 2; ++d0) stg[orow * 64 + d0 * 32 + r32] = f2bf(o[d0][r] * rli[r]); }
    asm volatile("s_waitcnt lgkmcnt(0)" ::: "memory");
#pragma unroll
    for (int i = 0; i < 4; ++i) { const int row = i * 8 + (lane >> 3), ch = lane & 7; const u32x4 v = *(const LAS u32x4*)(stg + row * 64 + ch * 8); *(u32x4*)(Ow + (size_t)row * 512 + ch * 8) = v; }
    __syncthreads();
}
}

namespace lru {
constexpr int XS_STRIDE = 144;
constexpr int L_XS = 0, L_BM = 74240, L_CW = L_BM + 24576, L_CB = L_CW + 1024, L_AGG = L_CB + 256, L_PRE = L_AGG + 4096, L_CIN = L_PRE + 4096, L_END = L_CIN + 128;
__device__ __forceinline__ void lru_unit(int u, int layer, const bf16_t* XPRE, bf16_t* GG, const float* conv_w, const float* conv_b, const float* wgate, const float* bgate, const float* lam,
                                         unsigned* flags, float* carry, LAS unsigned char* lds) {
    int tid_ = threadIdx.x; asm volatile("" : "+v"(tid_));
    const int tid = tid_, lane = tid & 63, r32 = lane & 31, hi = lane >> 5;
    const int wid = __builtin_amdgcn_readfirstlane(tid >> 6);
    const int ck = u >> 6, bh = u & 63, b = bh >> 3, h = bh & 7, s0 = ck * 512;
    LAS float* CW = (LAS float*)(lds + L_CW); LAS float* CB = (LAS float*)(lds + L_CB);
    LAS f32x2* AGG = (LAS f32x2*)(lds + L_AGG); LAS f32x2* PRE = (LAS f32x2*)(lds + L_PRE); LAS float* CIN = (LAS float*)(lds + L_CIN);
    if (tid < 256) CW[tid] = conv_w[(tid >> 6) * 512 + h * 64 + (tid & 63)];
    else if (tid < 320) CB[tid - 256] = conv_b[h * 64 + (tid - 256)];
    for (int f = tid; f < 1536; f += 512) {
        const int l = f & 63, g = f >> 6, kc = g & 3, nt = g >> 2, n = l & 31, hh = l >> 5, col = 32 * nt + n, d0 = 16 * kc + 8 * hh;
        float v[8];
#pragma unroll
        for (int i = 0; i < 8; ++i) v[i] = (nt < 4) ? wgate[(size_t)h * 8192 + (d0 + i) * 128 + col] : ((d0 + i) == (col - 128) ? 1.0f : 0.0f);
        *(LAS u32x4*)(lds + L_BM + g * 1024 + l * 16) = (u32x4){cvt_pk_bf16(v[0], v[1]), cvt_pk_bf16(v[2], v[3]), cvt_pk_bf16(v[4], v[5]), cvt_pk_bf16(v[6], v[7])};
    }
    unsigned z0_ = 0u; asm volatile("" : "+v"(z0_));
    { u32x4 st[9];
#pragma unroll
      for (int k = 0; k < 9; ++k) { const int i = (tid >> 3) + 64 * k, s = s0 - 3 + i; st[k] = (u32x4){z0_, z0_, z0_, z0_};
          if (i < 515 && s >= 0) st[k] = *(const u32x4*)(XPRE + ((size_t)b * SEQ + s) * 512 + h * 64 + (tid & 7) * 8); }
#pragma unroll
      for (int k = 0; k < 9; ++k) { const int i = (tid >> 3) + 64 * k; if (i < 515) *(LAS u32x4*)(lds + L_XS + i * XS_STRIDE + (tid & 7) * 16) = st[k]; } }
    __syncthreads();
    bf16x8 afr[2][4];
#pragma unroll
    for (int kc = 0; kc < 4; ++kc) {
        const int d0 = 16 * kc + 8 * hi;
        f32x4 w0[4], w1[4];
#pragma unroll
        for (int j = 0; j < 4; ++j) { w0[j] = *(const LAS f32x4*)(CW + j * 64 + d0); w1[j] = *(const LAS f32x4*)(CW + j * 64 + d0 + 4); }
        const f32x4 cb0 = *(const LAS f32x4*)(CB + d0), cb1 = *(const LAS f32x4*)(CB + d0 + 4);
#pragma unroll
        for (int mt = 0; mt < 2; ++mt) {
            const int sl = wid * 64 + mt * 32 + r32;
            f32x4 xa0 = cb0, xa1 = cb1;
#pragma unroll
            for (int j = 0; j < 4; ++j) {
                const u32x4 xv = *(const LAS u32x4*)(lds + L_XS + (sl + j) * XS_STRIDE + d0 * 2);
                xa0 += w0[j] * (f32x4){bflo(xv.x), bfhi(xv.x), bflo(xv.y), bfhi(xv.y)};
                xa1 += w1[j] * (f32x4){bflo(xv.z), bfhi(xv.z), bflo(xv.w), bfhi(xv.w)};
            }
            afr[mt][kc] = __builtin_bit_cast(bf16x8, (u32x4){cvt_pk_bf16(xa0[0], xa0[1]), cvt_pk_bf16(xa0[2], xa0[3]), cvt_pk_bf16(xa1[0], xa1[1]), cvt_pk_bf16(xa1[2], xa1[3])});
        }
    }
    __syncthreads();
    { u32x4 st[8];
#pragma unroll
      for (int k = 0; k < 8; ++k) st[k] = *(const u32x4*)(GG + ((size_t)b * SEQ + s0 + (tid >> 3) + 64 * k) * 512 + h * 64 + (tid & 7) * 8);
#pragma unroll
      for (int k = 0; k < 8; ++k) *(LAS u32x4*)(lds + L_XS + ((tid >> 3) + 64 * k) * XS_STRIDE + (tid & 7) * 16) = st[k]; }
    const int fbase = layer * 256;
#pragma unroll 1
    for (int ct = 0; ct < 2; ++ct) {
        const int c = 32 * ct + r32;
        const float spc = 8.0f * log1pf(expf(-lam[h * 64 + c]));
        const float br = bgate[h * 128 + c], bi = bgate[h * 128 + 64 + c];
        float hq[2][16], ac[2][16];
#pragma unroll
        for (int mt = 0; mt < 2; ++mt) {
            f32x16 R, I, X;
#pragma unroll
            for (int r = 0; r < 16; ++r) { R[r] = br; I[r] = bi; X[r] = 0.f; }
#pragma unroll
            for (int kc = 0; kc < 4; ++kc) {
                const bf16x8 b0 = *(const LAS bf16x8*)(lds + L_BM + ((ct) * 4 + kc) * 1024 + lane * 16);
                const bf16x8 b1 = *(const LAS bf16x8*)(lds + L_BM + ((2 + ct) * 4 + kc) * 1024 + lane * 16);
                const bf16x8 b2 = *(const LAS bf16x8*)(lds + L_BM + ((4 + ct) * 4 + kc) * 1024 + lane * 16);
                R = __builtin_amdgcn_mfma_f32_32x32x16_bf16(afr[mt][kc], b0, R, 0, 0, 0);
                I = __builtin_amdgcn_mfma_f32_32x32x16_bf16(afr[mt][kc], b1, I, 0, 0, 0);
                X = __builtin_amdgcn_mfma_f32_32x32x16_bf16(afr[mt][kc], b2, X, 0, 0, 0);
            }
            float Ar[4], Hr[4];
#pragma unroll
            for (int q = 0; q < 4; ++q) { float A = 1.f, H = 0.f;
#pragma unroll
                for (int k = 0; k < 4; ++k) { const int r = 4 * q + k;
                    const float rg = fast_sigmoid(R[r]), ig = fast_sigmoid(I[r]);
                    const float la = -rg * spc;
                    const float a = __builtin_amdgcn_exp2f(la * 1.4426950408889634f);
                    const float x2 = 2.0f * la;
                    float om = -x2 * (1.0f + x2 * (0.5f + x2 * (0.16666667f + x2 * (0.041666668f + x2 * (0.0083333338f + x2 * 0.0013888889f)))));
                    if (__builtin_expect(__any(x2 <= -0.25f), 0)) om = (x2 > -0.25f) ? om : (1.0f - a * a);
                    const float uu = __builtin_amdgcn_sqrtf(fmaxf(om, 0.f)) * (ig * X[r]);
                    H = a * H + uu; A *= a; ac[mt][r] = A; hq[mt][r] = H; }
                Ar[q] = A; Hr[q] = H; }
            float pA[4], pH[4];
#pragma unroll
            for (int q = 0; q < 4; ++q) { pA[q] = __shfl_xor(Ar[q], 32); pH[q] = __shfl_xor(Hr[q], 32); }
            float A = 1.f, H = 0.f;
#pragma unroll
            for (int q = 0; q < 4; ++q) {
                const float A0 = hi ? pA[q] : Ar[q], H0 = hi ? pH[q] : Hr[q], A1 = hi ? Ar[q] : pA[q], H1 = hi ? Hr[q] : pH[q];
                const float Hm = A0 * H + H0, Am = A * A0;
                const float cA = hi ? Am : A, cH = hi ? Hm : H;
#pragma unroll
                for (int k = 0; k < 4; ++k) { const int r = 4 * q + k; hq[mt][r] += ac[mt][r] * cH; ac[mt][r] *= cA; }
                H = A1 * Hm + H1; A = Am * A1;
            }
            if (hi == 0) AGG[(2 * wid + mt) * 32 + r32] = (f32x2){A, H};
            __builtin_amdgcn_sched_barrier(0);
        }
        __syncthreads();
        if (wid == 0 && lane < 32) {
            float A = 1.f, H = 0.f;
#pragma unroll
            for (int t = 0; t < 16; ++t) { PRE[t * 32 + lane] = (f32x2){A, H}; const f32x2 g = AGG[t * 32 + lane]; H = g.x * H + g.y; A *= g.x; }
            if (ck < 3) {
                __hip_atomic_store(carry + ((size_t)u * 64 + c) * 2, A, __ATOMIC_RELAXED, __HIP_MEMORY_SCOPE_AGENT);
                __hip_atomic_store(carry + ((size_t)u * 64 + c) * 2 + 1, H, __ATOMIC_RELAXED, __HIP_MEMORY_SCOPE_AGENT);
                asm volatile("s_waitcnt vmcnt(0)" ::: "memory");
                if (lane == 0) __hip_atomic_store(flags + (size_t)(fbase + u) * 2 + ct, 1u, __ATOMIC_RELEASE, __HIP_MEMORY_SCOPE_AGENT);
            }
            float cin = 0.f;
            for (int j = 0; j < ck; ++j) {
                const int uj = j * 64 + bh;
                unsigned* fp = flags + (size_t)(fbase + uj) * 2 + ct; unsigned sp = 0;
                while (__hip_atomic_load(fp, __ATOMIC_RELAXED, __HIP_MEMORY_SCOPE_AGENT) == 0u) { __builtin_amdgcn_s_sleep(2); if (++sp > (1u << 22)) break; }
                __builtin_amdgcn_fence(__ATOMIC_ACQUIRE, "agent");
                const float Aj = __hip_atomic_load(carry + ((size_t)uj * 64 + c) * 2, __ATOMIC_RELAXED, __HIP_MEMORY_SCOPE_AGENT);
                const float Hj = __hip_atomic_load(carry + ((size_t)uj * 64 + c) * 2 + 1, __ATOMIC_RELAXED, __HIP_MEMORY_SCOPE_AGENT);
                cin = Aj * cin + Hj;
            }
            CIN[lane] = cin;
        }
        __syncthreads();
        {
            const float cinc = CIN[r32];
#pragma unroll
            for (int mt = 0; mt < 2; ++mt) {
                const f32x2 p = PRE[(2 * wid + mt) * 32 + r32];
                const float cint = p.y + p.x * cinc;
                LAS bf16_t* gp = (LAS bf16_t*)(lds + L_XS + (wid * 64 + mt * 32) * XS_STRIDE) + c;
#pragma unroll
                for (int r = 0; r < 16; ++r) { LAS bf16_t* q = gp + att::crow(r, hi) * (XS_STRIDE / 2); const float hv = hq[mt][r] + ac[mt][r] * cint; *q = f2bf(hv * bf2f(*q)); }
            }
        }
    }
    __syncthreads();
    for (int i = tid >> 3; i < 512; i += 64)
        *(u32x4*)(GG + ((size_t)b * SEQ + s0 + i) * 512 + h * 64 + (tid & 7) * 8) = *(const LAS u32x4*)(lds + L_XS + i * XS_STRIDE + (tid & 7) * 16);
    __syncthreads();
}
}

namespace cv {
constexpr int L_XS = 0, L_YB = 63488, YB_STRIDE = 516, L_END = L_YB + 32 * YB_STRIDE * 4;
__device__ __forceinline__ void conv_unit(int u, const bf16_t* PC, bf16_t* AC, const float* dw_w, const float* dw_b, const float* ln_g, const float* ln_b,
                                          const bf16_t* KPE, bf16_t* KR, const float* CS, LAS unsigned char* lds) {
    int tid_ = threadIdx.x; asm volatile("" : "+v"(tid_));
    const int tid = tid_, lane = tid & 63;
    const int wid = __builtin_amdgcn_readfirstlane(tid >> 6);
    const int m0 = u * 32, b = m0 >> 11, s0 = m0 & 2047;
    unsigned z0_ = 0u; asm volatile("" : "+v"(z0_));
    { u32x4 st[8];
#pragma unroll
      for (int k = 0; k < 8; ++k) { const int i = (tid >> 6) + 8 * k, s = s0 - 30 + i; st[k] = (u32x4){z0_, z0_, z0_, z0_};
          if (i < 62 && s >= 0) st[k] = *(const u32x4*)(PC + ((size_t)b * SEQ + s) * 512 + (tid & 63) * 8); }
#pragma unroll
      for (int k = 0; k < 8; ++k) { const int i = (tid >> 6) + 8 * k; if (i < 62) *(LAS u32x4*)(lds + L_XS + i * 1024 + (tid & 63) * 16) = st[k]; } }
    { const int tok = tid >> 4, j = tid & 15; const size_t m = (size_t)m0 + tok;
      const float x1 = bf2f(KPE[m * 32 + j]), x2 = bf2f(KPE[m * 32 + 16 + j]); const float cs = CS[m * 32 + j], sn = CS[m * 32 + 16 + j];
      KR[m * 32 + j] = f2bf(x1 * cs - x2 * sn); KR[m * 32 + 16 + j] = f2bf(x2 * cs + x1 * sn); }
    __syncthreads();
    {
        const int ch = tid;
        float w[31];
#pragma unroll
        for (int j = 0; j < 31; ++j) w[j] = dw_w[j * 512 + ch];
        const float bias = dw_b[ch];
        const LAS bf16_t* xs = (const LAS bf16_t*)(lds + L_XS) + ch;
        LAS float* YB = (LAS float*)(lds + L_YB);
#pragma unroll 1
        for (int g = 0; g < 4; ++g) {
            float x[38];
#pragma unroll
            for (int k = 0; k < 38; ++k) x[k] = bf2f(xs[(8 * g + k) * 512]);
#pragma unroll
            for (int o = 0; o < 8; ++o) { float y = bias;
#pragma unroll
                for (int j = 0; j < 31; ++j) y += w[j] * x[o + j];
                YB[(8 * g + o) * YB_STRIDE + ch] = y; }
        }
    }
    __syncthreads();
    {
        const LAS float* YB = (const LAS float*)(lds + L_YB);
        const f32x4 g0 = *(const f32x4*)(ln_g + lane * 8), g1 = *(const f32x4*)(ln_g + lane * 8 + 4), b0 = *(const f32x4*)(ln_b + lane * 8), b1 = *(const f32x4*)(ln_b + lane * 8 + 4);
#pragma unroll
        for (int k = 0; k < 4; ++k) {
            const int tok = wid * 4 + k;
            f32x4 a = *(const LAS f32x4*)(YB + tok * YB_STRIDE + lane * 8), c = *(const LAS f32x4*)(YB + tok * YB_STRIDE + lane * 8 + 4);
            const float mean = wave_sum((a[0] + a[1]) + (a[2] + a[3]) + (c[0] + c[1]) + (c[2] + c[3])) * (1.0f / 512.0f);
            a = a - mean; c = c - mean;
            const float var = wave_sum((a[0] * a[0] + a[1] * a[1]) + (a[2] * a[2] + a[3] * a[3]) + (c[0] * c[0] + c[1] * c[1]) + (c[2] * c[2] + c[3] * c[3])) * (1.0f / 512.0f);
            const float rstd = rsqrtf(var + EPS);
            a = a * rstd * g0 + b0; c = c * rstd * g1 + b1;
#pragma unroll
            for (int i = 0; i < 4; ++i) { a[i] = a[i] * fast_sigmoid(a[i]); c[i] = c[i] * fast_sigmoid(c[i]); }
            *(u32x4*)(AC + ((size_t)m0 + tok) * 512 + lane * 8) = pg8::pack8(a, c);
        }
    }
    __syncthreads();
}
}

#define XB_TMO      128
#define XB_XCNT(j)  (256  + 64 * (j))
#define XB_XSUB(j)  (1280 + 64 * (j))
#define XB_XGEN(j)  (2304 + 64 * (j))
#define XB_TOP      3328
#define XB_TOPGEN   3392
#define XCD_BAR_WORDS 3456
#define XB_SPIN_CAP (1u << 18)
__device__ __forceinline__ unsigned xb_ld(unsigned* p)              { return __hip_atomic_load(p, __ATOMIC_RELAXED, __HIP_MEMORY_SCOPE_AGENT); }
__device__ __forceinline__ unsigned xb_add(unsigned* p, unsigned v) { return __hip_atomic_fetch_add(p, v, __ATOMIC_RELAXED, __HIP_MEMORY_SCOPE_AGENT); }
__device__ __forceinline__ unsigned xb_xcc_id() { return (unsigned)__builtin_amdgcn_s_getreg((3 << 11) | 20) & 0xFu; }
#define XB_SPIN(cond, bar) do { unsigned _sp = 0; while (cond) { __builtin_amdgcn_s_sleep(1); \
    if ((++_sp & 255u) == 0u) { if (xb_ld(&(bar)[XB_TMO])) break; if (_sp > XB_SPIN_CAP) { atomicAdd(&(bar)[XB_TMO], 1u); break; } } } } while (0)
struct XcdBarrier { unsigned* bar; unsigned x; volatile LAS unsigned* st; };
__device__ __forceinline__ XcdBarrier xcd_barrier_post(unsigned* bar, volatile LAS unsigned* st) {
    XcdBarrier b; b.bar = bar; b.x = xb_xcc_id(); b.st = st;
    if (threadIdx.x == 0) (void)xb_add(&bar[XB_XCNT(b.x)], 1u);
    return b;
}
__device__ __forceinline__ void xcd_barrier_complete(unsigned* bar, unsigned x, unsigned& nloc, unsigned& nx) {
    const unsigned G = gridDim.x * gridDim.y * gridDim.z;
    unsigned sum, cnt, mine, sp = 0u;
    for (;;) {
        sum = 0u; cnt = 0u; mine = 0u;
#pragma unroll 1
        for (unsigned j = 0; j < 16; ++j) { const unsigned c = xb_ld(&bar[XB_XCNT(j)]); sum += c; cnt += (c > 0u) ? 1u : 0u; mine = (j == x) ? c : mine; }
        if (sum == G) break;
        __builtin_amdgcn_s_sleep(1);
        if ((++sp & 255u) == 0u) { if (xb_ld(&bar[XB_TMO])) break; if (sp > XB_SPIN_CAP) { atomicAdd(&bar[XB_TMO], 1u); break; } }
    }
    nloc = mine > 0u ? mine : 1u; nx = cnt > 0u ? cnt : 1u;
}
__device__ __forceinline__ void xcd_barrier(const XcdBarrier& b) {
    asm volatile("s_waitcnt vmcnt(0)" ::: "memory");
    __syncthreads();
    if (threadIdx.x == 0) {
        unsigned* bar = b.bar; asm volatile("" : "+s"(bar));
        __builtin_amdgcn_s_waitcnt(0);
        unsigned nloc = b.st[0], nx = b.st[1];
        if (nloc == 0u) { xcd_barrier_complete(bar, b.x, nloc, nx); b.st[0] = nloc; b.st[1] = nx; }
        const unsigned old = xb_add(&bar[XB_XSUB(b.x)], 1u);
        const unsigned gen = old / nloc;
        if (old + 1u == (gen + 1u) * nloc) {
            __builtin_amdgcn_fence(__ATOMIC_RELEASE, "agent");
            asm volatile("s_waitcnt vmcnt(0)" ::: "memory");
            const unsigned og = xb_add(&bar[XB_TOP], 1u);
            const unsigned tg = og / nx;
            if (og + 1u == (tg + 1u) * nx) xb_add(&bar[XB_TOPGEN], 1u);
            else XB_SPIN(xb_ld(&bar[XB_TOPGEN]) == tg, bar);
            __builtin_amdgcn_fence(__ATOMIC_ACQUIRE, "agent");
            xb_add(&bar[XB_XGEN(b.x)], 1u);
            asm volatile("s_waitcnt vmcnt(0)" ::: "memory");
        } else {
            XB_SPIN(xb_ld(&bar[XB_XGEN(b.x)]) == gen, bar);
            __builtin_amdgcn_fence(__ATOMIC_ACQUIRE, "agent");
            asm volatile("s_waitcnt vmcnt(0)" ::: "memory");
        }
    }
    __syncthreads();
}

constexpr size_t MiB = 1u << 20;
constexpr size_t WS_SSA = 0, WS_SSB = 1 * MiB, WS_SSQ = 2 * MiB, WS_SSKV = 3 * MiB, WS_BIASP = 3 * MiB + 512 * 1024, WS_BAR = 3 * MiB + 768 * 1024, BAR_ZERO_BYTES = 32768, WS_LFLAG = WS_BAR + 16384, WS_SPLITF = WS_BAR + 24576, WS_LCARRY = WS_BAR + 32768, WS_W = 4 * MiB, WS_XB = 55 * MiB, WS_R1 = 87 * MiB;
constexpr size_t WS_GG = 183 * MiB, WS_AC = 199 * MiB, WS_CQ = 215 * MiB, WS_Q = 227 * MiB, WS_KPE = 251 * MiB, WS_KR = 252 * MiB, WS_CS = 253 * MiB, WS_END = 255 * MiB;
constexpr size_t WS_CKV = WS_W;
constexpr size_t W_F1W1 = 0, W_F1W2 = 11 * MiB, W_F2W1 = 16 * MiB + 512 * 1024, W_F2W2 = 27 * MiB + 512 * 1024, W_IN = 33 * MiB, W_LRUO = 44 * MiB + 512 * 1024,
                 W_UQ = 45 * MiB + 512 * 1024, W_UKV = 46 * MiB + 256 * 1024, W_MLAO = 46 * MiB + 768 * 1024, W_CONVO = 47 * MiB + 768 * 1024, W_OUT = 48 * MiB + 768 * 1024;
constexpr size_t DO_XPRE = 0, DO_PC = 16 * MiB, DO_KN = 32 * MiB, DO_V = 48 * MiB, DO_O = 0, DO_MERGED = 32 * MiB;
constexpr int LDS_BYTES = 147456, LDS_BARST = LDS_BYTES - 64;
static_assert(att::L_END <= LDS_BARST && lru::L_END <= LDS_BARST && cv::L_END <= LDS_BARST && pg8::STAGE_BYTES <= LDS_BARST && XCD_BAR_WORDS * 4 <= BAR_ZERO_BYTES, "LDS / barrier map");
static_assert(att::L_END <= LDS_BYTES && lru::L_END <= LDS_BYTES && cv::L_END <= LDS_BYTES && pg8::STAGE_BYTES <= LDS_BYTES, "LDS");

__device__ const float INVF[16] = {1.0f, 0.5623413251903491f, 0.31622776601683794f, 0.1778279410038923f, 0.1f, 0.05623413251903491f, 0.031622776601683794f, 0.01778279410038923f,
                                   0.01f, 0.005623413251903491f, 0.0031622776601683794f, 0.001778279410038923f, 0.001f, 0.0005623413251903491f, 0.00031622776601683794f, 0.0001778279410038923f};

__device__ __forceinline__ int dest_row(int kind, int n0) {
    if (kind == 1) { if (n0 < FF) return 256 * (n0 / 128) + (n0 % 128); const int n1 = n0 - FF; return 256 * (n1 / 128) + 128 + (n1 % 128); }
    if (kind == 2) {
        if (n0 < 1696) return n0;
        if (n0 < 2208) { const int v = n0 - 1696; return 1792 + 256 * (v / 128) + (v % 128); }
        if (n0 < 2720) { const int v = n0 - 2208; return 1792 + 256 * (v / 128) + 128 + (v % 128); }
        return 2816 + (n0 - 2720);
    }
    return n0;
}
__device__ __forceinline__ void cvt_item(const float* W, int K, int N, bf16_t* WT, int kind, const float* gk, LAS float* scr, int item, int lane) {
    const int nblk = N / 32, kb = item / nblk, nb = item % nblk, k0 = 64 * kb, n0 = 32 * nb;
#pragma unroll 8
    for (int i = 0; i < 32; ++i) { const int kk = 2 * i + (lane >> 5); scr[kk * 33 + (lane & 31)] = __builtin_nontemporal_load(W + (size_t)(k0 + kk) * N + n0 + (lane & 31)); }
    asm volatile("s_waitcnt lgkmcnt(0)" ::: "memory");
    const int c = lane & 7; const int dr = dest_row(kind, n0);
    float gs[8];
#pragma unroll
    for (int i = 0; i < 8; ++i) gs[i] = gk ? gk[k0 + 8 * c + i] : 1.0f;
#pragma unroll
    for (int j = 0; j < 4; ++j) { const int n = (lane >> 3) + 8 * j; const LAS float* s = scr + (8 * c) * 33 + n;
        u32x4 o; o.x = cvt_pk_bf16(s[0 * 33] * gs[0], s[1 * 33] * gs[1]); o.y = cvt_pk_bf16(s[2 * 33] * gs[2], s[3 * 33] * gs[3]); o.z = cvt_pk_bf16(s[4 * 33] * gs[4], s[5 * 33] * gs[5]); o.w = cvt_pk_bf16(s[6 * 33] * gs[6], s[7 * 33] * gs[7]);
        *(u32x4*)(WT + (size_t)(dr + n) * K + k0 + 8 * c) = o; }
    asm volatile("s_waitcnt lgkmcnt(0)" ::: "memory");
}

#ifndef GASQ
#define GASQ __attribute__((address_space(1)))
#endif
__device__ __forceinline__ const float* gptr(const GASQ float* p) { asm volatile("" : "+s"(p)); return (const float*)p; }
struct KArgs { const void* in[30]; float* out; unsigned char* ws; int ph_lo, ph_hi; };

__global__ void __launch_bounds__(512, 2) fwd_kernel(KArgs a) {
    extern __shared__ __attribute__((aligned(16))) unsigned char lds_raw[];
    LAS unsigned char* lds = (LAS unsigned char*)lds_raw;
    cg::grid_group grid = cg::this_grid();
#define OPAQUE_TID int tid_ = threadIdx.x; asm volatile("" : "+v"(tid_)); const int tid = tid_, lane = tid & 63, wave = __builtin_amdgcn_readfirstlane(tid >> 6), gw = bid * 8 + wave;
#define CS ((float*)(ws_ + WS_CS))
#define BIASP ((float*)(ws_ + WS_BIASP))
#define XB ((bf16_t*)(ws_ + WS_XB))
#define HB ((bf16_t*)(ws_ + WS_R1))
#define GB ((bf16_t*)(ws_ + WS_R1))
#define GG ((bf16_t*)(ws_ + WS_GG))
#define AC ((bf16_t*)(ws_ + WS_AC))
#define CQ ((bf16_t*)(ws_ + WS_CQ))
#define CKV ((bf16_t*)(ws_ + WS_CKV))
#define QB ((bf16_t*)(ws_ + WS_Q))
#define KPE ((bf16_t*)(ws_ + WS_KPE))
#define KR ((bf16_t*)(ws_ + WS_KR))
#define XPRE ((bf16_t*)(do_ + DO_XPRE))
#define PC ((bf16_t*)(do_ + DO_PC))
#define KN ((bf16_t*)(do_ + DO_KN))
#define VB ((bf16_t*)(do_ + DO_V))
#define OB ((bf16_t*)(do_ + DO_O))
#define MG ((bf16_t*)(do_ + DO_MERGED))
#define WB (ws_ + WS_W)
    const int lo = a.ph_lo, hi = a.ph_hi;
    int ph = 0;
    if (threadIdx.x < 16) ((LAS unsigned*)(lds + LDS_BARST))[threadIdx.x] = 0u;
    __syncthreads();
    XcdBarrier xbar = xcd_barrier_post((unsigned*)(a.ws + WS_BAR), (volatile LAS unsigned*)(lds + LDS_BARST));
    if (hi < 0) grid.sync();
typedef const float* cfp_t; typedef unsigned char* ucp_t;
#define KAS __attribute__((address_space(4)))
#define GASQ __attribute__((address_space(1)))
#define PHASE_BEGIN if (ph >= lo && ph < hi) { int G = gridDim.x, bid = blockIdx.x; asm volatile("" : "+s"(G), "+s"(bid)); const int NGW = G * 8; (void)NGW;     \
    const KAS void* kp_ = (const KAS void*)__builtin_amdgcn_kernarg_segment_ptr(); asm volatile("" : "+s"(kp_)); \
    GASQ unsigned char* wsg_ = (GASQ unsigned char*)(((const KAS ucp_t*)kp_)[31]); GASQ unsigned char* dog_ = (GASQ unsigned char*)(((const KAS ucp_t*)kp_)[30]); asm volatile("" : "+s"(wsg_), "+s"(dog_)); \
    unsigned char* ws_ = (unsigned char*)wsg_; unsigned char* do_ = (unsigned char*)dog_;
#define PHASE_END   if (ph + 1 < hi) { for (int r_ = 0; r_ < REP_SYNC; ++r_) xcd_barrier(xbar); } } ++ph;
#define INF(i) (gptr((const GASQ float*)(((const KAS cfp_t*)kp_)[i])))

    for (int l = 0; l < 2; ++l) {
        PHASE_BEGIN
        {
            OPAQUE_TID
            LAS float* scr = (LAS float*)(lds + wave * 16384);
            const float* w1a = INF(3) + (size_t)l * DM * 5632; const float* w2a = INF(4) + (size_t)l * FF * DM;
            const float* w1b = INF(27) + (size_t)l * DM * 5632; const float* w2b = INF(28) + (size_t)l * FF * DM;
            const float* win = INF(6) + (size_t)l * DM * DIN;
            constexpr int I_W1 = 16 * 176, I_W2 = 44 * 32, I_IN = 16 * 181, I_LO = 8 * 32, I_UQ = 6 * 24, I_UKV = 4 * 32, I_OUT = 16 * 32;
            constexpr int NITEMS = 2 * I_W1 + 2 * I_W2 + I_IN + 3 * I_LO + I_UQ + I_UKV + I_OUT;
            for (int r_ = 0; r_ < REP_CVT; ++r_)
            for (int it = gw; it < NITEMS; it += NGW) {
                int r = it;
                if (r < I_W1) { cvt_item(w1a, DM, 5632, (bf16_t*)(WB + W_F1W1), 1, INF(2) + l * DM, scr, r, lane); continue; } r -= I_W1;
                if (r < I_W1) { cvt_item(w1b, DM, 5632, (bf16_t*)(WB + W_F2W1), 1, INF(26) + l * DM, scr, r, lane); continue; } r -= I_W1;
                if (r < I_IN) { cvt_item(win, DM, DIN, (bf16_t*)(WB + W_IN), 2, INF(5) + l * DM, scr, r, lane); continue; } r -= I_IN;
                if (r < I_W2) { cvt_item(w2a, FF, DM, (bf16_t*)(WB + W_F1W2), 0, nullptr, scr, r, lane); continue; } r -= I_W2;
                if (r < I_W2) { cvt_item(w2b, FF, DM, (bf16_t*)(WB + W_F2W2), 0, nullptr, scr, r, lane); continue; } r -= I_W2;
                if (r < I_OUT) { cvt_item(INF(25) + (size_t)l * DM * DM, DM, DM, (bf16_t*)(WB + W_OUT), 0, nullptr, scr, r, lane); continue; } r -= I_OUT;
                if (r < I_LO) { cvt_item(INF(13) + (size_t)l * 512 * DM, 512, DM, (bf16_t*)(WB + W_LRUO), 0, nullptr, scr, r, lane); continue; } r -= I_LO;
                if (r < I_LO) { cvt_item(INF(18) + (size_t)l * 512 * DM, 512, DM, (bf16_t*)(WB + W_MLAO), 0, nullptr, scr, r, lane); continue; } r -= I_LO;
                if (r < I_LO) { cvt_item(INF(23) + (size_t)l * 512 * DM, 512, DM, (bf16_t*)(WB + W_CONVO), 0, nullptr, scr, r, lane); continue; } r -= I_LO;
                if (r < I_UQ) { cvt_item(INF(15) + (size_t)l * 384 * 768, 384, 768, (bf16_t*)(WB + W_UQ), 0, INF(14) + l * 384, scr, r, lane); continue; } r -= I_UQ;
                cvt_item(INF(17) + (size_t)l * 256 * 1024, 256, 1024, (bf16_t*)(WB + W_UKV), 0, INF(16) + l * 256, scr, r, lane);
            }
            { u32x4* z = (u32x4*)((bf16_t*)(WB + W_IN) + (size_t)1696 * DM); for (int i = bid * 512 + tid; i < 96 * DM / 8; i += G * 512) { unsigned zz = 0u; asm volatile("" : "+v"(zz)); z[i] = (u32x4){zz, zz, zz, zz}; } }
            if (l == 0) {
                const float* x = INF(0);
                for (int m = gw; m < MROWS; m += NGW) {
                    const f32x4* xr = (const f32x4*)(x + (size_t)m * DM) + lane; float s = 0.f; f32x4 v[4];
#pragma unroll
                    for (int j = 0; j < 4; ++j) { v[j] = __builtin_nontemporal_load(xr + 64 * j); s += (v[j][0] * v[j][0] + v[j][1] * v[j][1]) + (v[j][2] * v[j][2] + v[j][3] * v[j][3]); }
                    s = wave_sum(s);
                    u32x2* o8 = (u32x2*)(XB + (size_t)m * DM) + lane;
#pragma unroll
                    for (int j = 0; j < 4; ++j) o8[64 * j] = (u32x2){cvt_pk_bf16(v[j][0], v[j][1]), cvt_pk_bf16(v[j][2], v[j][3])};
                    if (lane < 16) ((float*)(ws_ + WS_SSA))[(size_t)m * 16 + lane] = (lane == 0) ? s : 0.f;
                }
                const int* pos = (const int*)INF(1);
                for (int i = bid * 512 + tid; i < MROWS * 16; i += G * 512) { const int m = i >> 4, j = i & 15;
                    const float ang = (float)pos[m] * INVF[j];
                    double t = (double)ang * 0.15915494309189535; t -= rint(t); const float tf = (float)t;
                    CS[(size_t)m * 32 + j] = __builtin_amdgcn_cosf(tf); CS[(size_t)m * 32 + 16 + j] = __builtin_amdgcn_sinf(tf); }
                for (int i = bid * 512 + tid; i < 2 * DINP; i += G * 512) { const int ll = i / DINP, d = i % DINP; int n = -1;
                    if (d < 1696) n = d; else if (d < 1792) n = -1; else if (d < 2816) { const int t = d - 1792, p = t / 256, r = t % 256; n = (r < 128) ? (1696 + p * 128 + r) : (2208 + p * 128 + (r - 128)); } else n = 2720 + (d - 2816);
                    BIASP[i] = (n >= 0) ? INF(7)[(size_t)ll * DIN + n] : 0.f; }
            }
            __syncthreads();
        }
        PHASE_END

#define SSX(k) ((float*)(ws_ + ((((k) & 1) != 0) ? WS_SSB : WS_SSA)))
#define ss0 SSX(3 * l)
#define ss1 SSX(3 * l + 1)
#define ss2 SSX(3 * l + 2)
#define ss3 SSX(3 * l + 3)
#define ssq ((float*)(ws_ + WS_SSQ))
#define sskv ((float*)(ws_ + WS_SSKV))

        PHASE_BEGIN
#ifndef NO_G1
        for (int r_ = 0; r_ < REP_F1UP; ++r_) { pg8::Gemm g{XB, XB, XB, (bf16_t*)(WB + W_F1W1), nullptr, nullptr, MROWS, 5632, DM, DM}; pg8::StaticOrder S; S.init(MROWS, 5632, G, bid, 1, false);
          pg8::EpiUp E{HB, ss0}; pg8::gemm_phase<pg8::EpiUp, true>(lds, g, S, E);
          pg8::TailOrder T; T.init(MROWS, 5632, G, bid);
          if (T.on) { const int kh = T.half() * 512; pg8::Gemm gt{XB + kh, XB + kh, XB + kh, (bf16_t*)(WB + W_F1W1) + kh, nullptr, nullptr, MROWS, 5632, 512, DM};
              pg8::EpiUpTail Et{HB, ss0, (float*)do_, (unsigned*)(ws_ + WS_SPLITF) + (l * 2 + 0) * 128}; pg8::gemm_phase<pg8::EpiUpTail, true, pg8::TailOrder>(lds, gt, T, Et); } }
#endif
        PHASE_END
        PHASE_BEGIN
#ifndef NO_G2
        { pg8::Gemm g{HB, HB, HB, (bf16_t*)(WB + W_F1W2), nullptr, nullptr, MROWS, DM, FF, FF}; pg8::StaticOrder S; S.init(MROWS, DM, G, bid, 1);
          pg8::EpiRes E{XB, 0.5f, ss1, nullptr}; pg8::gemm_phase<pg8::EpiRes, true>(lds, g, S, E); }
#endif
        PHASE_END
        PHASE_BEGIN
#ifndef NO_G3
        for (int r_ = 0; r_ < REP_WIN; ++r_) { pg8::Gemm g{XB, XB, XB, (bf16_t*)(WB + W_IN), nullptr, nullptr, MROWS, DINP, DM, DM}; pg8::StaticOrder S; S.init(MROWS, DINP, G, bid, 1);
          pg8::EpiWin E{ss1, BIASP + l * DINP, XPRE, GG, CQ, CKV, KPE, PC, GB, ssq, sskv}; pg8::gemm_phase<pg8::EpiWin, true>(lds, g, S, E); }
#endif
        PHASE_END
        PHASE_BEGIN
#ifndef NO_G4
        for (int r_ = 0; r_ < REP_S4G; ++r_) { pg8::Gemm g{CQ, CQ, CQ, (bf16_t*)(WB + W_UQ), nullptr, nullptr, MROWS, 768, 384, 384}; pg8::StaticOrder S; S.init(MROWS, 768, G, bid, 1);
          pg8::EpiQ E{QB, ssq, CS}; pg8::gemm_phase<pg8::EpiQ, true>(lds, g, S, E); }
#endif
#ifndef NO_G4B
        for (int r_ = 0; r_ < REP_S4G; ++r_) { pg8::Gemm g{CKV, CKV, CKV, (bf16_t*)(WB + W_UKV), nullptr, nullptr, MROWS, 1024, 256, 256}; pg8::StaticOrder S; S.init(MROWS, 1024, G, bid, 1);
          pg8::EpiKV E{KN, VB, sskv}; pg8::gemm_phase<pg8::EpiKV, true>(lds, g, S, E); }
#endif
#ifndef NO_LRU
        for (int u = bid; u < 256; u += G)
            lru::lru_unit(u, l, XPRE, GG, INF(8) + l * 4 * 512, INF(9) + l * 512, INF(10) + (size_t)l * 8 * 64 * 128, INF(11) + l * 8 * 128, INF(12) + l * 512, (unsigned*)(ws_ + WS_LFLAG), (float*)(ws_ + WS_LCARRY), lds);
#endif
#ifndef NO_CONV
        for (int r_ = 0; r_ < REP_CONV; ++r_)
        for (int u = bid; u < 512; u += G)
            cv::conv_unit(u, PC, AC, INF(19) + l * 31 * 512, INF(20) + l * 512, INF(21) + l * 512, INF(22) + l * 512, KPE, KR, CS, lds);
#endif
        PHASE_END
        PHASE_BEGIN
#ifndef NO_ATT
        for (int r_ = 0; r_ < REP_ATT; ++r_)
        for (int u = ((G & 7) == 0 ? (bid & 7) * (G >> 3) + (bid >> 3) : bid); u < 256; u += G) { const int bh = u >> 2, s = u & 3;
            att::attn_block(bh >> 3, bh & 7, 7 - s, QB, KN, KR, VB, OB, lds);
            att::attn_block(bh >> 3, bh & 7, s, QB, KN, KR, VB, OB, lds); }
#endif
        PHASE_END
        PHASE_BEGIN
#ifndef NO_G6
        for (int r_ = 0; r_ < REP_MERGE; ++r_) { pg8::Gemm g{GG, OB, AC, (bf16_t*)(WB + W_LRUO), (bf16_t*)(WB + W_MLAO), (bf16_t*)(WB + W_CONVO), MROWS, DM, 512, 512}; pg8::StaticOrder S; S.init(MROWS, DM, G, bid, 3);
          pg8::EpiMerge E{GB, INF(24) + l * DM, MG}; pg8::gemm_phase<pg8::EpiMerge, true>(lds, g, S, E); }
#endif
        PHASE_END
        PHASE_BEGIN
#ifndef NO_G7
        { pg8::Gemm g{MG, MG, MG, (bf16_t*)(WB + W_OUT), nullptr, nullptr, MROWS, DM, DM, DM}; pg8::StaticOrder S; S.init(MROWS, DM, G, bid, 1);
          pg8::EpiRes E{XB, 1.0f, ss2, nullptr}; pg8::gemm_phase<pg8::EpiRes, true>(lds, g, S, E); }
#endif
        PHASE_END
        PHASE_BEGIN
#ifndef NO_G8
        { pg8::Gemm g{XB, XB, XB, (bf16_t*)(WB + W_F2W1), nullptr, nullptr, MROWS, 5632, DM, DM}; pg8::StaticOrder S; S.init(MROWS, 5632, G, bid, 1, false);
          pg8::EpiUp E{HB, ss2}; pg8::gemm_phase<pg8::EpiUp, true>(lds, g, S, E);
          pg8::TailOrder T; T.init(MROWS, 5632, G, bid);
          if (T.on) { const int kh = T.half() * 512; pg8::Gemm gt{XB + kh, XB + kh, XB + kh, (bf16_t*)(WB + W_F2W1) + kh, nullptr, nullptr, MROWS, 5632, 512, DM};
              pg8::EpiUpTail Et{HB, ss2, (float*)do_, (unsigned*)(ws_ + WS_SPLITF) + (l * 2 + 1) * 128}; pg8::gemm_phase<pg8::EpiUpTail, true, pg8::TailOrder>(lds, gt, T, Et); } }
#endif
        PHASE_END
        PHASE_BEGIN
#ifndef NO_G9
        { pg8::Gemm g{HB, HB, HB, (bf16_t*)(WB + W_F2W2), nullptr, nullptr, MROWS, DM, FF, FF}; pg8::StaticOrder S; S.init(MROWS, DM, G, bid, 1);
          pg8::EpiRes E{XB, 0.5f, ss3, (l == 1) ? (float*)do_ : nullptr}; pg8::gemm_phase<pg8::EpiRes, true>(lds, g, S, E); }
#endif
        PHASE_END
    }
    PHASE_BEGIN
    {
        OPAQUE_TID
        const float* ssf = (const float*)(ws_ + WS_SSA); const float* gf = INF(29);
        for (int m = gw; m < MROWS; m += NGW) {
            const float rs = rsqrtf(sum_slots16(ssf + (size_t)m * 16) * (1.0f / DM) + EPS);
            f32x4* xr = (f32x4*)((float*)do_ + (size_t)m * DM) + lane; const f32x4* gr = (const f32x4*)gf + lane;
#pragma unroll
            for (int j = 0; j < 4; ++j) xr[64 * j] = xr[64 * j] * rs * gr[64 * j];
        }
    }
    PHASE_END
}

constexpr int N_PHASES = 21;
#ifndef MK_PER_PHASE
#define MK_PER_PHASE 0
#endif

extern "C" void kernel_launch(void* const* d_in, const int* in_sizes, int n_in, void* d_out, int out_size, void* d_ws, size_t ws_size, hipStream_t stream) {
    static int grid = 0;
    if (grid == 0) {
        if (n_in != 30 || out_size != MROWS * DM || ws_size < WS_END) { fprintf(stderr, "kernel_launch: unexpected problem (n_in %d out %d ws %zu)\n", n_in, out_size, ws_size); grid = -1; return; }
        int dev = 0, cus = 0, per_cu = 0;
        hipGetDevice(&dev); hipDeviceGetAttribute(&cus, hipDeviceAttributeMultiprocessorCount, dev);
        hipFuncSetAttribute((const void*)fwd_kernel, hipFuncAttributeMaxDynamicSharedMemorySize, LDS_BYTES);
        hipOccupancyMaxActiveBlocksPerMultiprocessor(&per_cu, (const void*)fwd_kernel, 512, LDS_BYTES);
        if (per_cu < 1) { fprintf(stderr, "kernel_launch: occupancy query says %d blocks per CU\n", per_cu); per_cu = 1; }
        (void)hipGetLastError();
        grid = cus * 1;
    }
    if (grid < 0) return;
    hipMemsetAsync((char*)d_ws + WS_BAR, 0, BAR_ZERO_BYTES, stream);
    KArgs a{};
    for (int i = 0; i < 30; ++i) a.in[i] = d_in[i];
    a.out = (float*)d_out; a.ws = (unsigned char*)d_ws;
#if MK_PER_PHASE
    for (int p = 0; p < N_PHASES; ++p) { a.ph_lo = p; a.ph_hi = p + 1; hipLaunchKernelGGL(fwd_kernel, dim3(grid), dim3(512), LDS_BYTES, stream, a); }
#else
    a.ph_lo = 0; a.ph_hi = N_PHASES;
    void* args[] = {&a};
    hipError_t e = hipLaunchCooperativeKernel((const void*)fwd_kernel, dim3(grid), dim3(512), args, LDS_BYTES, stream);
    if (e != hipSuccess) fprintf(stderr, "cooperative launch failed: %s (grid %d)\n", hipGetErrorString(e), grid);
#endif
}
```

```cpp
#include <hip/hip_runtime.h>
#include <hip/hip_cooperative_groups.h>
#include <cstdio>
#include <cstdint>
namespace cg = cooperative_groups;

#define LAS __attribute__((address_space(3)))
typedef unsigned short bf16_t;
typedef short bf16x8 __attribute__((ext_vector_type(8)));
typedef short s16x4 __attribute__((ext_vector_type(4)));
typedef float f32x2 __attribute__((ext_vector_type(2)));
typedef float f32x4 __attribute__((ext_vector_type(4)));
typedef float f32x16 __attribute__((ext_vector_type(16)));
typedef unsigned u32x2 __attribute__((ext_vector_type(2)));
typedef unsigned u32x4 __attribute__((ext_vector_type(4)));

#ifndef REP_ATT
#define REP_ATT 1
#endif
#ifndef REP_F1UP
#define REP_F1UP 1
#endif
#ifndef REP_WIN
#define REP_WIN 1
#endif
#ifndef REP_S4G
#define REP_S4G 1
#endif
#ifndef REP_CONV
#define REP_CONV 1
#endif
#ifndef REP_MERGE
#define REP_MERGE 1
#endif
#ifndef REP_SYNC
#define REP_SYNC 1
#endif
#ifndef REP_CVT
#define REP_CVT 1
#endif
#ifndef REP_LRU
#define REP_LRU 1
#endif
constexpr int MROWS = 16384, DM = 1024, FF = 2816, SEQ = 2048, NB = 8;
constexpr int DIN = 5792, DINP = 5888;
constexpr float EPS = 1e-6f;
constexpr float QSCALE = 0.10206207261596577f * 1.4426950408889634f;

__device__ __forceinline__ unsigned cvt_pk_bf16(float lo, float hi) { unsigned r; asm volatile("v_cvt_pk_bf16_f32 %0, %1, %2" : "=v"(r) : "v"(lo), "v"(hi)); return r; }
__device__ __forceinline__ float bflo(unsigned w) { return __uint_as_float(w << 16); }
__device__ __forceinline__ float bfhi(unsigned w) { return __uint_as_float(w & 0xffff0000u); }
__device__ __forceinline__ float bf2f(bf16_t v) { return __uint_as_float(((unsigned)v) << 16); }
__device__ __forceinline__ bf16_t f2bf(float f) { return (bf16_t)(cvt_pk_bf16(f, 0.f) & 0xffffu); }
__device__ __forceinline__ float fast_sigmoid(float x) { return __builtin_amdgcn_rcpf(1.0f + __builtin_amdgcn_exp2f(-1.4426950408889634f * x)); }
__device__ __forceinline__ float wave_sum(float v) {
#pragma unroll
    for (int o = 1; o < 64; o <<= 1) v += __shfl_xor(v, o);
    return v;
}

__device__ __forceinline__ float sum_slots16(const float* p) { const f32x4 a = *(const f32x4*)p, b = *(const f32x4*)(p + 4), c = *(const f32x4*)(p + 8), d = *(const f32x4*)(p + 12);
    return (((a[0] + a[1]) + (a[2] + a[3])) + ((b[0] + b[1]) + (b[2] + b[3]))) + (((c[0] + c[1]) + (c[2] + c[3])) + ((d[0] + d[1]) + (d[2] + d[3]))); }
__device__ __forceinline__ float sum_slots12(const float* p) { const f32x4 a = *(const f32x4*)p, b = *(const f32x4*)(p + 4), c = *(const f32x4*)(p + 8);
    return (((a[0] + a[1]) + (a[2] + a[3])) + ((b[0] + b[1]) + (b[2] + b[3]))) + ((c[0] + c[1]) + (c[2] + c[3])); }
__device__ __forceinline__ float sum_slots8(const float* p) { const f32x4 a = *(const f32x4*)p, b = *(const f32x4*)(p + 4);
    return ((a[0] + a[1]) + (a[2] + a[3])) + ((b[0] + b[1]) + (b[2] + b[3])); }

namespace pg8 {
constexpr int BM = 256, BK = 64, HALF = 128, HTB = HALF * BK * 2, STAGE_BYTES = 8 * HTB, NXCD = 8, WGM = 4;
__host__ __device__ __forceinline__ int lds_byte(int r, int c) { const int st = (r >> 4) * 2 + (c >> 5), rr = r & 15, cc = c & 31, ob = rr * 64 + cc * 2; return st * 1024 + (ob ^ (((ob >> 9) & 1) << 5)); }
__host__ __device__ __forceinline__ void stage_rc(int b, int& R, int& C) { const int st = b / 1024, sb = b % 1024, swz = sb ^ (((sb >> 9) & 1) << 5); R = (st >> 1) * 16 + swz / 64; C = (st & 1) * 32 + (swz % 64) / 2; }
__host__ __device__ __forceinline__ int perm32(int rho) { const int n = rho >> 4, i = rho & 15; return 8 * (i >> 2) + 4 * n + (i & 3); }

struct Unit { int pm, pn, seg, split, slot; };
struct Gemm { const bf16_t *A0, *A1, *A2; const bf16_t *B0, *B1, *B2; int M, N, K, LD;
    __device__ __forceinline__ const char* a(int s) const { return (const char*)(s == 0 ? A0 : (s == 1 ? A1 : A2)); }
    __device__ __forceinline__ const char* b(int s) const { return (const char*)(s == 0 ? B0 : (s == 1 ? B1 : B2)); } };

__device__ __forceinline__ void unit_of(int L, int nwg, int nM, int nN, Unit& u) {
    int wgid = L; { const int q = nwg / NXCD, r = nwg % NXCD, xcd = wgid % NXCD, off = wgid / NXCD; wgid = (xcd < r ? xcd * (q + 1) : r * (q + 1) + (xcd - r) * q) + off; }
    const int nig = WGM * nN, gid = wgid / nig, fm = gid * WGM, gsz = (nM - fm) < WGM ? (nM - fm) : WGM;
    u.pm = fm + ((wgid % nig) % gsz); u.pn = (wgid % nig) / gsz;
}
struct StaticOrder {
    int nM, nN, nwg, G, c, nseg, nlim;
    __device__ __forceinline__ void init(int M, int N, int G_, int c_, int nseg_, bool split_tail = false) { nM = M / BM; nN = N / BM; nwg = nM * nN; G = G_; c = c_; nseg = nseg_;
        nlim = (split_tail && 2 * (nwg % G_) == G_) ? (nwg / G_) * G_ : nwg; }
    __device__ __forceinline__ bool next(int i, Unit& u) const {
        const int ti = i / nseg; u.seg = i - ti * nseg; u.split = 0; u.slot = 0;
        const long L = (long)ti * G + c; if (L >= nlim) return false;
        unit_of((int)L, nwg, nM, nN, u); return true;
    }
};
struct TailOrder {
    int nM, nN, nwg, G, c, on;
    __device__ __forceinline__ void init(int M, int N, int G_, int c_) { nM = M / BM; nN = N / BM; nwg = nM * nN; G = G_; c = c_; on = 0; (void)G_; }
    __device__ __forceinline__ int half() const { return (c >= (G >> 1)) ? 1 : 0; }
    __device__ __forceinline__ bool next(int i, Unit& u) const {
        if (!on || i != 0) return false;
        u.seg = 0; u.slot = c - half() * (G >> 1); u.split = 1 + half();
        unit_of((nwg / G) * G + u.slot, nwg, nM, nN, u); return true;
    }
};

template <class Epi, bool ALIGN_EPI, class Order = StaticOrder>
__device__ __forceinline__ void gemm_phase(LAS unsigned char* lds, const Gemm g, const Order& S, const Epi& E) {
    int tid_ = threadIdx.x; asm volatile("" : "+v"(tid_));
    const int tid = tid_, wid = __builtin_amdgcn_readfirstlane(tid >> 6), lane = tid & 63, wr = wid >> 2, wc = wid & 3, fr = lane & 15, fq = lane >> 4;
    const int K = g.LD, nt = g.K / BK;
    const char *gA0 = (const char*)g.A0, *gA1 = (const char*)g.A1, *gA2 = (const char*)g.A2, *gB0 = (const char*)g.B0, *gB1 = (const char*)g.B1, *gB2 = (const char*)g.B2;
    asm volatile("" : "+s"(gA0), "+s"(gA1), "+s"(gA2), "+s"(gB0), "+s"(gB1), "+s"(gB2));
#define PG8_SELA(s) ((s) == 0 ? gA0 : ((s) == 1 ? gA1 : gA2))
#define PG8_SELB(s) ((s) == 0 ? gB0 : ((s) == 1 ? gB1 : gB2))
    unsigned voffA[2], voffB[2];
#pragma unroll
    for (int i = 0; i < 2; ++i) { int R, C; stage_rc(tid * 16 + i * 8192, R, C); const int Rb = Epi::PERM ? ((R & ~31) + perm32(R & 31)) : R;
        voffA[i] = (unsigned)(R * K + C) * 2u; voffB[i] = (unsigned)(Rb * K + C) * 2u; }
    const size_t kstep = (size_t)(BK * 2);
    const size_t hstep = (size_t)HALF * K * 2;
    const size_t tstep = 2 * hstep;
    const unsigned ldsw = (unsigned)wid * 1024u;
    const int aoff = lds_byte(wr * 64 + fr, fq * 8), boff = lds_byte(wc * 32 + fr, fq * 8);
#define PG8_SA(b, h) (((b) * 2 + (h)) * HTB)
#define PG8_SB(b, h) ((4 + (b) * 2 + (h)) * HTB)
#define PG8_STAGE(bufoff, gbase, voff) do { _Pragma("unroll") for (int _i = 0; _i < 2; ++_i) \
        __builtin_amdgcn_global_load_lds((const unsigned*)((const char*)(gbase) + (voff)[_i]), (LAS unsigned*)(lds + (bufoff) + ldsw + _i * 8192), 16, 0, 0); } while (0)
#define PG8_LDA(dst, b, h) do { _Pragma("unroll") for (int m = 0; m < 4; ++m) _Pragma("unroll") for (int k = 0; k < 2; ++k) dst[m][k] = *(const LAS bf16x8*)(lds + PG8_SA(b, h) + aoff + m * 2048 + k * 1024); } while (0)
#define PG8_LDB(dst, b, h) do { _Pragma("unroll") for (int n = 0; n < 2; ++n) _Pragma("unroll") for (int k = 0; k < 2; ++k) dst[n][k] = *(const LAS bf16x8*)(lds + PG8_SB(b, h) + boff + n * 2048 + k * 1024); } while (0)
#define PG8_MMA(ai, bj, At, Bt) do { __builtin_amdgcn_s_setprio(1); _Pragma("unroll") for (int m = 0; m < 4; ++m) _Pragma("unroll") for (int n = 0; n < 2; ++n) _Pragma("unroll") for (int k = 0; k < 2; ++k) \
        acc[ai][bj][m][n] = __builtin_amdgcn_mfma_f32_16x16x32_bf16(Bt[n][k], At[m][k], acc[ai][bj][m][n], 0, 0, 0); __builtin_amdgcn_s_setprio(0); } while (0)
#define PG8_WAIT_V(n) asm volatile("s_waitcnt vmcnt(" #n ")" ::: "memory")
#define PG8_WAIT_L(n) asm volatile("s_waitcnt lgkmcnt(" #n ")" ::: "memory")
#define PG8_BAR __builtin_amdgcn_s_barrier()
#define PG8_SCHED __builtin_amdgcn_sched_barrier(0)
    Unit cur, nxt; int ui = 0;
    if (!S.next(0, cur)) return;
    f32x4 acc[2][2][4][2];
#pragma unroll
    for (int a = 0; a < 2; ++a)
#pragma unroll
        for (int b = 0; b < 2; ++b)
#pragma unroll
            for (int m = 0; m < 4; ++m)
#pragma unroll
                for (int n = 0; n < 2; ++n) acc[a][b][m][n] = (f32x4){0.f, 0.f, 0.f, 0.f};
    bf16x8 At[4][2], B0[2][2], B1[2][2];
    const char* cA = PG8_SELA(cur.seg) + (size_t)cur.pm * tstep; const char* cB = PG8_SELB(cur.seg) + (size_t)cur.pn * tstep;
    PG8_STAGE(PG8_SB(0, 0), cB, voffB); PG8_STAGE(PG8_SB(0, 1), cB + hstep, voffB); PG8_STAGE(PG8_SA(0, 0), cA, voffA); PG8_STAGE(PG8_SA(0, 1), cA + hstep, voffA);
    if (wr == 1) PG8_BAR;
    PG8_WAIT_V(2); PG8_BAR;
    PG8_STAGE(PG8_SB(1, 0), cB + kstep, voffB); PG8_STAGE(PG8_SA(1, 0), cA + kstep, voffA); PG8_STAGE(PG8_SB(1, 1), cB + hstep + kstep, voffB);
    PG8_WAIT_V(6); PG8_BAR;
    for (;;) {
        const bool has_next = S.next(ui + 1, nxt);
        const char* nA = has_next ? PG8_SELA(nxt.seg) + (size_t)nxt.pm * tstep : cA; const char* nB = has_next ? PG8_SELB(nxt.seg) + (size_t)nxt.pn * tstep : cB;
#pragma unroll 1
        for (int t = 0; t < nt; t += 2) {
            const bool last = (t == nt - 2);
            const char* a1 = cA + (size_t)(t + 1) * kstep;
            const char* a2 = last ? nA : cA + (size_t)(t + 2) * kstep; const char* b2 = last ? nB : cB + (size_t)(t + 2) * kstep;
            const char* a3 = a2 + kstep; const char* b3 = b2 + kstep;
            PG8_LDB(B0, 0, 0); PG8_LDB(B1, 0, 1); PG8_SCHED; PG8_LDA(At, 0, 0); PG8_STAGE(PG8_SA(1, 1), a1 + hstep, voffA);
            PG8_WAIT_V(8); PG8_WAIT_L(0); PG8_BAR; PG8_MMA(0, 0, At, B0); PG8_MMA(0, 1, At, B1); PG8_BAR; PG8_SCHED;
            PG8_LDA(At, 0, 1); PG8_STAGE(PG8_SB(0, 0), b2, voffB); PG8_STAGE(PG8_SB(0, 1), b2 + hstep, voffB); PG8_STAGE(PG8_SA(0, 0), a2, voffA);
            PG8_WAIT_V(8); PG8_WAIT_L(0); PG8_BAR; PG8_MMA(1, 0, At, B0); PG8_MMA(1, 1, At, B1); PG8_BAR; PG8_SCHED;
            PG8_LDB(B0, 1, 0); PG8_LDB(B1, 1, 1); PG8_SCHED; PG8_LDA(At, 1, 0); PG8_STAGE(PG8_SA(0, 1), a2 + hstep, voffA);
            PG8_WAIT_V(8); PG8_WAIT_L(0); PG8_BAR; PG8_MMA(0, 0, At, B0); PG8_MMA(0, 1, At, B1); PG8_BAR; PG8_SCHED;
            PG8_LDA(At, 1, 1); PG8_STAGE(PG8_SB(1, 0), b3, voffB); PG8_STAGE(PG8_SB(1, 1), b3 + hstep, voffB); PG8_STAGE(PG8_SA(1, 0), a3, voffA);
            PG8_WAIT_V(8); PG8_WAIT_L(0); PG8_BAR; PG8_MMA(1, 0, At, B0); PG8_MMA(1, 1, At, B1); PG8_BAR; PG8_SCHED;
        }
        if constexpr (ALIGN_EPI) { if (wr == 0) PG8_BAR; }
        const bool zero = E(acc, cur, wr, wc, fr, fq);
        if (!has_next) break;
        if (zero) {
#pragma unroll
            for (int a = 0; a < 2; ++a)
#pragma unroll
                for (int b = 0; b < 2; ++b)
#pragma unroll
                    for (int m = 0; m < 4; ++m)
#pragma unroll
                        for (int n = 0; n < 2; ++n) acc[a][b][m][n] = (f32x4){0.f, 0.f, 0.f, 0.f};
        }
        cur = nxt; cA = nA; cB = nB; ++ui;
        if constexpr (ALIGN_EPI) { if (wr == 1) PG8_BAR; }
    }
    PG8_WAIT_V(0);
    if constexpr (!ALIGN_EPI) { if (wr == 0) PG8_BAR; }
    PG8_BAR;
#undef PG8_SA
#undef PG8_SB
#undef PG8_STAGE
#undef PG8_LDA
#undef PG8_LDB
#undef PG8_MMA
#undef PG8_WAIT_V
#undef PG8_WAIT_L
#undef PG8_BAR
#undef PG8_SCHED
}

#define EPI_ROW(ai, m) (u.pm * BM + (ai) * HALF + wr * 64 + (m) * 16 + fr)
__device__ __forceinline__ u32x4 pack8(const f32x4 a, const f32x4 b) { u32x4 w; w.x = cvt_pk_bf16(a[0], a[1]); w.y = cvt_pk_bf16(a[2], a[3]); w.z = cvt_pk_bf16(b[0], b[1]); w.w = cvt_pk_bf16(b[2], b[3]); return w; }

struct EpiUp {
    static constexpr bool PERM = true;
    bf16_t* H; const float* ss;
    __device__ __forceinline__ bool operator()(f32x4 (&acc)[2][2][4][2], const Unit& u, int wr, int wc, int fr, int fq) const {
        asm volatile("" : "+v"(fr), "+v"(fq));
#pragma unroll
        for (int ai = 0; ai < 2; ++ai)
#pragma unroll
            for (int m = 0; m < 4; ++m) {
                const int row = EPI_ROW(ai, m);
                const float rs = rsqrtf(sum_slots16(ss + (size_t)row * 16) * (1.0f / DM) + EPS);
                f32x4 o[2];
#pragma unroll
                for (int n = 0; n < 2; ++n)
#pragma unroll
                    for (int i = 0; i < 4; ++i) { const float gv = acc[ai][0][m][n][i] * rs, uv = acc[ai][1][m][n][i] * rs; o[n][i] = gv * fast_sigmoid(gv) * uv; }
                *(u32x4*)(H + (size_t)row * FF + u.pn * 128 + wc * 32 + fq * 8) = pack8(o[0], o[1]);
            }
        return true;
    }
};

struct EpiUpTail {
    static constexpr bool PERM = true;
    bf16_t* H; const float* ss; float* P; unsigned* flg;
    __device__ __forceinline__ bool operator()(f32x4 (&acc)[2][2][4][2], const Unit& u, int wr, int wc, int fr, int fq) const {
        asm volatile("" : "+v"(fr), "+v"(fq));
        const int tid = threadIdx.x;
        float* pp = P + (size_t)u.slot * (32 * 2048) + tid * 4;
        if (u.split == 2) {
#pragma unroll
            for (int ai = 0; ai < 2; ++ai)
#pragma unroll
                for (int bj = 0; bj < 2; ++bj)
#pragma unroll
                    for (int m = 0; m < 4; ++m)
#pragma unroll
                        for (int n = 0; n < 2; ++n) *(f32x4*)(pp + (((ai * 2 + bj) * 4 + m) * 2 + n) * 2048) = acc[ai][bj][m][n];
            __threadfence();
            __syncthreads();
            if (tid == 0) __hip_atomic_store(flg + u.slot, 1u, __ATOMIC_RELEASE, __HIP_MEMORY_SCOPE_AGENT);
            return true;
        }
        if (tid == 0) { unsigned sp = 0; while (__hip_atomic_load(flg + u.slot, __ATOMIC_RELAXED, __HIP_MEMORY_SCOPE_AGENT) == 0u) { __builtin_amdgcn_s_sleep(2); if (++sp > (1u << 22)) break; } }
        __syncthreads();
        __builtin_amdgcn_fence(__ATOMIC_ACQUIRE, "agent");
#pragma unroll
        for (int ai = 0; ai < 2; ++ai)
#pragma unroll
            for (int m = 0; m < 4; ++m) {
                const int row = EPI_ROW(ai, m);
                const float rs = rsqrtf(sum_slots16(ss + (size_t)row * 16) * (1.0f / DM) + EPS);
                f32x4 o[2], ga[2], ua[2];
#pragma unroll
                for (int n = 0; n < 2; ++n) { ga[n] = acc[ai][0][m][n] + *(const f32x4*)(pp + (((ai * 2 + 0) * 4 + m) * 2 + n) * 2048); ua[n] = acc[ai][1][m][n] + *(const f32x4*)(pp + (((ai * 2 + 1) * 4 + m) * 2 + n) * 2048); }
#pragma unroll
                for (int n = 0; n < 2; ++n)
#pragma unroll
                    for (int i = 0; i < 4; ++i) { const float gv = ga[n][i] * rs, uv = ua[n][i] * rs; o[n][i] = gv * fast_sigmoid(gv) * uv; }
                *(u32x4*)(H + (size_t)row * FF + u.pn * 128 + wc * 32 + fq * 8) = pack8(o[0], o[1]);
                asm volatile("" ::: "memory");
            }
        return true;
    }
};

struct EpiRes {
    static constexpr bool PERM = true;
    bf16_t* XB; float alpha; float* ssn; float* outf;
    __device__ __forceinline__ bool operator()(f32x4 (&acc)[2][2][4][2], const Unit& u, int wr, int wc, int fr, int fq) const {
        asm volatile("" : "+v"(fr), "+v"(fq));
#pragma unroll
        for (int ai = 0; ai < 2; ++ai)
#pragma unroll
            for (int m = 0; m < 4; ++m) {
                const int row = EPI_ROW(ai, m);
                float sq = 0.f;
#pragma unroll
                for (int bj = 0; bj < 2; ++bj) {
                    const size_t off = (size_t)row * DM + u.pn * BM + bj * HALF + wc * 32 + fq * 8;
                    const u32x4 old = *(const u32x4*)(XB + off);
                    f32x4 a, b;
                    a[0] = bflo(old.x) + alpha * acc[ai][bj][m][0][0]; a[1] = bfhi(old.x) + alpha * acc[ai][bj][m][0][1];
                    a[2] = bflo(old.y) + alpha * acc[ai][bj][m][0][2]; a[3] = bfhi(old.y) + alpha * acc[ai][bj][m][0][3];
                    b[0] = bflo(old.z) + alpha * acc[ai][bj][m][1][0]; b[1] = bfhi(old.z) + alpha * acc[ai][bj][m][1][1];
                    b[2] = bflo(old.w) + alpha * acc[ai][bj][m][1][2]; b[3] = bfhi(old.w) + alpha * acc[ai][bj][m][1][3];
                    sq += (a[0] * a[0] + a[1] * a[1]) + (a[2] * a[2] + a[3] * a[3]) + (b[0] * b[0] + b[1] * b[1]) + (b[2] * b[2] + b[3] * b[3]);
                    *(u32x4*)(XB + off) = pack8(a, b);
                    if (outf) { *(f32x4*)(outf + off) = a; *(f32x4*)(outf + off + 4) = b; }
                }
                sq += __shfl_xor(sq, 16); sq += __shfl_xor(sq, 32);
                if (fq == 0) ssn[(size_t)row * 16 + u.pn * 4 + wc] = sq;
            }
        return true;
    }
};

struct EpiWin {
    static constexpr bool PERM = true;
    const float* ss; const float* biasP;
    bf16_t *XPRE, *GG, *CQ, *CKV, *KPE, *PC, *G; float *ssq, *sskv;
    __device__ __forceinline__ bool operator()(f32x4 (&acc)[2][2][4][2], const Unit& u, int wr, int wc, int fr, int fq) const {
        asm volatile("" : "+v"(fr), "+v"(fq));
        const int pn = u.pn;
        const int cl = wc * 32 + fq * 8;
        f32x4 bv[2][2];
#pragma unroll
        for (int bj = 0; bj < 2; ++bj)
#pragma unroll
            for (int n = 0; n < 2; ++n) bv[bj][n] = *(const f32x4*)(biasP + pn * BM + bj * HALF + cl + 4 * n);
#pragma unroll
        for (int ai = 0; ai < 2; ++ai)
#pragma unroll
            for (int m = 0; m < 4; ++m) {
                const int row = EPI_ROW(ai, m);
                const float rs = rsqrtf(sum_slots16(ss + (size_t)row * 16) * (1.0f / DM) + EPS);
                f32x4 v[2][2];
#pragma unroll
                for (int bj = 0; bj < 2; ++bj)
#pragma unroll
                    for (int n = 0; n < 2; ++n) v[bj][n] = acc[ai][bj][m][n] * rs + bv[bj][n];
                if (pn < 2) {
#pragma unroll
                    for (int bj = 0; bj < 2; ++bj) *(u32x4*)(XPRE + (size_t)row * 512 + pn * BM + bj * HALF + cl) = pack8(v[bj][0], v[bj][1]);
                } else if (pn < 4) {
#pragma unroll
                    for (int bj = 0; bj < 2; ++bj) {
#pragma unroll
                        for (int n = 0; n < 2; ++n)
#pragma unroll
                            for (int i = 0; i < 4; ++i) { const float x = v[bj][n][i]; const float z = 1.5957691216057308f * (x + 0.044715f * x * x * x); v[bj][n][i] = x * fast_sigmoid(z); }
                        *(u32x4*)(GG + (size_t)row * 512 + (pn - 2) * BM + bj * HALF + cl) = pack8(v[bj][0], v[bj][1]);
                    }
                } else if (pn < 7) {
#pragma unroll
                    for (int bj = 0; bj < 2; ++bj) {
                        const int seg = (pn - 4) * 2 + bj;
                        float sq = 0.f;
#pragma unroll
                        for (int n = 0; n < 2; ++n)
#pragma unroll
                            for (int i = 0; i < 4; ++i) sq += v[bj][n][i] * v[bj][n][i];
                        sq += __shfl_xor(sq, 16); sq += __shfl_xor(sq, 32);
                        const u32x4 w = pack8(v[bj][0], v[bj][1]);
                        if (seg < 3) { *(u32x4*)(CQ + (size_t)row * 384 + seg * 128 + cl) = w; if (fq == 0) ssq[(size_t)row * 16 + seg * 4 + wc] = sq; }
                        else if (seg < 5) { *(u32x4*)(CKV + (size_t)row * 256 + (seg - 3) * 128 + cl) = w; if (fq == 0) sskv[(size_t)row * 8 + (seg - 3) * 4 + wc] = sq; }
                        else if (wc == 0) { *(u32x4*)(KPE + (size_t)row * 32 + fq * 8) = w; }
                    }
                } else if (pn < 11) {
                    f32x4 o[2];
#pragma unroll
                    for (int n = 0; n < 2; ++n)
#pragma unroll
                        for (int i = 0; i < 4; ++i) o[n][i] = v[0][n][i] * fast_sigmoid(v[1][n][i]);
                    *(u32x4*)(PC + (size_t)row * 512 + (pn - 7) * 128 + cl) = pack8(o[0], o[1]);
                } else {
#pragma unroll
                    for (int bj = 0; bj < 2; ++bj) {
#pragma unroll
                        for (int n = 0; n < 2; ++n)
#pragma unroll
                            for (int i = 0; i < 4; ++i) v[bj][n][i] = fmaxf(fast_sigmoid(v[bj][n][i]), 1e-30f);
                        *(u32x4*)(G + (size_t)row * 3072 + (pn - 11) * BM + bj * HALF + cl) = pack8(v[bj][0], v[bj][1]);
                    }
                }
            }
        return true;
    }
};

struct EpiQ {
    static constexpr bool PERM = false;
    bf16_t* Q; const float* ssq; const float* CS;
    __device__ __forceinline__ bool operator()(f32x4 (&acc)[2][2][4][2], const Unit& u, int wr, int wc, int fr, int fq) const {
        asm volatile("" : "+v"(fr), "+v"(fq));
        float rsv[2][4];
#pragma unroll
        for (int ai = 0; ai < 2; ++ai) {
#pragma unroll
            for (int m = 0; m < 4; ++m) rsv[ai][m] = sum_slots12(ssq + (size_t)EPI_ROW(ai, m) * 16);
            asm volatile("" ::: "memory"); }
#pragma unroll
        for (int ai = 0; ai < 2; ++ai)
#pragma unroll
            for (int m = 0; m < 4; ++m) {
                const int row = EPI_ROW(ai, m);
                const float rs = rsqrtf(rsv[ai][m] * (1.0f / 384.0f) + EPS) * QSCALE;
                const f32x4 cs = *(const f32x4*)(CS + (size_t)row * 32 + 4 * fq), sn = *(const f32x4*)(CS + (size_t)row * 32 + 16 + 4 * fq);
#pragma unroll
                for (int bj = 0; bj < 2; ++bj) {
                    const int c0 = u.pn * BM + bj * HALF + wc * 32;
                    f32x4 x1 = acc[ai][bj][m][0] * rs, x2 = acc[ai][bj][m][1] * rs;
                    if ((c0 % 96) == 64) { const f32x4 y1 = x1 * cs - x2 * sn, y2 = x2 * cs + x1 * sn; x1 = y1; x2 = y2; }
                    u32x2 w1, w2; w1.x = cvt_pk_bf16(x1[0], x1[1]); w1.y = cvt_pk_bf16(x1[2], x1[3]); w2.x = cvt_pk_bf16(x2[0], x2[1]); w2.y = cvt_pk_bf16(x2[2], x2[3]);
                    *(u32x2*)(Q + (size_t)row * 768 + c0 + 4 * fq) = w1; *(u32x2*)(Q + (size_t)row * 768 + c0 + 16 + 4 * fq) = w2;
                }
            }
        return true;
    }
};

struct EpiKV {
    static constexpr bool PERM = true;
    bf16_t *KN, *V; const float* sskv;
    __device__ __forceinline__ bool operator()(f32x4 (&acc)[2][2][4][2], const Unit& u, int wr, int wc, int fr, int fq) const {
        asm volatile("" : "+v"(fr), "+v"(fq));
        float rsv[2][4];
#pragma unroll
        for (int ai = 0; ai < 2; ++ai)
#pragma unroll
            for (int m = 0; m < 4; ++m) rsv[ai][m] = sum_slots8(sskv + (size_t)EPI_ROW(ai, m) * 8);
#pragma unroll
        for (int ai = 0; ai < 2; ++ai)
#pragma unroll
            for (int m = 0; m < 4; ++m) {
                const int row = EPI_ROW(ai, m);
                const float rs = rsqrtf(rsv[ai][m] * (1.0f / 256.0f) + EPS);
#pragma unroll
                for (int bj = 0; bj < 2; ++bj) {
                    const int head = u.pn * 2 + bj; const int j = wc * 32 + fq * 8;
                    const u32x4 w = pack8(acc[ai][bj][m][0] * rs, acc[ai][bj][m][1] * rs);
                    if (wc < 2) *(u32x4*)(KN + (size_t)row * 512 + head * 64 + j) = w;
                    else        *(u32x4*)(V + (size_t)row * 512 + head * 64 + (j - 64)) = w;
                }
            }
        return true;
    }
};

struct EpiMerge {
    static constexpr bool PERM = true;
    const bf16_t* G; const float* bc; bf16_t* OUT;
    __device__ __forceinline__ bool operator()(f32x4 (&acc)[2][2][4][2], const Unit& u, int wr, int wc, int fr, int fq) const {
        asm volatile("" : "+v"(fr), "+v"(fq));
        const int seg = u.seg;
        const int colb = u.pn * BM + wc * 32 + fq * 8;
#pragma unroll
        for (int ai = 0; ai < 2; ++ai)
#pragma unroll
        for (int mh = 0; mh < 2; ++mh) {
            u32x4 ga[2][2], gb[2][2];
#pragma unroll
            for (int mm = 0; mm < 2; ++mm)
#pragma unroll
                for (int bj = 0; bj < 2; ++bj) {
                    const bf16_t* gp = G + (size_t)EPI_ROW(ai, 2 * mh + mm) * 3072 + seg * 1024 + colb + bj * HALF;
                    ga[mm][bj] = *(const u32x4*)gp;
                    gb[mm][bj] = (seg < 2) ? *(const u32x4*)(gp + 1024) : ga[mm][bj];
                }
            if (seg < 2) {
#pragma unroll
                for (int mm = 0; mm < 2; ++mm)
#pragma unroll
                    for (int bj = 0; bj < 2; ++bj) {
                        const int m = 2 * mh + mm; const u32x4 a = ga[mm][bj], b = gb[mm][bj];
                        const f32x4 r0 = {bflo(a.x) * __builtin_amdgcn_rcpf(bflo(b.x)), bfhi(a.x) * __builtin_amdgcn_rcpf(bfhi(b.x)), bflo(a.y) * __builtin_amdgcn_rcpf(bflo(b.y)), bfhi(a.y) * __builtin_amdgcn_rcpf(bfhi(b.y))};
                        const f32x4 r1 = {bflo(a.z) * __builtin_amdgcn_rcpf(bflo(b.z)), bfhi(a.z) * __builtin_amdgcn_rcpf(bfhi(b.z)), bflo(a.w) * __builtin_amdgcn_rcpf(bflo(b.w)), bfhi(a.w) * __builtin_amdgcn_rcpf(bfhi(b.w))};
                        acc[ai][bj][m][0] *= r0; acc[ai][bj][m][1] *= r1;
                    }
            } else {
#pragma unroll
                for (int bj = 0; bj < 2; ++bj) {
                    const f32x4 c0 = *(const f32x4*)(bc + colb + bj * HALF), c1 = *(const f32x4*)(bc + colb + bj * HALF + 4);
#pragma unroll
                    for (int mm = 0; mm < 2; ++mm) {
                        const int m = 2 * mh + mm; const u32x4 a = ga[mm][bj];
                        const f32x4 a0 = {bflo(a.x), bfhi(a.x), bflo(a.y), bfhi(a.y)}, a1 = {bflo(a.z), bfhi(a.z), bflo(a.w), bfhi(a.w)};
                        *(u32x4*)(OUT + (size_t)EPI_ROW(ai, m) * DM + colb + bj * HALF) = pack8((acc[ai][bj][m][0] + c0) * a0, (acc[ai][bj][m][1] + c1) * a1);
                    }
                }
            }
            asm volatile("" ::: "memory");
        }
        return seg == 2;
    }
};
}

namespace att {
__device__ __forceinline__ int crow(int r, int hi) { return (r & 3) + 8 * (r >> 2) + 4 * hi; }
constexpr int KSLOT = 12288, VSLOT = 8192;
constexpr int L_K = 0, L_V = 2 * KSLOT, L_WS = L_V + 2 * VSLOT, L_OST = L_WS + 2048, L_END = L_OST + 8 * 4096;

__device__ __forceinline__ float hmax(float m) { auto rr = __builtin_amdgcn_permlane32_swap(__float_as_uint(m), __float_as_uint(m), false, false); return fmaxf(__uint_as_float(rr[0]), __uint_as_float(rr[1])); }
__device__ __forceinline__ float hsum(float m) { auto rr = __builtin_amdgcn_permlane32_swap(__float_as_uint(m), __float_as_uint(m), false, false); return __uint_as_float(rr[0]) + __uint_as_float(rr[1]); }

__device__ __forceinline__ void pv(f32x16* o, unsigned vb, bf16x8 pa0, bf16x8 pa1, bf16x8 pa2, bf16x8 pa3) {
    s16x4 lo[2][4], hi[2][4];
#pragma unroll
    for (int d0 = 0; d0 < 2; ++d0)
#pragma unroll
        for (int ks = 0; ks < 4; ++ks) {
            asm volatile("ds_read_b64_tr_b16 %0,%1 offset:%c2" : "=&v"(lo[d0][ks]) : "v"(vb), "i"(d0 * 4096 + ks * 1024) : "memory");
            asm volatile("ds_read_b64_tr_b16 %0,%1 offset:%c2" : "=&v"(hi[d0][ks]) : "v"(vb), "i"(d0 * 4096 + ks * 1024 + 512) : "memory"); }
#define PK(d, k) (bf16x8){lo[d][k][0], lo[d][k][1], lo[d][k][2], lo[d][k][3], hi[d][k][0], hi[d][k][1], hi[d][k][2], hi[d][k][3]}
    asm volatile("s_waitcnt lgkmcnt(8)" ::: "memory"); __builtin_amdgcn_sched_barrier(0);
    o[0] = __builtin_amdgcn_mfma_f32_32x32x16_bf16(pa0, PK(0, 0), o[0], 0, 0, 0);
    o[0] = __builtin_amdgcn_mfma_f32_32x32x16_bf16(pa1, PK(0, 1), o[0], 0, 0, 0);
    o[0] = __builtin_amdgcn_mfma_f32_32x32x16_bf16(pa2, PK(0, 2), o[0], 0, 0, 0);
    o[0] = __builtin_amdgcn_mfma_f32_32x32x16_bf16(pa3, PK(0, 3), o[0], 0, 0, 0);
    asm volatile("s_waitcnt lgkmcnt(0)" ::: "memory"); __builtin_amdgcn_sched_barrier(0);
    o[1] = __builtin_amdgcn_mfma_f32_32x32x16_bf16(pa0, PK(1, 0), o[1], 0, 0, 0);
    o[1] = __builtin_amdgcn_mfma_f32_32x32x16_bf16(pa1, PK(1, 1), o[1], 0, 0, 0);
    o[1] = __builtin_amdgcn_mfma_f32_32x32x16_bf16(pa2, PK(1, 2), o[1], 0, 0, 0);
    o[1] = __builtin_amdgcn_mfma_f32_32x32x16_bf16(pa3, PK(1, 3), o[1], 0, 0, 0);
#undef PK
}

__device__ __forceinline__ void attn_block(int b, int h, int qb, const bf16_t* Q, const bf16_t* KN, const bf16_t* KR, const bf16_t* V, bf16_t* O, LAS unsigned char* lds) {
    int tid_ = threadIdx.x; asm volatile("" : "+v"(tid_));
    const int tid = tid_, lane = tid & 63, r32 = lane & 31, hi = lane >> 5;
    const int wid = __builtin_amdgcn_readfirstlane(tid >> 6);
    const size_t rowbase = (size_t)b * SEQ; const int q0 = qb * 256;
    const bf16_t* Qw = Q + (rowbase + q0 + wid * 32 + r32) * 768 + h * 96;
    bf16x8 qr[6];
#pragma unroll
    for (int d0 = 0; d0 < 6; ++d0) qr[d0] = *(const bf16x8*)(Qw + d0 * 16 + hi * 8);
    const int NT = 4 * qb + 4;
    const bf16_t* kg = KN + (rowbase + lane) * 512 + h * 64 + wid * 8;
    const bf16_t* krg = KR + (rowbase + lane) * 32 + (wid & 3) * 8;
    const bf16_t* vg = V + (rowbase + 16 * (wid & 3) + (lane >> 2)) * 512 + h * 64 + (wid >> 2) * 32 + (lane & 3) * 8;
    const int kdst = L_K + wid * 1024 + lane * 16, krdst = L_K + (8 + (wid & 3)) * 1024 + lane * 16, vdst = L_V + wid * 1024 + lane * 16;
    unsigned z0_ = 0u; asm volatile("" : "+v"(z0_)); u32x4 kreg, krreg = {z0_, z0_, z0_, z0_}, vreg;
    kreg = *(const u32x4*)kg; if (wid < 4) krreg = *(const u32x4*)krg; vreg = *(const u32x4*)vg;
    *(LAS u32x4*)(lds + kdst) = kreg; if (wid < 4) *(LAS u32x4*)(lds + krdst) = krreg; *(LAS u32x4*)(lds + vdst) = vreg;
    __syncthreads();
    float mrun = -INFINITY, lrun = 0.f; f32x16 o[2];
#pragma unroll
    for (int r = 0; r < 16; ++r) { o[0][r] = 0.f; o[1][r] = 0.f; }
    LAS float* wsf = (LAS float*)(lds + L_WS) + wid * 64;
    const int qabs = q0 + wid * 32 + r32;
    const unsigned vbl = (unsigned)(uintptr_t)(lds + L_V) + ((lane >> 4) & 1) * 32 + (lane & 3) * 8 + (4 * hi + ((lane & 15) >> 2)) * 64;
    for (int t = 0; t < NT; ++t) {
        const int cur = t & 1;
        if (t + 1 < NT) { const size_t adv = (size_t)(t + 1) * 64; kreg = *(const u32x4*)(kg + adv * 512); if (wid < 4) krreg = *(const u32x4*)(krg + adv * 32); vreg = *(const u32x4*)(vg + adv * 512); }
        const int jb = t - 4 * qb;
        if (jb <= (wid >> 1)) {
            f32x16 p0, p1;
#pragma unroll
            for (int r = 0; r < 16; ++r) { p0[r] = 0.f; p1[r] = 0.f; }
            const LAS unsigned char* kb = lds + L_K + cur * KSLOT + hi * 1024 + r32 * 16;
            bf16x8 kf[12];
#pragma unroll
            for (int d0 = 0; d0 < 6; ++d0) { kf[2 * d0] = *(const LAS bf16x8*)(kb + d0 * 2048); kf[2 * d0 + 1] = *(const LAS bf16x8*)(kb + d0 * 2048 + 512); }
            __builtin_amdgcn_sched_barrier(0);
#pragma unroll
            for (int d0 = 0; d0 < 6; ++d0) {
                p0 = __builtin_amdgcn_mfma_f32_32x32x16_bf16(kf[2 * d0], qr[d0], p0, 0, 0, 0);
                p1 = __builtin_amdgcn_mfma_f32_32x32x16_bf16(kf[2 * d0 + 1], qr[d0], p1, 0, 0, 0);
            }
            if (jb == (wid >> 1)) {
                const int kbase = 64 * t + 4 * hi;
#pragma unroll
                for (int r = 0; r < 16; ++r) { const int kv = kbase + (r & 3) + 8 * (r >> 2); if (kv > qabs) p0[r] = -INFINITY; if (kv + 32 > qabs) p1[r] = -INFINITY; }
            }
            float rm = fmaxf(p0[0], p1[0]);
#pragma unroll
            for (int r = 1; r < 16; ++r) rm = fmaxf(rm, fmaxf(p0[r], p1[r]));
            rm = hmax(rm);
            if (__any(rm > mrun + 8.0f)) {
                const float mn = fmaxf(mrun, rm);
                const float alpha = __builtin_amdgcn_exp2f(mrun - mn);
                mrun = mn; lrun *= alpha;
                if (hi == 0) wsf[r32] = alpha;
                asm volatile("s_waitcnt lgkmcnt(0)" ::: "memory");
#pragma unroll
                for (int r = 0; r < 16; ++r) { const float a = wsf[crow(r, hi)]; o[0][r] *= a; o[1][r] *= a; }
            }
            float sum = 0.f;
#pragma unroll
            for (int r = 0; r < 16; ++r) { p0[r] = __builtin_amdgcn_exp2f(p0[r] - mrun); p1[r] = __builtin_amdgcn_exp2f(p1[r] - mrun); sum += p0[r] + p1[r]; }
            lrun += sum;
            u32x4 pw0, pw1, pw2, pw3;
            pw0 = (u32x4){cvt_pk_bf16(p0[0], p0[1]), cvt_pk_bf16(p0[2], p0[3]), cvt_pk_bf16(p0[4], p0[5]), cvt_pk_bf16(p0[6], p0[7])};
            pw1 = (u32x4){cvt_pk_bf16(p0[8], p0[9]), cvt_pk_bf16(p0[10], p0[11]), cvt_pk_bf16(p0[12], p0[13]), cvt_pk_bf16(p0[14], p0[15])};
            pw2 = (u32x4){cvt_pk_bf16(p1[0], p1[1]), cvt_pk_bf16(p1[2], p1[3]), cvt_pk_bf16(p1[4], p1[5]), cvt_pk_bf16(p1[6], p1[7])};
            pw3 = (u32x4){cvt_pk_bf16(p1[8], p1[9]), cvt_pk_bf16(p1[10], p1[11]), cvt_pk_bf16(p1[12], p1[13]), cvt_pk_bf16(p1[14], p1[15])};
            pv(o, vbl + cur * VSLOT, __builtin_bit_cast(bf16x8, pw0), __builtin_bit_cast(bf16x8, pw1), __builtin_bit_cast(bf16x8, pw2), __builtin_bit_cast(bf16x8, pw3));
        }
        if (t + 1 < NT) { const int nb = (cur ^ 1); *(LAS u32x4*)(lds + kdst + nb * KSLOT) = kreg; if (wid < 4) *(LAS u32x4*)(lds + krdst + nb * KSLOT) = krreg; *(LAS u32x4*)(lds + vdst + nb * VSLOT) = vreg; }
        __syncthreads();
    }
    lrun = hsum(lrun);
    if (hi == 0) wsf[32 + r32] = lrun;
    asm volatile("s_waitcnt lgkmcnt(0)" ::: "memory");
    float rli[16];
#pragma unroll
    for (int r = 0; r < 16; ++r) rli[r] = __builtin_amdgcn_rcpf(wsf[32 + crow(r, hi)]);
    bf16_t* Ow = O + (rowbase + q0 + wid * 32) * 512 + h * 64;
    LAS bf16_t* stg = (LAS bf16_t*)(lds + L_OST) + wid * 2048;
#pragma unroll
    for (int r = 0; r < 16; ++r) { const int orow = crow(r, hi);
#pragma unroll
        for (int d0 = 0; d0 < 2; ++d0) stg[orow * 64 + d0 * 32 + r32] = f2bf(o[d0][r] * rli[r]); }
    asm volatile("s_waitcnt lgkmcnt(0)" ::: "memory");
#pragma unroll
    for (int i = 0; i < 4; ++i) { const int row = i * 8 + (lane >> 3), ch = lane & 7; const u32x4 v = *(const LAS u32x4*)(stg + row * 64 + ch * 8); *(u32x4*)(Ow + (size_t)row * 512 + ch * 8) = v; }
    __syncthreads();
}
}

namespace lru {
constexpr int XS_STRIDE = 144;
constexpr int L_XS = 0, L_BM = 74240, L_CW = L_BM + 24576, L_CB = L_CW + 1024, L_AGG = L_CB + 256, L_PRE = L_AGG + 4096, L_CIN = L_PRE + 4096, L_END = L_CIN + 128;
__device__ __forceinline__ void lru_unit(int u, int layer, const bf16_t* XPRE, bf16_t* GG, const float* conv_w, const float* conv_b, const float* wgate, const float* bgate, const float* lam,
                                         unsigned* flags, float* carry, LAS unsigned char* lds) {
    int tid_ = threadIdx.x; asm volatile("" : "+v"(tid_));
    const int tid = tid_, lane = tid & 63, r32 = lane & 31, hi = lane >> 5;
    const int wid = __builtin_amdgcn_readfirstlane(tid >> 6);
    const int ck = u >> 6, bh = u & 63, b = bh >> 3, h = bh & 7, s0 = ck * 512;
    LAS float* CW = (LAS float*)(lds + L_CW); LAS float* CB = (LAS float*)(lds + L_CB);
    LAS f32x2* AGG = (LAS f32x2*)(lds + L_AGG); LAS f32x2* PRE = (LAS f32x2*)(lds + L_PRE); LAS float* CIN = (LAS float*)(lds + L_CIN);
    if (tid < 256) CW[tid] = conv_w[(tid >> 6) * 512 + h * 64 + (tid & 63)];
    else if (tid < 320) CB[tid - 256] = conv_b[h * 64 + (tid - 256)];
    for (int f = tid; f < 1536; f += 512) {
        const int l = f & 63, g = f >> 6, kc = g & 3, nt = g >> 2, n = l & 31, hh = l >> 5, col = 32 * nt + n, d0 = 16 * kc + 8 * hh;
        float v[8];
#pragma unroll
        for (int i = 0; i < 8; ++i) v[i] = (nt < 4) ? wgate[(size_t)h * 8192 + (d0 + i) * 128 + col] : ((d0 + i) == (col - 128) ? 1.0f : 0.0f);
        *(LAS u32x4*)(lds + L_BM + g * 1024 + l * 16) = (u32x4){cvt_pk_bf16(v[0], v[1]), cvt_pk_bf16(v[2], v[3]), cvt_pk_bf16(v[4], v[5]), cvt_pk_bf16(v[6], v[7])};
    }
    unsigned z0_ = 0u; asm volatile("" : "+v"(z0_));
    { u32x4 st[9];
#pragma unroll
      for (int k = 0; k < 9; ++k) { const int i = (tid >> 3) + 64 * k, s = s0 - 3 + i; st[k] = (u32x4){z0_, z0_, z0_, z0_};
          if (i < 515 && s >= 0) st[k] = *(const u32x4*)(XPRE + ((size_t)b * SEQ + s) * 512 + h * 64 + (tid & 7) * 8); }
#pragma unroll
      for (int k = 0; k < 9; ++k) { const int i = (tid >> 3) + 64 * k; if (i < 515) *(LAS u32x4*)(lds + L_XS + i * XS_STRIDE + (tid & 7) * 16) = st[k]; } }
    __syncthreads();
    bf16x8 afr[2][4];
#pragma unroll
    for (int kc = 0; kc < 4; ++kc) {
        const int d0 = 16 * kc + 8 * hi;
        f32x4 w0[4], w1[4];
#pragma unroll
        for (int j = 0; j < 4; ++j) { w0[j] = *(const LAS f32x4*)(CW + j * 64 + d0); w1[j] = *(const LAS f32x4*)(CW + j * 64 + d0 + 4); }
        const f32x4 cb0 = *(const LAS f32x4*)(CB + d0), cb1 = *(const LAS f32x4*)(CB + d0 + 4);
#pragma unroll
        for (int mt = 0; mt < 2; ++mt) {
            const int sl = wid * 64 + mt * 32 + r32;
            f32x4 xa0 = cb0, xa1 = cb1;
#pragma unroll
            for (int j = 0; j < 4; ++j) {
                const u32x4 xv = *(const LAS u32x4*)(lds + L_XS + (sl + j) * XS_STRIDE + d0 * 2);
                xa0 += w0[j] * (f32x4){bflo(xv.x), bfhi(xv.x), bflo(xv.y), bfhi(xv.y)};
                xa1 += w1[j] * (f32x4){bflo(xv.z), bfhi(xv.z), bflo(xv.w), bfhi(xv.w)};
            }
            afr[mt][kc] = __builtin_bit_cast(bf16x8, (u32x4){cvt_pk_bf16(xa0[0], xa0[1]), cvt_pk_bf16(xa0[2], xa0[3]), cvt_pk_bf16(xa1[0], xa1[1]), cvt_pk_bf16(xa1[2], xa1[3])});
        }
    }
    __syncthreads();
    { u32x4 st[8];
#pragma unroll
      for (int k = 0; k < 8; ++k) st[k] = *(const u32x4*)(GG + ((size_t)b * SEQ + s0 + (tid >> 3) + 64 * k) * 512 + h * 64 + (tid & 7) * 8);
#pragma unroll
      for (int k = 0; k < 8; ++k) *(LAS u32x4*)(lds + L_XS + ((tid >> 3) + 64 * k) * XS_STRIDE + (tid & 7) * 16) = st[k]; }
    const int fbase = layer * 256;
#pragma unroll 1
    for (int ct = 0; ct < 2; ++ct) {
        const int c = 32 * ct + r32;
        const float spc = 8.0f * log1pf(expf(-lam[h * 64 + c]));
        const float br = bgate[h * 128 + c], bi = bgate[h * 128 + 64 + c];
        float hq[2][16], ac[2][16];
#pragma unroll
        for (int mt = 0; mt < 2; ++mt) {
            f32x16 R, I, X;
#pragma unroll
            for (int r = 0; r < 16; ++r) { R[r] = br; I[r] = bi; X[r] = 0.f; }
#pragma unroll
            for (int kc = 0; kc < 4; ++kc) {
                const bf16x8 b0 = *(const LAS bf16x8*)(lds + L_BM + ((ct) * 4 + kc) * 1024 + lane * 16);
                const bf16x8 b1 = *(const LAS bf16x8*)(lds + L_BM + ((2 + ct) * 4 + kc) * 1024 + lane * 16);
                const bf16x8 b2 = *(const LAS bf16x8*)(lds + L_BM + ((4 + ct) * 4 + kc) * 1024 + lane * 16);
                R = __builtin_amdgcn_mfma_f32_32x32x16_bf16(afr[mt][kc], b0, R, 0, 0, 0);
                I = __builtin_amdgcn_mfma_f32_32x32x16_bf16(afr[mt][kc], b1, I, 0, 0, 0);
                X = __builtin_amdgcn_mfma_f32_32x32x16_bf16(afr[mt][kc], b2, X, 0, 0, 0);
            }
            float Ar[4], Hr[4];
#pragma unroll
            for (int q = 0; q < 4; ++q) { float A = 1.f, H = 0.f;
#pragma unroll
                for (int k = 0; k < 4; ++k) { const int r = 4 * q + k;
                    const float rg = fast_sigmoid(R[r]), ig = fast_sigmoid(I[r]);
                    const float la = -rg * spc;
                    const float a = __builtin_amdgcn_exp2f(la * 1.4426950408889634f);
                    const float x2 = 2.0f * la;
                    float om = -x2 * (1.0f + x2 * (0.5f + x2 * (0.16666667f + x2 * (0.041666668f + x2 * (0.0083333338f + x2 * 0.0013888889f)))));
                    if (__builtin_expect(__any(x2 <= -0.25f), 0)) om = (x2 > -0.25f) ? om : (1.0f - a * a);
                    const float uu = __builtin_amdgcn_sqrtf(fmaxf(om, 0.f)) * (ig * X[r]);
                    H = a * H + uu; A *= a; ac[mt][r] = A; hq[mt][r] = H; }
                Ar[q] = A; Hr[q] = H; }
            float pA[4], pH[4];
#pragma unroll
            for (int q = 0; q < 4; ++q) { pA[q] = __shfl_xor(Ar[q], 32); pH[q] = __shfl_xor(Hr[q], 32); }
            float A = 1.f, H = 0.f;
#pragma unroll
            for (int q = 0; q < 4; ++q) {
                const float A0 = hi ? pA[q] : Ar[q], H0 = hi ? pH[q] : Hr[q], A1 = hi ? Ar[q] : pA[q], H1 = hi ? Hr[q] : pH[q];
                const float Hm = A0 * H + H0, Am = A * A0;
                const float cA = hi ? Am : A, cH = hi ? Hm : H;
#pragma unroll
                for (int k = 0; k < 4; ++k) { const int r = 4 * q + k; hq[mt][r] += ac[mt][r] * cH; ac[mt][r] *= cA; }
                H = A1 * Hm + H1; A = Am * A1;
            }
            if (hi == 0) AGG[(2 * wid + mt) * 32 + r32] = (f32x2){A, H};
            __builtin_amdgcn_sched_barrier(0);
        }
        __syncthreads();
        if (wid == 0 && lane < 32) {
            float A = 1.f, H = 0.f;
#pragma unroll
            for (int t = 0; t < 16; ++t) { PRE[t * 32 + lane] = (f32x2){A, H}; const f32x2 g = AGG[t * 32 + lane]; H = g.x * H + g.y; A *= g.x; }
            if (ck < 3) {
                __hip_atomic_store(carry + ((size_t)u * 64 + c) * 2, A, __ATOMIC_RELAXED, __HIP_MEMORY_SCOPE_AGENT);
                __hip_atomic_store(carry + ((size_t)u * 64 + c) * 2 + 1, H, __ATOMIC_RELAXED, __HIP_MEMORY_SCOPE_AGENT);
                asm volatile("s_waitcnt vmcnt(0)" ::: "memory");
                if (lane == 0) __hip_atomic_store(flags + (size_t)(fbase + u) * 2 + ct, 1u, __ATOMIC_RELEASE, __HIP_MEMORY_SCOPE_AGENT);
            }
            float cin = 0.f;
            for (int j = 0; j < ck; ++j) {
                const int uj = j * 64 + bh;
                unsigned* fp = flags + (size_t)(fbase + uj) * 2 + ct; unsigned sp = 0;
                while (__hip_atomic_load(fp, __ATOMIC_RELAXED, __HIP_MEMORY_SCOPE_AGENT) == 0u) { __builtin_amdgcn_s_sleep(2); if (++sp > (1u << 22)) break; }
                __builtin_amdgcn_fence(__ATOMIC_ACQUIRE, "agent");
                const float Aj = __hip_atomic_load(carry + ((size_t)uj * 64 + c) * 2, __ATOMIC_RELAXED, __HIP_MEMORY_SCOPE_AGENT);
                const float Hj = __hip_atomic_load(carry + ((size_t)uj * 64 + c) * 2 + 1, __ATOMIC_RELAXED, __HIP_MEMORY_SCOPE_AGENT);
                cin = Aj * cin + Hj;
            }
            CIN[lane] = cin;
        }
        __syncthreads();
        {
            const float cinc = CIN[r32];
#pragma unroll
            for (int mt = 0; mt < 2; ++mt) {
                const f32x2 p = PRE[(2 * wid + mt) * 32 + r32];
                const float cint = p.y + p.x * cinc;
                LAS bf16_t* gp = (LAS bf16_t*)(lds + L_XS + (wid * 64 + mt * 32) * XS_STRIDE) + c;
#pragma unroll
                for (int r = 0; r < 16; ++r) { LAS bf16_t* q = gp + att::crow(r, hi) * (XS_STRIDE / 2); const float hv = hq[mt][r] + ac[mt][r] * cint; *q = f2bf(hv * bf2f(*q)); }
            }
        }
    }
    __syncthreads();
    for (int i = tid >> 3; i < 512; i += 64)
        *(u32x4*)(GG + ((size_t)b * SEQ + s0 + i) * 512 + h * 64 + (tid & 7) * 8) = *(const LAS u32x4*)(lds + L_XS + i * XS_STRIDE + (tid & 7) * 16);
    __syncthreads();
}
}

namespace cv {
constexpr int L_XS = 0, L_YB = 63488, YB_STRIDE = 516, L_END = L_YB + 32 * YB_STRIDE * 4;
__device__ __forceinline__ void conv_unit(int u, const bf16_t* PC, bf16_t* AC, const float* dw_w, const float* dw_b, const float* ln_g, const float* ln_b,
                                          const bf16_t* KPE, bf16_t* KR, const float* CS, LAS unsigned char* lds) {
    int tid_ = threadIdx.x; asm volatile("" : "+v"(tid_));
    const int tid = tid_, lane = tid & 63;
    const int wid = __builtin_amdgcn_readfirstlane(tid >> 6);
    const int m0 = u * 32, b = m0 >> 11, s0 = m0 & 2047;
    unsigned z0_ = 0u; asm volatile("" : "+v"(z0_));
    { u32x4 st[8];
#pragma unroll
      for (int k = 0; k < 8; ++k) { const int i = (tid >> 6) + 8 * k, s = s0 - 30 + i; st[k] = (u32x4){z0_, z0_, z0_, z0_};
          if (i < 62 && s >= 0) st[k] = *(const u32x4*)(PC + ((size_t)b * SEQ + s) * 512 + (tid & 63) * 8); }
#pragma unroll
      for (int k = 0; k < 8; ++k) { const int i = (tid >> 6) + 8 * k; if (i < 62) *(LAS u32x4*)(lds + L_XS + i * 1024 + (tid & 63) * 16) = st[k]; } }
    { const int tok = tid >> 4, j = tid & 15; const size_t m = (size_t)m0 + tok;
      const float x1 = bf2f(KPE[m * 32 + j]), x2 = bf2f(KPE[m * 32 + 16 + j]); const float cs = CS[m * 32 + j], sn = CS[m * 32 + 16 + j];
      KR[m * 32 + j] = f2bf(x1 * cs - x2 * sn); KR[m * 32 + 16 + j] = f2bf(x2 * cs + x1 * sn); }
    __syncthreads();
    {
        const int ch = tid;
        float w[31];
#pragma unroll
        for (int j = 0; j < 31; ++j) w[j] = dw_w[j * 512 + ch];
        const float bias = dw_b[ch];
        const LAS bf16_t* xs = (const LAS bf16_t*)(lds + L_XS) + ch;
        LAS float* YB = (LAS float*)(lds + L_YB);
#pragma unroll 1
        for (int g = 0; g < 4; ++g) {
            float x[38];
#pragma unroll
            for (int k = 0; k < 38; ++k) x[k] = bf2f(xs[(8 * g + k) * 512]);
#pragma unroll
            for (int o = 0; o < 8; ++o) { float y = bias;
#pragma unroll
                for (int j = 0; j < 31; ++j) y += w[j] * x[o + j];
                YB[(8 * g + o) * YB_STRIDE + ch] = y; }
        }
    }
    __syncthreads();
    {
        const LAS float* YB = (const LAS float*)(lds + L_YB);
        const f32x4 g0 = *(const f32x4*)(ln_g + lane * 8), g1 = *(const f32x4*)(ln_g + lane * 8 + 4), b0 = *(const f32x4*)(ln_b + lane * 8), b1 = *(const f32x4*)(ln_b + lane * 8 + 4);
#pragma unroll
        for (int k = 0; k < 4; ++k) {
            const int tok = wid * 4 + k;
            f32x4 a = *(const LAS f32x4*)(YB + tok * YB_STRIDE + lane * 8), c = *(const LAS f32x4*)(YB + tok * YB_STRIDE + lane * 8 + 4);
            const float mean = wave_sum((a[0] + a[1]) + (a[2] + a[3]) + (c[0] + c[1]) + (c[2] + c[3])) * (1.0f / 512.0f);
            a = a - mean; c = c - mean;
            const float var = wave_sum((a[0] * a[0] + a[1] * a[1]) + (a[2] * a[2] + a[3] * a[3]) + (c[0] * c[0] + c[1] * c[1]) + (c[2] * c[2] + c[3] * c[3])) * (1.0f / 512.0f);
            const float rstd = rsqrtf(var + EPS);
            a = a * rstd * g0 + b0; c = c * rstd * g1 + b1;
#pragma unroll
            for (int i = 0; i < 4; ++i) { a[i] = a[i] * fast_sigmoid(a[i]); c[i] = c[i] * fast_sigmoid(c[i]); }
            *(u32x4*)(AC + ((size_t)m0 + tok) * 512 + lane * 8) = pg8::pack8(a, c);
        }
    }
    __syncthreads();
}
}

#define XB_TMO      128
#define XB_XCNT(j)  (256  + 64 * (j))
#define XB_XSUB(j)  (1280 + 64 * (j))
#define XB_XGEN(j)  (2304 + 64 * (j))
#define XB_TOP      3328
#define XB_TOPGEN   3392
#define XCD_BAR_WORDS 3456
#define XB_SPIN_CAP (1u << 18)
__device__ __forceinline__ unsigned xb_ld(unsigned* p)              { return __hip_atomic_load(p, __ATOMIC_RELAXED, __HIP_MEMORY_SCOPE_AGENT); }
__device__ __forceinline__ unsigned xb_add(unsigned* p, unsigned v) { return __hip_atomic_fetch_add(p, v, __ATOMIC_RELAXED, __HIP_MEMORY_SCOPE_AGENT); }
__device__ __forceinline__ unsigned xb_xcc_id() { return (unsigned)__builtin_amdgcn_s_getreg((3 << 11) | 20) & 0xFu; }
#define XB_SPIN(cond, bar) do { unsigned _sp = 0; while (cond) { __builtin_amdgcn_s_sleep(1); \
    if ((++_sp & 255u) == 0u) { if (xb_ld(&(bar)[XB_TMO])) break; if (_sp > XB_SPIN_CAP) { atomicAdd(&(bar)[XB_TMO], 1u); break; } } } } while (0)
struct XcdBarrier { unsigned* bar; unsigned x; volatile LAS unsigned* st; };
__device__ __forceinline__ XcdBarrier xcd_barrier_post(unsigned* bar, volatile LAS unsigned* st) {
    XcdBarrier b; b.bar = bar; b.x = xb_xcc_id(); b.st = st;
    if (threadIdx.x == 0) (void)xb_add(&bar[XB_XCNT(b.x)], 1u);
    return b;
}
__device__ __forceinline__ void xcd_barrier_complete(unsigned* bar, unsigned x, unsigned& nloc, unsigned& nx) {
    const unsigned G = gridDim.x * gridDim.y * gridDim.z;
    unsigned sum, cnt, mine, sp = 0u;
    for (;;) {
        sum = 0u; cnt = 0u; mine = 0u;
#pragma unroll 1
        for (unsigned j = 0; j < 16; ++j) { const unsigned c = xb_ld(&bar[XB_XCNT(j)]); sum += c; cnt += (c > 0u) ? 1u : 0u; mine = (j == x) ? c : mine; }
        if (sum == G) break;
        __builtin_amdgcn_s_sleep(1);
        if ((++sp & 255u) == 0u) { if (xb_ld(&bar[XB_TMO])) break; if (sp > XB_SPIN_CAP) { atomicAdd(&bar[XB_TMO], 1u); break; } }
    }
    nloc = mine > 0u ? mine : 1u; nx = cnt > 0u ? cnt : 1u;
}
__device__ __forceinline__ void xcd_barrier(const XcdBarrier& b) {
    asm volatile("s_waitcnt vmcnt(0)" ::: "memory");
    __syncthreads();
    if (threadIdx.x == 0) {
        unsigned* bar = b.bar; asm volatile("" : "+s"(bar));
        __builtin_amdgcn_s_waitcnt(0);
        unsigned nloc = b.st[0], nx = b.st[1];
        if (nloc == 0u) { xcd_barrier_complete(bar, b.x, nloc, nx); b.st[0] = nloc; b.st[1] = nx; }
        const unsigned old = xb_add(&bar[XB_XSUB(b.x)], 1u);
        const unsigned gen = old / nloc;
        if (old + 1u == (gen + 1u) * nloc) {
            __builtin_amdgcn_fence(__ATOMIC_RELEASE, "agent");
            asm volatile("s_waitcnt vmcnt(0)" ::: "memory");
            const unsigned og = xb_add(&bar[XB_TOP], 1u);
            const unsigned tg = og / nx;
            if (og + 1u == (tg + 1u) * nx) xb_add(&bar[XB_TOPGEN], 1u);
            else XB_SPIN(xb_ld(&bar[XB_TOPGEN]) == tg, bar);
            __builtin_amdgcn_fence(__ATOMIC_ACQUIRE, "agent");
            xb_add(&bar[XB_XGEN(b.x)], 1u);
            asm volatile("s_waitcnt vmcnt(0)" ::: "memory");
        } else {
            XB_SPIN(xb_ld(&bar[XB_XGEN(b.x)]) == gen, bar);
            __builtin_amdgcn_fence(__ATOMIC_ACQUIRE, "agent");
            asm volatile("s_waitcnt vmcnt(0)" ::: "memory");
        }
    }
    __syncthreads();
}

constexpr size_t MiB = 1u << 20;
constexpr size_t WS_SSA = 0, WS_SSB = 1 * MiB, WS_SSQ = 2 * MiB, WS_SSKV = 3 * MiB, WS_BIASP = 3 * MiB + 512 * 1024, WS_BAR = 3 * MiB + 768 * 1024, BAR_ZERO_BYTES = 32768, WS_LFLAG = WS_BAR + 16384, WS_SPLITF = WS_BAR + 24576, WS_LCARRY = WS_BAR + 32768, WS_W = 4 * MiB, WS_XB = 55 * MiB, WS_R1 = 87 * MiB;
constexpr size_t WS_GG = 183 * MiB, WS_AC = 199 * MiB, WS_CQ = 215 * MiB, WS_Q = 227 * MiB, WS_KPE = 251 * MiB, WS_KR = 252 * MiB, WS_CS = 253 * MiB, WS_END = 255 * MiB;
constexpr size_t WS_CKV = WS_W;
constexpr size_t W_F1W1 = 0, W_F1W2 = 11 * MiB, W_F2W1 = 16 * MiB + 512 * 1024, W_F2W2 = 27 * MiB + 512 * 1024, W_IN = 33 * MiB, W_LRUO = 44 * MiB + 512 * 1024,
                 W_UQ = 45 * MiB + 512 * 1024, W_UKV = 46 * MiB + 256 * 1024, W_MLAO = 46 * MiB + 768 * 1024, W_CONVO = 47 * MiB + 768 * 1024, W_OUT = 48 * MiB + 768 * 1024;
constexpr size_t DO_XPRE = 0, DO_PC = 16 * MiB, DO_KN = 32 * MiB, DO_V = 48 * MiB, DO_O = 0, DO_MERGED = 32 * MiB;
constexpr int LDS_BYTES = 147456, LDS_BARST = LDS_BYTES - 64;
static_assert(att::L_END <= LDS_BARST && lru::L_END <= LDS_BARST && cv::L_END <= LDS_BARST && pg8::STAGE_BYTES <= LDS_BARST && XCD_BAR_WORDS * 4 <= BAR_ZERO_BYTES, "LDS / barrier map");
static_assert(att::L_END <= LDS_BYTES && lru::L_END <= LDS_BYTES && cv::L_END <= LDS_BYTES && pg8::STAGE_BYTES <= LDS_BYTES, "LDS");

__device__ const float INVF[16] = {1.0f, 0.5623413251903491f, 0.31622776601683794f, 0.1778279410038923f, 0.1f, 0.05623413251903491f, 0.031622776601683794f, 0.01778279410038923f,
                                   0.01f, 0.005623413251903491f, 0.0031622776601683794f, 0.001778279410038923f, 0.001f, 0.0005623413251903491f, 0.00031622776601683794f, 0.0001778279410038923f};

__device__ __forceinline__ int dest_row(int kind, int n0) {
    if (kind == 1) { if (n0 < FF) return 256 * (n0 / 128) + (n0 % 128); const int n1 = n0 - FF; return 256 * (n1 / 128) + 128 + (n1 % 128); }
    if (kind == 2) {
        if (n0 < 1696) return n0;
        if (n0 < 2208) { const int v = n0 - 1696; return 1792 + 256 * (v / 128) + (v % 128); }
        if (n0 < 2720) { const int v = n0 - 2208; return 1792 + 256 * (v / 128) + 128 + (v % 128); }
        return 2816 + (n0 - 2720);
    }
    return n0;
}
__device__ __forceinline__ void cvt_item(const float* W, int K, int N, bf16_t* WT, int kind, const float* gk, LAS float* scr, int item, int lane) {
    const int nblk = N / 32, kb = item / nblk, nb = item % nblk, k0 = 64 * kb, n0 = 32 * nb;
#pragma unroll 16
    for (int i = 0; i < 32; ++i) { const int kk = 2 * i + (lane >> 5); scr[kk * 33 + (lane & 31)] = __builtin_nontemporal_load(W + (size_t)(k0 + kk) * N + n0 + (lane & 31)); }
    asm volatile("s_waitcnt lgkmcnt(0)" ::: "memory");
    const int c = lane & 7; const int dr = dest_row(kind, n0);
    float gs[8];
#pragma unroll
    for (int i = 0; i < 8; ++i) gs[i] = gk ? gk[k0 + 8 * c + i] : 1.0f;
#pragma unroll
    for (int j = 0; j < 4; ++j) { const int n = (lane >> 3) + 8 * j; const LAS float* s = scr + (8 * c) * 33 + n;
        u32x4 o; o.x = cvt_pk_bf16(s[0 * 33] * gs[0], s[1 * 33] * gs[1]); o.y = cvt_pk_bf16(s[2 * 33] * gs[2], s[3 * 33] * gs[3]); o.z = cvt_pk_bf16(s[4 * 33] * gs[4], s[5 * 33] * gs[5]); o.w = cvt_pk_bf16(s[6 * 33] * gs[6], s[7 * 33] * gs[7]);
        *(u32x4*)(WT + (size_t)(dr + n) * K + k0 + 8 * c) = o; }
    asm volatile("s_waitcnt lgkmcnt(0)" ::: "memory");
}

#ifndef GASQ
#define GASQ __attribute__((address_space(1)))
#endif
__device__ __forceinline__ const float* gptr(const GASQ float* p) { asm volatile("" : "+s"(p)); return (const float*)p; }
struct KArgs { const void* in[30]; float* out; unsigned char* ws; int ph_lo, ph_hi; };

__global__ void __launch_bounds__(512, 2) fwd_kernel(KArgs a) {
    extern __shared__ __attribute__((aligned(16))) unsigned char lds_raw[];
    LAS unsigned char* lds = (LAS unsigned char*)lds_raw;
    cg::grid_group grid = cg::this_grid();
#define OPAQUE_TID int tid_ = threadIdx.x; asm volatile("" : "+v"(tid_)); const int tid = tid_, lane = tid & 63, wave = __builtin_amdgcn_readfirstlane(tid >> 6), gw = bid * 8 + wave;
#define CS ((float*)(ws_ + WS_CS))
#define BIASP ((float*)(ws_ + WS_BIASP))
#define XB ((bf16_t*)(ws_ + WS_XB))
#define HB ((bf16_t*)(ws_ + WS_R1))
#define GB ((bf16_t*)(ws_ + WS_R1))
#define GG ((bf16_t*)(ws_ + WS_GG))
#define AC ((bf16_t*)(ws_ + WS_AC))
#define CQ ((bf16_t*)(ws_ + WS_CQ))
#define CKV ((bf16_t*)(ws_ + WS_CKV))
#define QB ((bf16_t*)(ws_ + WS_Q))
#define KPE ((bf16_t*)(ws_ + WS_KPE))
#define KR ((bf16_t*)(ws_ + WS_KR))
#define XPRE ((bf16_t*)(do_ + DO_XPRE))
#define PC ((bf16_t*)(do_ + DO_PC))
#define KN ((bf16_t*)(do_ + DO_KN))
#define VB ((bf16_t*)(do_ + DO_V))
#define OB ((bf16_t*)(do_ + DO_O))
#define MG ((bf16_t*)(do_ + DO_MERGED))
#define WB (ws_ + WS_W)
    const int lo = a.ph_lo, hi = a.ph_hi;
    int ph = 0;
    if (threadIdx.x < 16) ((LAS unsigned*)(lds + LDS_BARST))[threadIdx.x] = 0u;
    __syncthreads();
    XcdBarrier xbar = xcd_barrier_post((unsigned*)(a.ws + WS_BAR), (volatile LAS unsigned*)(lds + LDS_BARST));
    if (hi < 0) grid.sync();
typedef const float* cfp_t; typedef unsigned char* ucp_t;
#define KAS __attribute__((address_space(4)))
#define GASQ __attribute__((address_space(1)))
#define PHASE_BEGIN if (ph >= lo && ph < hi) { int G = gridDim.x, bid = blockIdx.x; asm volatile("" : "+s"(G), "+s"(bid)); const int NGW = G * 8; (void)NGW;     \
    const KAS void* kp_ = (const KAS void*)__builtin_amdgcn_kernarg_segment_ptr(); asm volatile("" : "+s"(kp_)); \
    GASQ unsigned char* wsg_ = (GASQ unsigned char*)(((const KAS ucp_t*)kp_)[31]); GASQ unsigned char* dog_ = (GASQ unsigned char*)(((const KAS ucp_t*)kp_)[30]); asm volatile("" : "+s"(wsg_), "+s"(dog_)); \
    unsigned char* ws_ = (unsigned char*)wsg_; unsigned char* do_ = (unsigned char*)dog_;
#define PHASE_END   if (ph + 1 < hi) { for (int r_ = 0; r_ < REP_SYNC; ++r_) xcd_barrier(xbar); } } ++ph;
#define INF(i) (gptr((const GASQ float*)(((const KAS cfp_t*)kp_)[i])))

    for (int l = 0; l < 2; ++l) {
        PHASE_BEGIN
        {
            OPAQUE_TID
            LAS float* scr = (LAS float*)(lds + wave * 16384);
            const float* w1a = INF(3) + (size_t)l * DM * 5632; const float* w2a = INF(4) + (size_t)l * FF * DM;
            const float* w1b = INF(27) + (size_t)l * DM * 5632; const float* w2b = INF(28) + (size_t)l * FF * DM;
            const float* win = INF(6) + (size_t)l * DM * DIN;
            constexpr int I_W1 = 16 * 176, I_W2 = 44 * 32, I_IN = 16 * 181, I_LO = 8 * 32, I_UQ = 6 * 24, I_UKV = 4 * 32, I_OUT = 16 * 32;
            constexpr int NITEMS = 2 * I_W1 + 2 * I_W2 + I_IN + 3 * I_LO + I_UQ + I_UKV + I_OUT;
            for (int r_ = 0; r_ < REP_CVT; ++r_)
            for (int it = gw; it < NITEMS; it += NGW) {
                int r = it;
                if (r < I_W1) { cvt_item(w1a, DM, 5632, (bf16_t*)(WB + W_F1W1), 1, INF(2) + l * DM, scr, r, lane); continue; } r -= I_W1;
                if (r < I_W1) { cvt_item(w1b, DM, 5632, (bf16_t*)(WB + W_F2W1), 1, INF(26) + l * DM, scr, r, lane); continue; } r -= I_W1;
                if (r < I_IN) { cvt_item(win, DM, DIN, (bf16_t*)(WB + W_IN), 2, INF(5) + l * DM, scr, r, lane); continue; } r -= I_IN;
                if (r < I_W2) { cvt_item(w2a, FF, DM, (bf16_t*)(WB + W_F1W2), 0, nullptr, scr, r, lane); continue; } r -= I_W2;
                if (r < I_W2) { cvt_item(w2b, FF, DM, (bf16_t*)(WB + W_F2W2), 0, nullptr, scr, r, lane); continue; } r -= I_W2;
                if (r < I_OUT) { cvt_item(INF(25) + (size_t)l * DM * DM, DM, DM, (bf16_t*)(WB + W_OUT), 0, nullptr, scr, r, lane); continue; } r -= I_OUT;
                if (r < I_LO) { cvt_item(INF(13) + (size_t)l * 512 * DM, 512, DM, (bf16_t*)(WB + W_LRUO), 0, nullptr, scr, r, lane); continue; } r -= I_LO;
                if (r < I_LO) { cvt_item(INF(18) + (size_t)l * 512 * DM, 512, DM, (bf16_t*)(WB + W_MLAO), 0, nullptr, scr, r, lane); continue; } r -= I_LO;
                if (r < I_LO) { cvt_item(INF(23) + (size_t)l * 512 * DM, 512, DM, (bf16_t*)(WB + W_CONVO), 0, nullptr, scr, r, lane); continue; } r -= I_LO;
                if (r < I_UQ) { cvt_item(INF(15) + (size_t)l * 384 * 768, 384, 768, (bf16_t*)(WB + W_UQ), 0, INF(14) + l * 384, scr, r, lane); continue; } r -= I_UQ;
                cvt_item(INF(17) + (size_t)l * 256 * 1024, 256, 1024, (bf16_t*)(WB + W_UKV), 0, INF(16) + l * 256, scr, r, lane);
            }
            { u32x4* z = (u32x4*)((bf16_t*)(WB + W_IN) + (size_t)1696 * DM); for (int i = bid * 512 + tid; i < 96 * DM / 8; i += G * 512) { unsigned zz = 0u; asm volatile("" : "+v"(zz)); z[i] = (u32x4){zz, zz, zz, zz}; } }
            if (l == 0) {
                const float* x = INF(0);
                for (int m = gw; m < MROWS; m += NGW) {
                    const f32x4* xr = (const f32x4*)(x + (size_t)m * DM) + lane; float s = 0.f; f32x4 v[4];
#pragma unroll
                    for (int j = 0; j < 4; ++j) { v[j] = __builtin_nontemporal_load(xr + 64 * j); s += (v[j][0] * v[j][0] + v[j][1] * v[j][1]) + (v[j][2] * v[j][2] + v[j][3] * v[j][3]); }
                    s = wave_sum(s);
                    u32x2* o8 = (u32x2*)(XB + (size_t)m * DM) + lane;
#pragma unroll
                    for (int j = 0; j < 4; ++j) o8[64 * j] = (u32x2){cvt_pk_bf16(v[j][0], v[j][1]), cvt_pk_bf16(v[j][2], v[j][3])};
                    if (lane < 16) ((float*)(ws_ + WS_SSA))[(size_t)m * 16 + lane] = (lane == 0) ? s : 0.f;
                }
                const int* pos = (const int*)INF(1);
                for (int i = bid * 512 + tid; i < MROWS * 16; i += G * 512) { const int m = i >> 4, j = i & 15;
                    const float ang = (float)pos[m] * INVF[j];
                    double t = (double)ang * 0.15915494309189535; t -= rint(t); const float tf = (float)t;
                    CS[(size_t)m * 32 + j] = __builtin_amdgcn_cosf(tf); CS[(size_t)m * 32 + 16 + j] = __builtin_amdgcn_sinf(tf); }
                for (int i = bid * 512 + tid; i < 2 * DINP; i += G * 512) { const int ll = i / DINP, d = i % DINP; int n = -1;
                    if (d < 1696) n = d; else if (d < 1792) n = -1; else if (d < 2816) { const int t = d - 1792, p = t / 256, r = t % 256; n = (r < 128) ? (1696 + p * 128 + r) : (2208 + p * 128 + (r - 128)); } else n = 2720 + (d - 2816);
                    BIASP[i] = (n >= 0) ? INF(7)[(size_t)ll * DIN + n] : 0.f; }
            }
            __syncthreads();
        }
        PHASE_END

#define SSX(k) ((float*)(ws_ + ((((k) & 1) != 0) ? WS_SSB : WS_SSA)))
#define ss0 SSX(3 * l)
#define ss1 SSX(3 * l + 1)
#define ss2 SSX(3 * l + 2)
#define ss3 SSX(3 * l + 3)
#define ssq ((float*)(ws_ + WS_SSQ))
#define sskv ((float*)(ws_ + WS_SSKV))

        PHASE_BEGIN
#ifndef NO_G1
        for (int r_ = 0; r_ < REP_F1UP; ++r_) { pg8::Gemm g{XB, XB, XB, (bf16_t*)(WB + W_F1W1), nullptr, nullptr, MROWS, 5632, DM, DM}; pg8::StaticOrder S; S.init(MROWS, 5632, G, bid, 1, false);
          pg8::EpiUp E{HB, ss0}; pg8::gemm_phase<pg8::EpiUp, true>(lds, g, S, E);
          pg8::TailOrder T; T.init(MROWS, 5632, G, bid);
          if (T.on) { const int kh = T.half() * 512; pg8::Gemm gt{XB + kh, XB + kh, XB + kh, (bf16_t*)(WB + W_F1W1) + kh, nullptr, nullptr, MROWS, 5632, 512, DM};
              pg8::EpiUpTail Et{HB, ss0, (float*)do_, (unsigned*)(ws_ + WS_SPLITF) + (l * 2 + 0) * 128}; pg8::gemm_phase<pg8::EpiUpTail, true, pg8::TailOrder>(lds, gt, T, Et); } }
#endif
        PHASE_END
        PHASE_BEGIN
#ifndef NO_G2
        { pg8::Gemm g{HB, HB, HB, (bf16_t*)(WB + W_F1W2), nullptr, nullptr, MROWS, DM, FF, FF}; pg8::StaticOrder S; S.init(MROWS, DM, G, bid, 1);
          pg8::EpiRes E{XB, 0.5f, ss1, nullptr}; pg8::gemm_phase<pg8::EpiRes, true>(lds, g, S, E); }
#endif
        PHASE_END
        PHASE_BEGIN
#ifndef NO_G3
        for (int r_ = 0; r_ < REP_WIN; ++r_) { pg8::Gemm g{XB, XB, XB, (bf16_t*)(WB + W_IN), nullptr, nullptr, MROWS, DINP, DM, DM}; pg8::StaticOrder S; S.init(MROWS, DINP, G, bid, 1);
          pg8::EpiWin E{ss1, BIASP + l * DINP, XPRE, GG, CQ, CKV, KPE, PC, GB, ssq, sskv}; pg8::gemm_phase<pg8::EpiWin, true>(lds, g, S, E); }
#endif
        PHASE_END
        PHASE_BEGIN
#ifndef NO_G4
        for (int r_ = 0; r_ < REP_S4G; ++r_) { pg8::Gemm g{CQ, CQ, CQ, (bf16_t*)(WB + W_UQ), nullptr, nullptr, MROWS, 768, 384, 384}; pg8::StaticOrder S; S.init(MROWS, 768, G, bid, 1);
          pg8::EpiQ E{QB, ssq, CS}; pg8::gemm_phase<pg8::EpiQ, true>(lds, g, S, E); }
#endif
#ifndef NO_G4B
        for (int r_ = 0; r_ < REP_S4G; ++r_) { pg8::Gemm g{CKV, CKV, CKV, (bf16_t*)(WB + W_UKV), nullptr, nullptr, MROWS, 1024, 256, 256}; pg8::StaticOrder S; S.init(MROWS, 1024, G, bid, 1);
          pg8::EpiKV E{KN, VB, sskv}; pg8::gemm_phase<pg8::EpiKV, true>(lds, g, S, E); }
#endif
#ifndef NO_LRU
        for (int u = bid; u < 256; u += G)
            lru::lru_unit(u, l, XPRE, GG, INF(8) + l * 4 * 512, INF(9) + l * 512, INF(10) + (size_t)l * 8 * 64 * 128, INF(11) + l * 8 * 128, INF(12) + l * 512, (unsigned*)(ws_ + WS_LFLAG), (float*)(ws_ + WS_LCARRY), lds);
#endif
#ifndef NO_CONV
        for (int r_ = 0; r_ < REP_CONV; ++r_)
        for (int u = bid; u < 512; u += G)
            cv::conv_unit(u, PC, AC, INF(19) + l * 31 * 512, INF(20) + l * 512, INF(21) + l * 512, INF(22) + l * 512, KPE, KR, CS, lds);
#endif
        PHASE_END
        PHASE_BEGIN
#ifndef NO_ATT
        for (int r_ = 0; r_ < REP_ATT; ++r_)
        for (int u = ((G & 7) == 0 ? (bid & 7) * (G >> 3) + (bid >> 3) : bid); u < 256; u += G) { const int bh = u >> 2, s = u & 3;
            att::attn_block(bh >> 3, bh & 7, 7 - s, QB, KN, KR, VB, OB, lds);
            att::attn_block(bh >> 3, bh & 7, s, QB, KN, KR, VB, OB, lds); }
#endif
        PHASE_END
        PHASE_BEGIN
#ifndef NO_G6
        for (int r_ = 0; r_ < REP_MERGE; ++r_) { pg8::Gemm g{GG, OB, AC, (bf16_t*)(WB + W_LRUO), (bf16_t*)(WB + W_MLAO), (bf16_t*)(WB + W_CONVO), MROWS, DM, 512, 512}; pg8::StaticOrder S; S.init(MROWS, DM, G, bid, 3);
          pg8::EpiMerge E{GB, INF(24) + l * DM, MG}; pg8::gemm_phase<pg8::EpiMerge, true>(lds, g, S, E); }
#endif
        PHASE_END
        PHASE_BEGIN
#ifndef NO_G7
        { pg8::Gemm g{MG, MG, MG, (bf16_t*)(WB + W_OUT), nullptr, nullptr, MROWS, DM, DM, DM}; pg8::StaticOrder S; S.init(MROWS, DM, G, bid, 1);
          pg8::EpiRes E{XB, 1.0f, ss2, nullptr}; pg8::gemm_phase<pg8::EpiRes, true>(lds, g, S, E); }
#endif
        PHASE_END
        PHASE_BEGIN
#ifndef NO_G8
        { pg8::Gemm g{XB, XB, XB, (bf16_t*)(WB + W_F2W1), nullptr, nullptr, MROWS, 5632, DM, DM}; pg8::StaticOrder S; S.init(MROWS, 5632, G, bid, 1, false);
          pg8::EpiUp E{HB, ss2}; pg8::gemm_phase<pg8::EpiUp, true>(lds, g, S, E);
          pg8::TailOrder T; T.init(MROWS, 5632, G, bid);
          if (T.on) { const int kh = T.half() * 512; pg8::Gemm gt{XB + kh, XB + kh, XB + kh, (bf16_t*)(WB + W_F2W1) + kh, nullptr, nullptr, MROWS, 5632, 512, DM};
              pg8::EpiUpTail Et{HB, ss2, (float*)do_, (unsigned*)(ws_ + WS_SPLITF) + (l * 2 + 1) * 128}; pg8::gemm_phase<pg8::EpiUpTail, true, pg8::TailOrder>(lds, gt, T, Et); } }
#endif
        PHASE_END
        PHASE_BEGIN
#ifndef NO_G9
        { pg8::Gemm g{HB, HB, HB, (bf16_t*)(WB + W_F2W2), nullptr, nullptr, MROWS, DM, FF, FF}; pg8::StaticOrder S; S.init(MROWS, DM, G, bid, 1);
          pg8::EpiRes E{XB, 0.5f, ss3, (l == 1) ? (float*)do_ : nullptr}; pg8::gemm_phase<pg8::EpiRes, true>(lds, g, S, E); }
#endif
        PHASE_END
    }
    PHASE_BEGIN
    {
        OPAQUE_TID
        const float* ssf = (const float*)(ws_ + WS_SSA); const float* gf = INF(29);
        for (int m = gw; m < MROWS; m += NGW) {
            const float rs = rsqrtf(sum_slots16(ssf + (size_t)m * 16) * (1.0f / DM) + EPS);
            f32x4* xr = (f32x4*)((float*)do_ + (size_t)m * DM) + lane; const f32x4* gr = (const f32x4*)gf + lane;
#pragma unroll
            for (int j = 0; j < 4; ++j) xr[64 * j] = xr[64 * j] * rs * gr[64 * j];
        }
    }
    PHASE_END
}

constexpr int N_PHASES = 21;
#ifndef MK_PER_PHASE
#define MK_PER_PHASE 0
#endif

extern "C" void kernel_launch(void* const* d_in, const int* in_sizes, int n_in, void* d_out, int out_size, void* d_ws, size_t ws_size, hipStream_t stream) {
    static int grid = 0;
    if (grid == 0) {
        if (n_in != 30 || out_size != MROWS * DM || ws_size < WS_END) { fprintf(stderr, "kernel_launch: unexpected problem (n_in %d out %d ws %zu)\n", n_in, out_size, ws_size); grid = -1; return; }
        int dev = 0, cus = 0, per_cu = 0;
        hipGetDevice(&dev); hipDeviceGetAttribute(&cus, hipDeviceAttributeMultiprocessorCount, dev);
        hipFuncSetAttribute((const void*)fwd_kernel, hipFuncAttributeMaxDynamicSharedMemorySize, LDS_BYTES);
        hipOccupancyMaxActiveBlocksPerMultiprocessor(&per_cu, (const void*)fwd_kernel, 512, LDS_BYTES);
        if (per_cu < 1) { fprintf(stderr, "kernel_launch: occupancy query says %d blocks per CU\n", per_cu); per_cu = 1; }
        (void)hipGetLastError();
        grid = cus * 1;
    }
    if (grid < 0) return;
    hipMemsetAsync((char*)d_ws + WS_BAR, 0, BAR_ZERO_BYTES, stream);
    KArgs a{};
    for (int i = 0; i < 30; ++i) a.in[i] = d_in[i];
    a.out = (float*)d_out; a.ws = (unsigned char*)d_ws;
#if MK_PER_PHASE
    for (int p = 0; p < N_PHASES; ++p) { a.ph_lo = p; a.ph_hi = p + 1; hipLaunchKernelGGL(fwd_kernel, dim3(grid), dim3(512), LDS_BYTES, stream, a); }
#else
    a.ph_lo = 0; a.ph_hi = N_PHASES;
    void* args[] = {&a};
    hipError_t e = hipLaunchCooperativeKernel((const void*)fwd_kernel, dim3(grid), dim3(512), args, LDS_BYTES, stream);
    if (e != hipSuccess) fprintf(stderr, "cooperative launch failed: %s (grid %d)\n", hipGetErrorString(e), grid);
#endif
}
```

```cpp
#include <hip/hip_runtime.h>
#include <hip/hip_cooperative_groups.h>
#include <cstdio>
#include <cstdint>
namespace cg = cooperative_groups;

#define LAS __attribute__((address_space(3)))
typedef unsigned short bf16_t;
typedef short bf16x8 __attribute__((ext_vector_type(8)));
typedef short s16x4 __attribute__((ext_vector_type(4)));
typedef float f32x2 __attribute__((ext_vector_type(2)));
typedef float f32x4 __attribute__((ext_vector_type(4)));
typedef float f32x16 __attribute__((ext_vector_type(16)));
typedef unsigned u32x2 __attribute__((ext_vector_type(2)));
typedef unsigned u32x4 __attribute__((ext_vector_type(4)));

#ifndef REP_ATT
#define REP_ATT 1
#endif
#ifndef REP_F1UP
#define REP_F1UP 1
#endif
#ifndef REP_WIN
#define REP_WIN 1
#endif
#ifndef REP_S4G
#define REP_S4G 1
#endif
#ifndef REP_CONV
#define REP_CONV 1
#endif
#ifndef REP_MERGE
#define REP_MERGE 1
#endif
#ifndef REP_SYNC
#define REP_SYNC 1
#endif
#ifndef REP_CVT
#define REP_CVT 1
#endif
#ifndef REP_LRU
#define REP_LRU 1
#endif
constexpr int MROWS = 16384, DM = 1024, FF = 2816, SEQ = 2048, NB = 8;
constexpr int DIN = 5792, DINP = 5888;
constexpr float EPS = 1e-6f;
constexpr float QSCALE = 0.10206207261596577f * 1.4426950408889634f;

__device__ __forceinline__ unsigned cvt_pk_bf16(float lo, float hi) { unsigned r; asm volatile("v_cvt_pk_bf16_f32 %0, %1, %2" : "=v"(r) : "v"(lo), "v"(hi)); return r; }
__device__ __forceinline__ float bflo(unsigned w) { return __uint_as_float(w << 16); }
__device__ __forceinline__ float bfhi(unsigned w) { return __uint_as_float(w & 0xffff0000u); }
__device__ __forceinline__ float bf2f(bf16_t v) { return __uint_as_float(((unsigned)v) << 16); }
__device__ __forceinline__ bf16_t f2bf(float f) { return (bf16_t)(cvt_pk_bf16(f, 0.f) & 0xffffu); }
__device__ __forceinline__ float fast_sigmoid(float x) { return __builtin_amdgcn_rcpf(1.0f + __builtin_amdgcn_exp2f(-1.4426950408889634f * x)); }
__device__ __forceinline__ float wave_sum(float v) {
#pragma unroll
    for (int o = 1; o < 64; o <<= 1) v += __shfl_xor(v, o);
    return v;
}

__device__ __forceinline__ float sum_slots16(const float* p) { const f32x4 a = *(const f32x4*)p, b = *(const f32x4*)(p + 4), c = *(const f32x4*)(p + 8), d = *(const f32x4*)(p + 12);
    return (((a[0] + a[1]) + (a[2] + a[3])) + ((b[0] + b[1]) + (b[2] + b[3]))) + (((c[0] + c[1]) + (c[2] + c[3])) + ((d[0] + d[1]) + (d[2] + d[3]))); }
__device__ __forceinline__ float sum_slots12(const float* p) { const f32x4 a = *(const f32x4*)p, b = *(const f32x4*)(p + 4), c = *(const f32x4*)(p + 8);
    return (((a[0] + a[1]) + (a[2] + a[3])) + ((b[0] + b[1]) + (b[2] + b[3]))) + ((c[0] + c[1]) + (c[2] + c[3])); }
__device__ __forceinline__ float sum_slots8(const float* p) { const f32x4 a = *(const f32x4*)p, b = *(const f32x4*)(p + 4);
    return ((a[0] + a[1]) + (a[2] + a[3])) + ((b[0] + b[1]) + (b[2] + b[3])); }

namespace pg8 {
constexpr int BM = 256, BK = 64, HALF = 128, HTB = HALF * BK * 2, STAGE_BYTES = 8 * HTB, NXCD = 8, WGM = 4;
__host__ __device__ __forceinline__ int lds_byte(int r, int c) { const int st = (r >> 4) * 2 + (c >> 5), rr = r & 15, cc = c & 31, ob = rr * 64 + cc * 2; return st * 1024 + (ob ^ (((ob >> 9) & 1) << 5)); }
__host__ __device__ __forceinline__ void stage_rc(int b, int& R, int& C) { const int st = b / 1024, sb = b % 1024, swz = sb ^ (((sb >> 9) & 1) << 5); R = (st >> 1) * 16 + swz / 64; C = (st & 1) * 32 + (swz % 64) / 2; }
__host__ __device__ __forceinline__ int perm32(int rho) { const int n = rho >> 4, i = rho & 15; return 8 * (i >> 2) + 4 * n + (i & 3); }

struct Unit { int pm, pn, seg, split, slot; };
struct Gemm { const bf16_t *A0, *A1, *A2; const bf16_t *B0, *B1, *B2; int M, N, K, LD;
    __device__ __forceinline__ const char* a(int s) const { return (const char*)(s == 0 ? A0 : (s == 1 ? A1 : A2)); }
    __device__ __forceinline__ const char* b(int s) const { return (const char*)(s == 0 ? B0 : (s == 1 ? B1 : B2)); } };

__device__ __forceinline__ void unit_of(int L, int nwg, int nM, int nN, Unit& u) {
    int wgid = L; { const int q = nwg / NXCD, r = nwg % NXCD, xcd = wgid % NXCD, off = wgid / NXCD; wgid = (xcd < r ? xcd * (q + 1) : r * (q + 1) + (xcd - r) * q) + off; }
    const int nig = WGM * nN, gid = wgid / nig, fm = gid * WGM, gsz = (nM - fm) < WGM ? (nM - fm) : WGM;
    u.pm = fm + ((wgid % nig) % gsz); u.pn = (wgid % nig) / gsz;
}
struct StaticOrder {
    int nM, nN, nwg, G, c, nseg, nlim;
    __device__ __forceinline__ void init(int M, int N, int G_, int c_, int nseg_, bool split_tail = false) { nM = M / BM; nN = N / BM; nwg = nM * nN; G = G_; c = c_; nseg = nseg_;
        nlim = (split_tail && 2 * (nwg % G_) == G_) ? (nwg / G_) * G_ : nwg; }
    __device__ __forceinline__ bool next(int i, Unit& u) const {
        const int ti = i / nseg; u.seg = i - ti * nseg; u.split = 0; u.slot = 0;
        const long L = (long)ti * G + c; if (L >= nlim) return false;
        unit_of((int)L, nwg, nM, nN, u); return true;
    }
};
struct TailOrder {
    int nM, nN, nwg, G, c, on;
    __device__ __forceinline__ void init(int M, int N, int G_, int c_) { nM = M / BM; nN = N / BM; nwg = nM * nN; G = G_; c = c_; on = 0; (void)G_; }
    __device__ __forceinline__ int half() const { return (c >= (G >> 1)) ? 1 : 0; }
    __device__ __forceinline__ bool next(int i, Unit& u) const {
        if (!on || i != 0) return false;
        u.seg = 0; u.slot = c - half() * (G >> 1); u.split = 1 + half();
        unit_of((nwg / G) * G + u.slot, nwg, nM, nN, u); return true;
    }
};

template <class Epi, bool ALIGN_EPI, class Order = StaticOrder>
__device__ __forceinline__ void gemm_phase(LAS unsigned char* lds, const Gemm g, const Order& S, const Epi& E) {
    int tid_ = threadIdx.x; asm volatile("" : "+v"(tid_));
    const int tid = tid_, wid = __builtin_amdgcn_readfirstlane(tid >> 6), lane = tid & 63, wr = wid >> 2, wc = wid & 3, fr = lane & 15, fq = lane >> 4;
    const int K = g.LD, nt = g.K / BK;
    const char *gA0 = (const char*)g.A0, *gA1 = (const char*)g.A1, *gA2 = (const char*)g.A2, *gB0 = (const char*)g.B0, *gB1 = (const char*)g.B1, *gB2 = (const char*)g.B2;
    asm volatile("" : "+s"(gA0), "+s"(gA1), "+s"(gA2), "+s"(gB0), "+s"(gB1), "+s"(gB2));
#define PG8_SELA(s) ((s) == 0 ? gA0 : ((s) == 1 ? gA1 : gA2))
#define PG8_SELB(s) ((s) == 0 ? gB0 : ((s) == 1 ? gB1 : gB2))
    unsigned voffA[2], voffB[2];
#pragma unroll
    for (int i = 0; i < 2; ++i) { int R, C; stage_rc(tid * 16 + i * 8192, R, C); const int Rb = Epi::PERM ? ((R & ~31) + perm32(R & 31)) : R;
        voffA[i] = (unsigned)(R * K + C) * 2u; voffB[i] = (unsigned)(Rb * K + C) * 2u; }
    const size_t kstep = (size_t)(BK * 2);
    const size_t hstep = (size_t)HALF * K * 2;
    const size_t tstep = 2 * hstep;
    const unsigned ldsw = (unsigned)wid * 1024u;
    const int aoff = lds_byte(wr * 64 + fr, fq * 8), boff = lds_byte(wc * 32 + fr, fq * 8);
#define PG8_SA(b, h) (((b) * 2 + (h)) * HTB)
#define PG8_SB(b, h) ((4 + (b) * 2 + (h)) * HTB)
#define PG8_STAGE(bufoff, gbase, voff) do { _Pragma("unroll") for (int _i = 0; _i < 2; ++_i) \
        __builtin_amdgcn_global_load_lds((const unsigned*)((const char*)(gbase) + (voff)[_i]), (LAS unsigned*)(lds + (bufoff) + ldsw + _i * 8192), 16, 0, 0); } while (0)
#define PG8_LDA(dst, b, h) do { _Pragma("unroll") for (int m = 0; m < 4; ++m) _Pragma("unroll") for (int k = 0; k < 2; ++k) dst[m][k] = *(const LAS bf16x8*)(lds + PG8_SA(b, h) + aoff + m * 2048 + k * 1024); } while (0)
#define PG8_LDB(dst, b, h) do { _Pragma("unroll") for (int n = 0; n < 2; ++n) _Pragma("unroll") for (int k = 0; k < 2; ++k) dst[n][k] = *(const LAS bf16x8*)(lds + PG8_SB(b, h) + boff + n * 2048 + k * 1024); } while (0)
#define PG8_MMA(ai, bj, At, Bt) do { __builtin_amdgcn_s_setprio(1); _Pragma("unroll") for (int m = 0; m < 4; ++m) _Pragma("unroll") for (int n = 0; n < 2; ++n) _Pragma("unroll") for (int k = 0; k < 2; ++k) \
        acc[ai][bj][m][n] = __builtin_amdgcn_mfma_f32_16x16x32_bf16(Bt[n][k], At[m][k], acc[ai][bj][m][n], 0, 0, 0); __builtin_amdgcn_s_setprio(0); } while (0)
#define PG8_WAIT_V(n) asm volatile("s_waitcnt vmcnt(" #n ")" ::: "memory")
#define PG8_WAIT_L(n) asm volatile("s_waitcnt lgkmcnt(" #n ")" ::: "memory")
#define PG8_BAR __builtin_amdgcn_s_barrier()
#define PG8_SCHED __builtin_amdgcn_sched_barrier(0)
    Unit cur, nxt; int ui = 0;
    if (!S.next(0, cur)) return;
    f32x4 acc[2][2][4][2];
#pragma unroll
    for (int a = 0; a < 2; ++a)
#pragma unroll
        for (int b = 0; b < 2; ++b)
#pragma unroll
            for (int m = 0; m < 4; ++m)
#pragma unroll
                for (int n = 0; n < 2; ++n) acc[a][b][m][n] = (f32x4){0.f, 0.f, 0.f, 0.f};
    bf16x8 At[4][2], B0[2][2], B1[2][2];
    const char* cA = PG8_SELA(cur.seg) + (size_t)cur.pm * tstep; const char* cB = PG8_SELB(cur.seg) + (size_t)cur.pn * tstep;
    PG8_STAGE(PG8_SB(0, 0), cB, voffB); PG8_STAGE(PG8_SB(0, 1), cB + hstep, voffB); PG8_STAGE(PG8_SA(0, 0), cA, voffA); PG8_STAGE(PG8_SA(0, 1), cA + hstep, voffA);
    if (wr == 1) PG8_BAR;
    PG8_WAIT_V(2); PG8_BAR;
    PG8_STAGE(PG8_SB(1, 0), cB + kstep, voffB); PG8_STAGE(PG8_SA(1, 0), cA + kstep, voffA); PG8_STAGE(PG8_SB(1, 1), cB + hstep + kstep, voffB);
    PG8_WAIT_V(6); PG8_BAR;
    for (;;) {
        const bool has_next = S.next(ui + 1, nxt);
        const char* nA = has_next ? PG8_SELA(nxt.seg) + (size_t)nxt.pm * tstep : cA; const char* nB = has_next ? PG8_SELB(nxt.seg) + (size_t)nxt.pn * tstep : cB;
#pragma unroll 1
        for (int t = 0; t < nt; t += 2) {
            const bool last = (t == nt - 2);
            const char* a1 = cA + (size_t)(t + 1) * kstep;
            const char* a2 = last ? nA : cA + (size_t)(t + 2) * kstep; const char* b2 = last ? nB : cB + (size_t)(t + 2) * kstep;
            const char* a3 = a2 + kstep; const char* b3 = b2 + kstep;
            PG8_LDB(B0, 0, 0); PG8_LDB(B1, 0, 1); PG8_SCHED; PG8_LDA(At, 0, 0); PG8_STAGE(PG8_SA(1, 1), a1 + hstep, voffA);
            PG8_WAIT_V(8); PG8_WAIT_L(0); PG8_BAR; PG8_MMA(0, 0, At, B0); PG8_MMA(0, 1, At, B1); PG8_BAR; PG8_SCHED;
            PG8_LDA(At, 0, 1); PG8_STAGE(PG8_SB(0, 0), b2, voffB); PG8_STAGE(PG8_SB(0, 1), b2 + hstep, voffB); PG8_STAGE(PG8_SA(0, 0), a2, voffA);
            PG8_WAIT_V(8); PG8_WAIT_L(0); PG8_BAR; PG8_MMA(1, 0, At, B0); PG8_MMA(1, 1, At, B1); PG8_BAR; PG8_SCHED;
            PG8_LDB(B0, 1, 0); PG8_LDB(B1, 1, 1); PG8_SCHED; PG8_LDA(At, 1, 0); PG8_STAGE(PG8_SA(0, 1), a2 + hstep, voffA);
            PG8_WAIT_V(8); PG8_WAIT_L(0); PG8_BAR; PG8_MMA(0, 0, At, B0); PG8_MMA(0, 1, At, B1); PG8_BAR; PG8_SCHED;
            PG8_LDA(At, 1, 1); PG8_STAGE(PG8_SB(1, 0), b3, voffB); PG8_STAGE(PG8_SB(1, 1), b3 + hstep, voffB); PG8_STAGE(PG8_SA(1, 0), a3, voffA);
            PG8_WAIT_V(8); PG8_WAIT_L(0); PG8_BAR; PG8_MMA(1, 0, At, B0); PG8_MMA(1, 1, At, B1); PG8_BAR; PG8_SCHED;
        }
        if constexpr (ALIGN_EPI) { if (wr == 0) PG8_BAR; }
        const bool zero = E(acc, cur, wr, wc, fr, fq);
        if (!has_next) break;
        if (zero) {
#pragma unroll
            for (int a = 0; a < 2; ++a)
#pragma unroll
                for (int b = 0; b < 2; ++b)
#pragma unroll
                    for (int m = 0; m < 4; ++m)
#pragma unroll
                        for (int n = 0; n < 2; ++n) acc[a][b][m][n] = (f32x4){0.f, 0.f, 0.f, 0.f};
        }
        cur = nxt; cA = nA; cB = nB; ++ui;
        if constexpr (ALIGN_EPI) { if (wr == 1) PG8_BAR; }
    }
    PG8_WAIT_V(0);
    if constexpr (!ALIGN_EPI) { if (wr == 0) PG8_BAR; }
    PG8_BAR;
#undef PG8_SA
#undef PG8_SB
#undef PG8_STAGE
#undef PG8_LDA
#undef PG8_LDB
#undef PG8_MMA
#undef PG8_WAIT_V
#undef PG8_WAIT_L
#undef PG8_BAR
#undef PG8_SCHED
}

#define EPI_ROW(ai, m) (u.pm * BM + (ai) * HALF + wr * 64 + (m) * 16 + fr)
__device__ __forceinline__ u32x4 pack8(const f32x4 a, const f32x4 b) { u32x4 w; w.x = cvt_pk_bf16(a[0], a[1]); w.y = cvt_pk_bf16(a[2], a[3]); w.z = cvt_pk_bf16(b[0], b[1]); w.w = cvt_pk_bf16(b[2], b[3]); return w; }

struct EpiUp {
    static constexpr bool PERM = true;
    bf16_t* H; const float* ss;
    __device__ __forceinline__ bool operator()(f32x4 (&acc)[2][2][4][2], const Unit& u, int wr, int wc, int fr, int fq) const {
        asm volatile("" : "+v"(fr), "+v"(fq));
#pragma unroll
        for (int ai = 0; ai < 2; ++ai)
#pragma unroll
            for (int m = 0; m < 4; ++m) {
                const int row = EPI_ROW(ai, m);
                const float rs = rsqrtf(sum_slots16(ss + (size_t)row * 16) * (1.0f / DM) + EPS);
                f32x4 o[2];
#pragma unroll
                for (int n = 0; n < 2; ++n)
#pragma unroll
                    for (int i = 0; i < 4; ++i) { const float gv = acc[ai][0][m][n][i] * rs, uv = acc[ai][1][m][n][i] * rs; o[n][i] = gv * fast_sigmoid(gv) * uv; }
                *(u32x4*)(H + (size_t)row * FF + u.pn * 128 + wc * 32 + fq * 8) = pack8(o[0], o[1]);
            }
        return true;
    }
};

struct EpiUpTail {
    static constexpr bool PERM = true;
    bf16_t* H; const float* ss; float* P; unsigned* flg;
    __device__ __forceinline__ bool operator()(f32x4 (&acc)[2][2][4][2], const Unit& u, int wr, int wc, int fr, int fq) const {
        asm volatile("" : "+v"(fr), "+v"(fq));
        const int tid = threadIdx.x;
        float* pp = P + (size_t)u.slot * (32 * 2048) + tid * 4;
        if (u.split == 2) {
#pragma unroll
            for (int ai = 0; ai < 2; ++ai)
#pragma unroll
                for (int bj = 0; bj < 2; ++bj)
#pragma unroll
                    for (int m = 0; m < 4; ++m)
#pragma unroll
                        for (int n = 0; n < 2; ++n) *(f32x4*)(pp + (((ai * 2 + bj) * 4 + m) * 2 + n) * 2048) = acc[ai][bj][m][n];
            __threadfence();
            __syncthreads();
            if (tid == 0) __hip_atomic_store(flg + u.slot, 1u, __ATOMIC_RELEASE, __HIP_MEMORY_SCOPE_AGENT);
            return true;
        }
        if (tid == 0) { unsigned sp = 0; while (__hip_atomic_load(flg + u.slot, __ATOMIC_RELAXED, __HIP_MEMORY_SCOPE_AGENT) == 0u) { __builtin_amdgcn_s_sleep(2); if (++sp > (1u << 22)) break; } }
        __syncthreads();
        __builtin_amdgcn_fence(__ATOMIC_ACQUIRE, "agent");
#pragma unroll
        for (int ai = 0; ai < 2; ++ai)
#pragma unroll
            for (int m = 0; m < 4; ++m) {
                const int row = EPI_ROW(ai, m);
                const float rs = rsqrtf(sum_slots16(ss + (size_t)row * 16) * (1.0f / DM) + EPS);
                f32x4 o[2], ga[2], ua[2];
#pragma unroll
                for (int n = 0; n < 2; ++n) { ga[n] = acc[ai][0][m][n] + *(const f32x4*)(pp + (((ai * 2 + 0) * 4 + m) * 2 + n) * 2048); ua[n] = acc[ai][1][m][n] + *(const f32x4*)(pp + (((ai * 2 + 1) * 4 + m) * 2 + n) * 2048); }
#pragma unroll
                for (int n = 0; n < 2; ++n)
#pragma unroll
                    for (int i = 0; i < 4; ++i) { const float gv = ga[n][i] * rs, uv = ua[n][i] * rs; o[n][i] = gv * fast_sigmoid(gv) * uv; }
                *(u32x4*)(H + (size_t)row * FF + u.pn * 128 + wc * 32 + fq * 8) = pack8(o[0], o[1]);
                asm volatile("" ::: "memory");
            }
        return true;
    }
};

struct EpiRes {
    static constexpr bool PERM = true;
    bf16_t* XB; float alpha; float* ssn; float* outf;
    __device__ __forceinline__ bool operator()(f32x4 (&acc)[2][2][4][2], const Unit& u, int wr, int wc, int fr, int fq) const {
        asm volatile("" : "+v"(fr), "+v"(fq));
#pragma unroll
        for (int ai = 0; ai < 2; ++ai)
#pragma unroll
            for (int m = 0; m < 4; ++m) {
                const int row = EPI_ROW(ai, m);
                float sq = 0.f;
#pragma unroll
                for (int bj = 0; bj < 2; ++bj) {
                    const size_t off = (size_t)row * DM + u.pn * BM + bj * HALF + wc * 32 + fq * 8;
                    const u32x4 old = *(const u32x4*)(XB + off);
                    f32x4 a, b;
                    a[0] = bflo(old.x) + alpha * acc[ai][bj][m][0][0]; a[1] = bfhi(old.x) + alpha * acc[ai][bj][m][0][1];
                    a[2] = bflo(old.y) + alpha * acc[ai][bj][m][0][2]; a[3] = bfhi(old.y) + alpha * acc[ai][bj][m][0][3];
                    b[0] = bflo(old.z) + alpha * acc[ai][bj][m][1][0]; b[1] = bfhi(old.z) + alpha * acc[ai][bj][m][1][1];
                    b[2] = bflo(old.w) + alpha * acc[ai][bj][m][1][2]; b[3] = bfhi(old.w) + alpha * acc[ai][bj][m][1][3];
                    sq += (a[0] * a[0] + a[1] * a[1]) + (a[2] * a[2] + a[3] * a[3]) + (b[0] * b[0] + b[1] * b[1]) + (b[2] * b[2] + b[3] * b[3]);
                    *(u32x4*)(XB + off) = pack8(a, b);
                    if (outf) { *(f32x4*)(outf + off) = a; *(f32x4*)(outf + off + 4) = b; }
                }
                sq += __shfl_xor(sq, 16); sq += __shfl_xor(sq, 32);
                if (fq == 0) ssn[(size_t)row * 16 + u.pn * 4 + wc] = sq;
            }
        return true;
    }
};

struct EpiWin {
    static constexpr bool PERM = true;
    const float* ss; const float* biasP;
    bf16_t *XPRE, *GG, *CQ, *CKV, *KPE, *PC, *G; float *ssq, *sskv;
    __device__ __forceinline__ bool operator()(f32x4 (&acc)[2][2][4][2], const Unit& u, int wr, int wc, int fr, int fq) const {
        asm volatile("" : "+v"(fr), "+v"(fq));
        const int pn = u.pn;
        const int cl = wc * 32 + fq * 8;
        f32x4 bv[2][2];
#pragma unroll
        for (int bj = 0; bj < 2; ++bj)
#pragma unroll
            for (int n = 0; n < 2; ++n) bv[bj][n] = *(const f32x4*)(biasP + pn * BM + bj * HALF + cl + 4 * n);
#pragma unroll
        for (int ai = 0; ai < 2; ++ai)
#pragma unroll
            for (int m = 0; m < 4; ++m) {
                const int row = EPI_ROW(ai, m);
                const float rs = rsqrtf(sum_slots16(ss + (size_t)row * 16) * (1.0f / DM) + EPS);
                f32x4 v[2][2];
#pragma unroll
                for (int bj = 0; bj < 2; ++bj)
#pragma unroll
                    for (int n = 0; n < 2; ++n) v[bj][n] = acc[ai][bj][m][n] * rs + bv[bj][n];
                if (pn < 2) {
#pragma unroll
                    for (int bj = 0; bj < 2; ++bj) *(u32x4*)(XPRE + (size_t)row * 512 + pn * BM + bj * HALF + cl) = pack8(v[bj][0], v[bj][1]);
                } else if (pn < 4) {
#pragma unroll
                    for (int bj = 0; bj < 2; ++bj) {
#pragma unroll
                        for (int n = 0; n < 2; ++n)
#pragma unroll
                            for (int i = 0; i < 4; ++i) { const float x = v[bj][n][i]; const float z = 1.5957691216057308f * (x + 0.044715f * x * x * x); v[bj][n][i] = x * fast_sigmoid(z); }
                        *(u32x4*)(GG + (size_t)row * 512 + (pn - 2) * BM + bj * HALF + cl) = pack8(v[bj][0], v[bj][1]);
                    }
                } else if (pn < 7) {
#pragma unroll
                    for (int bj = 0; bj < 2; ++bj) {
                        const int seg = (pn - 4) * 2 + bj;
                        float sq = 0.f;
#pragma unroll
                        for (int n = 0; n < 2; ++n)
#pragma unroll
                            for (int i = 0; i < 4; ++i) sq += v[bj][n][i] * v[bj][n][i];
                        sq += __shfl_xor(sq, 16); sq += __shfl_xor(sq, 32);
                        const u32x4 w = pack8(v[bj][0], v[bj][1]);
                        if (seg < 3) { *(u32x4*)(CQ + (size_t)row * 384 + seg * 128 + cl) = w; if (fq == 0) ssq[(size_t)row * 16 + seg * 4 + wc] = sq; }
                        else if (seg < 5) { *(u32x4*)(CKV + (size_t)row * 256 + (seg - 3) * 128 + cl) = w; if (fq == 0) sskv[(size_t)row * 8 + (seg - 3) * 4 + wc] = sq; }
                        else if (wc == 0) { *(u32x4*)(KPE + (size_t)row * 32 + fq * 8) = w; }
                    }
                } else if (pn < 11) {
                    f32x4 o[2];
#pragma unroll
                    for (int n = 0; n < 2; ++n)
#pragma unroll
                        for (int i = 0; i < 4; ++i) o[n][i] = v[0][n][i] * fast_sigmoid(v[1][n][i]);
                    *(u32x4*)(PC + (size_t)row * 512 + (pn - 7) * 128 + cl) = pack8(o[0], o[1]);
                } else {
#pragma unroll
                    for (int bj = 0; bj < 2; ++bj) {
#pragma unroll
                        for (int n = 0; n < 2; ++n)
#pragma unroll
                            for (int i = 0; i < 4; ++i) v[bj][n][i] = fmaxf(fast_sigmoid(v[bj][n][i]), 1e-30f);
                        *(u32x4*)(G + (size_t)row * 3072 + (pn - 11) * BM + bj * HALF + cl) = pack8(v[bj][0], v[bj][1]);
                    }
                }
            }
        return true;
    }
};

struct EpiQ {
    static constexpr bool PERM = false;
    bf16_t* Q; const float* ssq; const float* CS;
    __device__ __forceinline__ bool operator()(f32x4 (&acc)[2][2][4][2], const Unit& u, int wr, int wc, int fr, int fq) const {
        asm volatile("" : "+v"(fr), "+v"(fq));
        float rsv[2][4];
#pragma unroll
        for (int ai = 0; ai < 2; ++ai) {
#pragma unroll
            for (int m = 0; m < 4; ++m) rsv[ai][m] = sum_slots12(ssq + (size_t)EPI_ROW(ai, m) * 16);
            asm volatile("" ::: "memory"); }
#pragma unroll
        for (int ai = 0; ai < 2; ++ai)
#pragma unroll
            for (int m = 0; m < 4; ++m) {
                const int row = EPI_ROW(ai, m);
                const float rs = rsqrtf(rsv[ai][m] * (1.0f / 384.0f) + EPS) * QSCALE;
                const f32x4 cs = *(const f32x4*)(CS + (size_t)row * 32 + 4 * fq), sn = *(const f32x4*)(CS + (size_t)row * 32 + 16 + 4 * fq);
#pragma unroll
                for (int bj = 0; bj < 2; ++bj) {
                    const int c0 = u.pn * BM + bj * HALF + wc * 32;
                    f32x4 x1 = acc[ai][bj][m][0] * rs, x2 = acc[ai][bj][m][1] * rs;
                    if ((c0 % 96) == 64) { const f32x4 y1 = x1 * cs - x2 * sn, y2 = x2 * cs + x1 * sn; x1 = y1; x2 = y2; }
                    u32x2 w1, w2; w1.x = cvt_pk_bf16(x1[0], x1[1]); w1.y = cvt_pk_bf16(x1[2], x1[3]); w2.x = cvt_pk_bf16(x2[0], x2[1]); w2.y = cvt_pk_bf16(x2[2], x2[3]);
                    *(u32x2*)(Q + (size_t)row * 768 + c0 + 4 * fq) = w1; *(u32x2*)(Q + (size_t)row * 768 + c0 + 16 + 4 * fq) = w2;
                }
            }
        return true;
    }
};

struct EpiKV {
    static constexpr bool PERM = true;
    bf16_t *KN, *V; const float* sskv;
    __device__ __forceinline__ bool operator()(f32x4 (&acc)[2][2][4][2], const Unit& u, int wr, int wc, int fr, int fq) const {
        asm volatile("" : "+v"(fr), "+v"(fq));
        float rsv[2][4];
#pragma unroll
        for (int ai = 0; ai < 2; ++ai)
#pragma unroll
            for (int m = 0; m < 4; ++m) rsv[ai][m] = sum_slots8(sskv + (size_t)EPI_ROW(ai, m) * 8);
#pragma unroll
        for (int ai = 0; ai < 2; ++ai)
#pragma unroll
            for (int m = 0; m < 4; ++m) {
                const int row = EPI_ROW(ai, m);
                const float rs = rsqrtf(rsv[ai][m] * (1.0f / 256.0f) + EPS);
#pragma unroll
                for (int bj = 0; bj < 2; ++bj) {
                    const int head = u.pn * 2 + bj; const int j = wc * 32 + fq * 8;
                    const u32x4 w = pack8(acc[ai][bj][m][0] * rs, acc[ai][bj][m][1] * rs);
                    if (wc < 2) *(u32x4*)(KN + (size_t)row * 512 + head * 64 + j) = w;
                    else        *(u32x4*)(V + (size_t)row * 512 + head * 64 + (j - 64)) = w;
                }
            }
        return true;
    }
};

struct EpiMerge {
    static constexpr bool PERM = true;
    const bf16_t* G; const float* bc; bf16_t* OUT;
    __device__ __forceinline__ bool operator()(f32x4 (&acc)[2][2][4][2], const Unit& u, int wr, int wc, int fr, int fq) const {
        asm volatile("" : "+v"(fr), "+v"(fq));
        const int seg = u.seg;
        const int colb = u.pn * BM + wc * 32 + fq * 8;
#pragma unroll
        for (int ai = 0; ai < 2; ++ai)
#pragma unroll
        for (int mh = 0; mh < 2; ++mh) {
            u32x4 ga[2][2], gb[2][2];
#pragma unroll
            for (int mm = 0; mm < 2; ++mm)
#pragma unroll
                for (int bj = 0; bj < 2; ++bj) {
                    const bf16_t* gp = G + (size_t)EPI_ROW(ai, 2 * mh + mm) * 3072 + seg * 1024 + colb + bj * HALF;
                    ga[mm][bj] = *(const u32x4*)gp;
                    gb[mm][bj] = (seg < 2) ? *(const u32x4*)(gp + 1024) : ga[mm][bj];
                }
            if (seg < 2) {
#pragma unroll
                for (int mm = 0; mm < 2; ++mm)
#pragma unroll
                    for (int bj = 0; bj < 2; ++bj) {
                        const int m = 2 * mh + mm; const u32x4 a = ga[mm][bj], b = gb[mm][bj];
                        const f32x4 r0 = {bflo(a.x) * __builtin_amdgcn_rcpf(bflo(b.x)), bfhi(a.x) * __builtin_amdgcn_rcpf(bfhi(b.x)), bflo(a.y) * __builtin_amdgcn_rcpf(bflo(b.y)), bfhi(a.y) * __builtin_amdgcn_rcpf(bfhi(b.y))};
                        const f32x4 r1 = {bflo(a.z) * __builtin_amdgcn_rcpf(bflo(b.z)), bfhi(a.z) * __builtin_amdgcn_rcpf(bfhi(b.z)), bflo(a.w) * __builtin_amdgcn_rcpf(bflo(b.w)), bfhi(a.w) * __builtin_amdgcn_rcpf(bfhi(b.w))};
                        acc[ai][bj][m][0] *= r0; acc[ai][bj][m][1] *= r1;
                    }
            } else {
#pragma unroll
                for (int bj = 0; bj < 2; ++bj) {
                    const f32x4 c0 = *(const f32x4*)(bc + colb + bj * HALF), c1 = *(const f32x4*)(bc + colb + bj * HALF + 4);
#pragma unroll
                    for (int mm = 0; mm < 2; ++mm) {
                        const int m = 2 * mh + mm; const u32x4 a = ga[mm][bj];
                        const f32x4 a0 = {bflo(a.x), bfhi(a.x), bflo(a.y), bfhi(a.y)}, a1 = {bflo(a.z), bfhi(a.z), bflo(a.w), bfhi(a.w)};
                        *(u32x4*)(OUT + (size_t)EPI_ROW(ai, m) * DM + colb + bj * HALF) = pack8((acc[ai][bj][m][0] + c0) * a0, (acc[ai][bj][m][1] + c1) * a1);
                    }
                }
            }
            asm volatile("" ::: "memory");
        }
        return seg == 2;
    }
};
}

namespace att {
__device__ __forceinline__ int crow(int r, int hi) { return (r & 3) + 8 * (r >> 2) + 4 * hi; }
constexpr int KSLOT = 12288, VSLOT = 8192;
constexpr int L_K = 0, L_V = 2 * KSLOT, L_WS = L_V + 2 * VSLOT, L_OST = L_WS + 2048, L_END = L_OST + 8 * 4096;

__device__ __forceinline__ float hmax(float m) { auto rr = __builtin_amdgcn_permlane32_swap(__float_as_uint(m), __float_as_uint(m), false, false); return fmaxf(__uint_as_float(rr[0]), __uint_as_float(rr[1])); }
__device__ __forceinline__ float hsum(float m) { auto rr = __builtin_amdgcn_permlane32_swap(__float_as_uint(m), __float_as_uint(m), false, false); return __uint_as_float(rr[0]) + __uint_as_float(rr[1]); }

__device__ __forceinline__ void pv(f32x16* o, unsigned vb, bf16x8 pa0, bf16x8 pa1, bf16x8 pa2, bf16x8 pa3) {
    s16x4 lo[2][4], hi[2][4];
#pragma unroll
    for (int d0 = 0; d0 < 2; ++d0)
#pragma unroll
        for (int ks = 0; ks < 4; ++ks) {
            asm volatile("ds_read_b64_tr_b16 %0,%1 offset:%c2" : "=&v"(lo[d0][ks]) : "v"(vb), "i"(d0 * 4096 + ks * 1024) : "memory");
            asm volatile("ds_read_b64_tr_b16 %0,%1 offset:%c2" : "=&v"(hi[d0][ks]) : "v"(vb), "i"(d0 * 4096 + ks * 1024 + 512) : "memory"); }
#define PK(d, k) (bf16x8){lo[d][k][0], lo[d][k][1], lo[d][k][2], lo[d][k][3], hi[d][k][0], hi[d][k][1], hi[d][k][2], hi[d][k][3]}
    asm volatile("s_waitcnt lgkmcnt(8)" ::: "memory"); __builtin_amdgcn_sched_barrier(0);
    o[0] = __builtin_amdgcn_mfma_f32_32x32x16_bf16(pa0, PK(0, 0), o[0], 0, 0, 0);
    o[0] = __builtin_amdgcn_mfma_f32_32x32x16_bf16(pa1, PK(0, 1), o[0], 0, 0, 0);
    o[0] = __builtin_amdgcn_mfma_f32_32x32x16_bf16(pa2, PK(0, 2), o[0], 0, 0, 0);
    o[0] = __builtin_amdgcn_mfma_f32_32x32x16_bf16(pa3, PK(0, 3), o[0], 0, 0, 0);
    asm volatile("s_waitcnt lgkmcnt(0)" ::: "memory"); __builtin_amdgcn_sched_barrier(0);
    o[1] = __builtin_amdgcn_mfma_f32_32x32x16_bf16(pa0, PK(1, 0), o[1], 0, 0, 0);
    o[1] = __builtin_amdgcn_mfma_f32_32x32x16_bf16(pa1, PK(1, 1), o[1], 0, 0, 0);
    o[1] = __builtin_amdgcn_mfma_f32_32x32x16_bf16(pa2, PK(1, 2), o[1], 0, 0, 0);
    o[1] = __builtin_amdgcn_mfma_f32_32x32x16_bf16(pa3, PK(1, 3), o[1], 0, 0, 0);
#undef PK
}

__device__ __forceinline__ void attn_block(int b, int h, int qb, const bf16_t* Q, const bf16_t* KN, const bf16_t* KR, const bf16_t* V, bf16_t* O, LAS unsigned char* lds) {
    int tid_ = threadIdx.x; asm volatile("" : "+v"(tid_));
    const int tid = tid_, lane = tid & 63, r32 = lane & 31, hi = lane >> 5;
    const int wid = __builtin_amdgcn_readfirstlane(tid >> 6);
    const size_t rowbase = (size_t)b * SEQ; const int q0 = qb * 256;
    const bf16_t* Qw = Q + (rowbase + q0 + wid * 32 + r32) * 768 + h * 96;
    bf16x8 qr[6];
#pragma unroll
    for (int d0 = 0; d0 < 6; ++d0) qr[d0] = *(const bf16x8*)(Qw + d0 * 16 + hi * 8);
    const int NT = 4 * qb + 4;
    const bf16_t* kg = KN + (rowbase + lane) * 512 + h * 64 + wid * 8;
    const bf16_t* krg = KR + (rowbase + lane) * 32 + (wid & 3) * 8;
    const bf16_t* vg = V + (rowbase + 16 * (wid & 3) + (lane >> 2)) * 512 + h * 64 + (wid >> 2) * 32 + (lane & 3) * 8;
    const int kdst = L_K + wid * 1024 + lane * 16, krdst = L_K + (8 + (wid & 3)) * 1024 + lane * 16, vdst = L_V + wid * 1024 + lane * 16;
    unsigned z0_ = 0u; asm volatile("" : "+v"(z0_)); u32x4 kreg, krreg = {z0_, z0_, z0_, z0_}, vreg;
    kreg = *(const u32x4*)kg; if (wid < 4) krreg = *(const u32x4*)krg; vreg = *(const u32x4*)vg;
    *(LAS u32x4*)(lds + kdst) = kreg; if (wid < 4) *(LAS u32x4*)(lds + krdst) = krreg; *(LAS u32x4*)(lds + vdst) = vreg;
    __syncthreads();
    float mrun = -INFINITY, lrun = 0.f; f32x16 o[2];
#pragma unroll
    for (int r = 0; r < 16; ++r) { o[0][r] = 0.f; o[1][r] = 0.f; }
    LAS float* wsf = (LAS float*)(lds + L_WS) + wid * 64;
    const int qabs = q0 + wid * 32 + r32;
    const unsigned vbl = (unsigned)(uintptr_t)(lds + L_V) + ((lane >> 4) & 1) * 32 + (lane & 3) * 8 + (4 * hi + ((lane & 15) >> 2)) * 64;
    for (int t = 0; t < NT; ++t) {
        const int cur = t & 1;
        if (t + 1 < NT) { const size_t adv = (size_t)(t + 1) * 64; kreg = *(const u32x4*)(kg + adv * 512); if (wid < 4) krreg = *(const u32x4*)(krg + adv * 32); vreg = *(const u32x4*)(vg + adv * 512); }
        const int jb = t - 4 * qb;
        if (jb <= (wid >> 1)) {
            f32x16 p0, p1;
#pragma unroll
            for (int r = 0; r < 16; ++r) { p0[r] = 0.f; p1[r] = 0.f; }
            const LAS unsigned char* kb = lds + L_K + cur * KSLOT + hi * 1024 + r32 * 16;
            bf16x8 kf[12];
#pragma unroll
            for (int d0 = 0; d0 < 6; ++d0) { kf[2 * d0] = *(const LAS bf16x8*)(kb + d0 * 2048); kf[2 * d0 + 1] = *(const LAS bf16x8*)(kb + d0 * 2048 + 512); }
            __builtin_amdgcn_sched_barrier(0);
#pragma unroll
            for (int d0 = 0; d0 < 6; ++d0) {
                p0 = __builtin_amdgcn_mfma_f32_32x32x16_bf16(kf[2 * d0], qr[d0], p0, 0, 0, 0);
                p1 = __builtin_amdgcn_mfma_f32_32x32x16_bf16(kf[2 * d0 + 1], qr[d0], p1, 0, 0, 0);
            }
            if (jb == (wid >> 1)) {
                const int kbase = 64 * t + 4 * hi;
#pragma unroll
                for (int r = 0; r < 16; ++r) { const int kv = kbase + (r & 3) + 8 * (r >> 2); if (kv > qabs) p0[r] = -INFINITY; if (kv + 32 > qabs) p1[r] = -INFINITY; }
            }
            float rm = fmaxf(p0[0], p1[0]);
#pragma unroll
            for (int r = 1; r < 16; ++r) rm = fmaxf(rm, fmaxf(p0[r], p1[r]));
            rm = hmax(rm);
            if (__any(rm > mrun + 8.0f)) {
                const float mn = fmaxf(mrun, rm);
                const float alpha = __builtin_amdgcn_exp2f(mrun - mn);
                mrun = mn; lrun *= alpha;
                if (hi == 0) wsf[r32] = alpha;
                asm volatile("s_waitcnt lgkmcnt(0)" ::: "memory");
#pragma unroll
                for (int r = 0; r < 16; ++r) { const float a = wsf[crow(r, hi)]; o[0][r] *= a; o[1][r] *= a; }
            }
            float sum = 0.f;
#pragma unroll
            for (int r = 0; r < 16; ++r) { p0[r] = __builtin_amdgcn_exp2f(p0[r] - mrun); p1[r] = __builtin_amdgcn_exp2f(p1[r] - mrun); sum += p0[r] + p1[r]; }
            lrun += sum;
            u32x4 pw0, pw1, pw2, pw3;
            pw0 = (u32x4){cvt_pk_bf16(p0[0], p0[1]), cvt_pk_bf16(p0[2], p0[3]), cvt_pk_bf16(p0[4], p0[5]), cvt_pk_bf16(p0[6], p0[7])};
            pw1 = (u32x4){cvt_pk_bf16(p0[8], p0[9]), cvt_pk_bf16(p0[10], p0[11]), cvt_pk_bf16(p0[12], p0[13]), cvt_pk_bf16(p0[14], p0[15])};
            pw2 = (u32x4){cvt_pk_bf16(p1[0], p1[1]), cvt_pk_bf16(p1[2], p1[3]), cvt_pk_bf16(p1[4], p1[5]), cvt_pk_bf16(p1[6], p1[7])};
            pw3 = (u32x4){cvt_pk_bf16(p1[8], p1[9]), cvt_pk_bf16(p1[10], p1[11]), cvt_pk_bf16(p1[12], p1[13]), cvt_pk_bf16(p1[14], p1[15])};
            pv(o, vbl + cur * VSLOT, __builtin_bit_cast(bf16x8, pw0), __builtin_bit_cast(bf16x8, pw1), __builtin_bit_cast(bf16x8, pw2), __builtin_bit_cast(bf16x8, pw3));
        }
        if (t + 1 < NT) { const int nb = (cur ^ 1); *(LAS u32x4*)(lds + kdst + nb * KSLOT) = kreg; if (wid < 4) *(LAS u32x4*)(lds + krdst + nb * KSLOT) = krreg; *(LAS u32x4*)(lds + vdst + nb * VSLOT) = vreg; }
        __syncthreads();
    }
    lrun = hsum(lrun);
    if (hi == 0) wsf[32 + r32] = lrun;
    asm volatile("s_waitcnt lgkmcnt(0)" ::: "memory");
    float rli[16];
#pragma unroll
    for (int r = 0; r < 16; ++r) rli[r] = __builtin_amdgcn_rcpf(wsf[32 + crow(r, hi)]);
    bf16_t* Ow = O + (rowbase + q0 + wid * 32) * 512 + h * 64;
    LAS bf16_t* stg = (LAS bf16_t*)(lds + L_OST) + wid * 2048;
#pragma unroll
    for (int r = 0; r < 16; ++r) { const int orow = crow(r, hi);
#pragma unroll
        for (int d0 = 0; d0 < 2; ++d0) stg[orow * 64 + d0 * 32 + r32] = f2bf(o[d0][r] * rli[r]); }
    asm volatile("s_waitcnt lgkmcnt(0)" ::: "memory");
#pragma unroll
    for (int i = 0; i < 4; ++i) { const int row = i * 8 + (lane >> 3), ch = lane & 7; const u32x4 v = *(const LAS u32x4*)(stg + row * 64 + ch * 8); *(u32x4*)(Ow + (size_t)row * 512 + ch * 8) = v; }
    __syncthreads();
}
}

namespace lru {
constexpr int XS_STRIDE = 144;
constexpr int L_XS = 0, L_BM = 74240, L_CW = L_BM + 24576, L_CB = L_CW + 1024, L_AGG = L_CB + 256, L_PRE = L_AGG + 4096, L_CIN = L_PRE + 4096, L_END = L_CIN + 128;
__device__ __forceinline__ void lru_unit(int u, int layer, const bf16_t* XPRE, bf16_t* GG, const float* conv_w, const float* conv_b, const float* wgate, const float* bgate, const float* lam,
                                         unsigned* flags, float* carry, LAS unsigned char* lds) {
    int tid_ = threadIdx.x; asm volatile("" : "+v"(tid_));
    const int tid = tid_, lane = tid & 63, r32 = lane & 31, hi = lane >> 5;
    const int wid = __builtin_amdgcn_readfirstlane(tid >> 6);
    const int ck = u >> 6, bh = u & 63, b = bh >> 3, h = bh & 7, s0 = ck * 512;
    LAS float* CW = (LAS float*)(lds + L_CW); LAS float* CB = (LAS float*)(lds + L_CB);
    LAS f32x2* AGG = (LAS f32x2*)(lds + L_AGG); LAS f32x2* PRE = (LAS f32x2*)(lds + L_PRE); LAS float* CIN = (LAS float*)(lds + L_CIN);
    if (tid < 256) CW[tid] = conv_w[(tid >> 6) * 512 + h * 64 + (tid & 63)];
    else if (tid < 320) CB[tid - 256] = conv_b[h * 64 + (tid - 256)];
    for (int f = tid; f < 1536; f += 512) {
        const int l = f & 63, g = f >> 6, kc = g & 3, nt = g >> 2, n = l & 31, hh = l >> 5, col = 32 * nt + n, d0 = 16 * kc + 8 * hh;
        float v[8];
#pragma unroll
        for (int i = 0; i < 8; ++i) v[i] = (nt < 4) ? wgate[(size_t)h * 8192 + (d0 + i) * 128 + col] : ((d0 + i) == (col - 128) ? 1.0f : 0.0f);
        *(LAS u32x4*)(lds + L_BM + g * 1024 + l * 16) = (u32x4){cvt_pk_bf16(v[0], v[1]), cvt_pk_bf16(v[2], v[3]), cvt_pk_bf16(v[4], v[5]), cvt_pk_bf16(v[6], v[7])};
    }
    unsigned z0_ = 0u; asm volatile("" : "+v"(z0_));
    { u32x4 st[9];
#pragma unroll
      for (int k = 0; k < 9; ++k) { const int i = (tid >> 3) + 64 * k, s = s0 - 3 + i; st[k] = (u32x4){z0_, z0_, z0_, z0_};
          if (i < 515 && s >= 0) st[k] = *(const u32x4*)(XPRE + ((size_t)b * SEQ + s) * 512 + h * 64 + (tid & 7) * 8); }
#pragma unroll
      for (int k = 0; k < 9; ++k) { const int i = (tid >> 3) + 64 * k; if (i < 515) *(LAS u32x4*)(lds + L_XS + i * XS_STRIDE + (tid & 7) * 16) = st[k]; } }
    __syncthreads();
    bf16x8 afr[2][4];
#pragma unroll
    for (int kc = 0; kc < 4; ++kc) {
        const int d0 = 16 * kc + 8 * hi;
        f32x4 w0[4], w1[4];
#pragma unroll
        for (int j = 0; j < 4; ++j) { w0[j] = *(const LAS f32x4*)(CW + j * 64 + d0); w1[j] = *(const LAS f32x4*)(CW + j * 64 + d0 + 4); }
        const f32x4 cb0 = *(const LAS f32x4*)(CB + d0), cb1 = *(const LAS f32x4*)(CB + d0 + 4);
#pragma unroll
        for (int mt = 0; mt < 2; ++mt) {
            const int sl = wid * 64 + mt * 32 + r32;
            f32x4 xa0 = cb0, xa1 = cb1;
#pragma unroll
            for (int j = 0; j < 4; ++j) {
                const u32x4 xv = *(const LAS u32x4*)(lds + L_XS + (sl + j) * XS_STRIDE + d0 * 2);
                xa0 += w0[j] * (f32x4){bflo(xv.x), bfhi(xv.x), bflo(xv.y), bfhi(xv.y)};
                xa1 += w1[j] * (f32x4){bflo(xv.z), bfhi(xv.z), bflo(xv.w), bfhi(xv.w)};
            }
            afr[mt][kc] = __builtin_bit_cast(bf16x8, (u32x4){cvt_pk_bf16(xa0[0], xa0[1]), cvt_pk_bf16(xa0[2], xa0[3]), cvt_pk_bf16(xa1[0], xa1[1]), cvt_pk_bf16(xa1[2], xa1[3])});
        }
    }
    __syncthreads();
    { u32x4 st[8];
#pragma unroll
      for (int k = 0; k < 8; ++k) st[k] = *(const u32x4*)(GG + ((size_t)b * SEQ + s0 + (tid >> 3) + 64 * k) * 512 + h * 64 + (tid & 7) * 8);
#pragma unroll
      for (int k = 0; k < 8; ++k) *(LAS u32x4*)(lds + L_XS + ((tid >> 3) + 64 * k) * XS_STRIDE + (tid & 7) * 16) = st[k]; }
    const int fbase = layer * 256;
#pragma unroll 1
    for (int ct = 0; ct < 2; ++ct) {
        const int c = 32 * ct + r32;
        const float spc = 8.0f * log1pf(expf(-lam[h * 64 + c]));
        const float br = bgate[h * 128 + c], bi = bgate[h * 128 + 64 + c];
        float hq[2][16], ac[2][16];
#pragma unroll
        for (int mt = 0; mt < 2; ++mt) {
            f32x16 R, I, X;
#pragma unroll
            for (int r = 0; r < 16; ++r) { R[r] = br; I[r] = bi; X[r] = 0.f; }
#pragma unroll
            for (int kc = 0; kc < 4; ++kc) {
                const bf16x8 b0 = *(const LAS bf16x8*)(lds + L_BM + ((ct) * 4 + kc) * 1024 + lane * 16);
                const bf16x8 b1 = *(const LAS bf16x8*)(lds + L_BM + ((2 + ct) * 4 + kc) * 1024 + lane * 16);
                const bf16x8 b2 = *(const LAS bf16x8*)(lds + L_BM + ((4 + ct) * 4 + kc) * 1024 + lane * 16);
                R = __builtin_amdgcn_mfma_f32_32x32x16_bf16(afr[mt][kc], b0, R, 0, 0, 0);
                I = __builtin_amdgcn_mfma_f32_32x32x16_bf16(afr[mt][kc], b1, I, 0, 0, 0);
                X = __builtin_amdgcn_mfma_f32_32x32x16_bf16(afr[mt][kc], b2, X, 0, 0, 0);
            }
            float Ar[4], Hr[4];
#pragma unroll
            for (int q = 0; q < 4; ++q) { float A = 1.f, H = 0.f;
#pragma unroll
                for (int k = 0; k < 4; ++k) { const int r = 4 * q + k;
                    const float rg = fast_sigmoid(R[r]), ig = fast_sigmoid(I[r]);
                    const float la = -rg * spc;
                    const float a = __builtin_amdgcn_exp2f(la * 1.4426950408889634f);
                    const float x2 = 2.0f * la;
                    float om = -x2 * (1.0f + x2 * (0.5f + x2 * (0.16666667f + x2 * (0.041666668f + x2 * (0.0083333338f + x2 * 0.0013888889f)))));
                    if (__builtin_expect(__any(x2 <= -0.25f), 0)) om = (x2 > -0.25f) ? om : (1.0f - a * a);
                    const float uu = __builtin_amdgcn_sqrtf(fmaxf(om, 0.f)) * (ig * X[r]);
                    H = a * H + uu; A *= a; ac[mt][r] = A; hq[mt][r] = H; }
                Ar[q] = A; Hr[q] = H; }
            float pA[4], pH[4];
#pragma unroll
            for (int q = 0; q < 4; ++q) { pA[q] = __shfl_xor(Ar[q], 32); pH[q] = __shfl_xor(Hr[q], 32); }
            float A = 1.f, H = 0.f;
#pragma unroll
            for (int q = 0; q < 4; ++q) {
                const float A0 = hi ? pA[q] : Ar[q], H0 = hi ? pH[q] : Hr[q], A1 = hi ? Ar[q] : pA[q], H1 = hi ? Hr[q] : pH[q];
                const float Hm = A0 * H + H0, Am = A * A0;
                const float cA = hi ? Am : A, cH = hi ? Hm : H;
#pragma unroll
                for (int k = 0; k < 4; ++k) { const int r = 4 * q + k; hq[mt][r] += ac[mt][r] * cH; ac[mt][r] *= cA; }
                H = A1 * Hm + H1; A = Am * A1;
            }
            if (hi == 0) AGG[(2 * wid + mt) * 32 + r32] = (f32x2){A, H};
            __builtin_amdgcn_sched_barrier(0);
        }
        __syncthreads();
        if (wid == 0 && lane < 32) {
            float A = 1.f, H = 0.f;
#pragma unroll
            for (int t = 0; t < 16; ++t) { PRE[t * 32 + lane] = (f32x2){A, H}; const f32x2 g = AGG[t * 32 + lane]; H = g.x * H + g.y; A *= g.x; }
            if (ck < 3) {
                __hip_atomic_store(carry + ((size_t)u * 64 + c) * 2, A, __ATOMIC_RELAXED, __HIP_MEMORY_SCOPE_AGENT);
                __hip_atomic_store(carry + ((size_t)u * 64 + c) * 2 + 1, H, __ATOMIC_RELAXED, __HIP_MEMORY_SCOPE_AGENT);
                asm volatile("s_waitcnt vmcnt(0)" ::: "memory");
                if (lane == 0) __hip_atomic_store(flags + (size_t)(fbase + u) * 2 + ct, 1u, __ATOMIC_RELEASE, __HIP_MEMORY_SCOPE_AGENT);
            }
            float cin = 0.f;
            for (int j = 0; j < ck; ++j) {
                const int uj = j * 64 + bh;
                unsigned* fp = flags + (size_t)(fbase + uj) * 2 + ct; unsigned sp = 0;
                while (__hip_atomic_load(fp, __ATOMIC_RELAXED, __HIP_MEMORY_SCOPE_AGENT) == 0u) { __builtin_amdgcn_s_sleep(2); if (++sp > (1u << 22)) break; }
                __builtin_amdgcn_fence(__ATOMIC_ACQUIRE, "agent");
                const float Aj = __hip_atomic_load(carry + ((size_t)uj * 64 + c) * 2, __ATOMIC_RELAXED, __HIP_MEMORY_SCOPE_AGENT);
                const float Hj = __hip_atomic_load(carry + ((size_t)uj * 64 + c) * 2 + 1, __ATOMIC_RELAXED, __HIP_MEMORY_SCOPE_AGENT);
                cin = Aj * cin + Hj;
            }
            CIN[lane] = cin;
        }
        __syncthreads();
        {
            const float cinc = CIN[r32];
#pragma unroll
            for (int mt = 0; mt < 2; ++mt) {
                const f32x2 p = PRE[(2 * wid + mt) * 32 + r32];
                const float cint = p.y + p.x * cinc;
                LAS bf16_t* gp = (LAS bf16_t*)(lds + L_XS + (wid * 64 + mt * 32) * XS_STRIDE) + c;
#pragma unroll
                for (int r = 0; r < 16; ++r) { LAS bf16_t* q = gp + att::crow(r, hi) * (XS_STRIDE / 2); const float hv = hq[mt][r] + ac[mt][r] * cint; *q = f2bf(hv * bf2f(*q)); }
            }
        }
    }
    __syncthreads();
    for (int i = tid >> 3; i < 512; i += 64)
        *(u32x4*)(GG + ((size_t)b * SEQ + s0 + i) * 512 + h * 64 + (tid & 7) * 8) = *(const LAS u32x4*)(lds + L_XS + i * XS_STRIDE + (tid & 7) * 16);
    __syncthreads();
}
}

namespace cv {
constexpr int L_XS = 0, L_YB = 63488, YB_STRIDE = 516, L_END = L_YB + 32 * YB_STRIDE * 4;
__device__ __forceinline__ void conv_unit(int u, const bf16_t* PC, bf16_t* AC, const float* dw_w, const float* dw_b, const float* ln_g, const float* ln_b,
                                          const bf16_t* KPE, bf16_t* KR, const float* CS, LAS unsigned char* lds) {
    int tid_ = threadIdx.x; asm volatile("" : "+v"(tid_));
    const int tid = tid_, lane = tid & 63;
    const int wid = __builtin_amdgcn_readfirstlane(tid >> 6);
    const int m0 = u * 32, b = m0 >> 11, s0 = m0 & 2047;
    unsigned z0_ = 0u; asm volatile("" : "+v"(z0_));
    { u32x4 st[8];
#pragma unroll
      for (int k = 0; k < 8; ++k) { const int i = (tid >> 6) + 8 * k, s = s0 - 30 + i; st[k] = (u32x4){z0_, z0_, z0_, z0_};
          if (i < 62 && s >= 0) st[k] = *(const u32x4*)(PC + ((size_t)b * SEQ + s) * 512 + (tid & 63) * 8); }
#pragma unroll
      for (int k = 0; k < 8; ++k) { const int i = (tid >> 6) + 8 * k; if (i < 62) *(LAS u32x4*)(lds + L_XS + i * 1024 + (tid & 63) * 16) = st[k]; } }
    { const int tok = tid >> 4, j = tid & 15; const size_t m = (size_t)m0 + tok;
      const float x1 = bf2f(KPE[m * 32 + j]), x2 = bf2f(KPE[m * 32 + 16 + j]); const float cs = CS[m * 32 + j], sn = CS[m * 32 + 16 + j];
      KR[m * 32 + j] = f2bf(x1 * cs - x2 * sn); KR[m * 32 + 16 + j] = f2bf(x2 * cs + x1 * sn); }
    __syncthreads();
    {
        const int ch = tid;
        float w[31];
#pragma unroll
        for (int j = 0; j < 31; ++j) w[j] = dw_w[j * 512 + ch];
        const float bias = dw_b[ch];
        const LAS bf16_t* xs = (const LAS bf16_t*)(lds + L_XS) + ch;
        LAS float* YB = (LAS float*)(lds + L_YB);
#pragma unroll 1
        for (int g = 0; g < 4; ++g) {
            float x[38];
#pragma unroll
            for (int k = 0; k < 38; ++k) x[k] = bf2f(xs[(8 * g + k) * 512]);
#pragma unroll
            for (int o = 0; o < 8; ++o) { float y = bias;
#pragma unroll
                for (int j = 0; j < 31; ++j) y += w[j] * x[o + j];
                YB[(8 * g + o) * YB_STRIDE + ch] = y; }
        }
    }
    __syncthreads();
    {
        const LAS float* YB = (const LAS float*)(lds + L_YB);
        const f32x4 g0 = *(const f32x4*)(ln_g + lane * 8), g1 = *(const f32x4*)(ln_g + lane * 8 + 4), b0 = *(const f32x4*)(ln_b + lane * 8), b1 = *(const f32x4*)(ln_b + lane * 8 + 4);
#pragma unroll
        for (int k = 0; k < 4; ++k) {
            const int tok = wid * 4 + k;
            f32x4 a = *(const LAS f32x4*)(YB + tok * YB_STRIDE + lane * 8), c = *(const LAS f32x4*)(YB + tok * YB_STRIDE + lane * 8 + 4);
            const float mean = wave_sum((a[0] + a[1]) + (a[2] + a[3]) + (c[0] + c[1]) + (c[2] + c[3])) * (1.0f / 512.0f);
            a = a - mean; c = c - mean;
            const float var = wave_sum((a[0] * a[0] + a[1] * a[1]) + (a[2] * a[2] + a[3] * a[3]) + (c[0] * c[0] + c[1] * c[1]) + (c[2] * c[2] + c[3] * c[3])) * (1.0f / 512.0f);
            const float rstd = rsqrtf(var + EPS);
            a = a * rstd * g0 + b0; c = c * rstd * g1 + b1;
#pragma unroll
            for (int i = 0; i < 4; ++i) { a[i] = a[i] * fast_sigmoid(a[i]); c[i] = c[i] * fast_sigmoid(c[i]); }
            *(u32x4*)(AC + ((size_t)m0 + tok) * 512 + lane * 8) = pg8::pack8(a, c);
        }
    }
    __syncthreads();
}
}

#define XB_TMO      128
#define XB_XCNT(j)  (256  + 64 * (j))
#define XB_XSUB(j)  (1280 + 64 * (j))
#define XB_XGEN(j)  (2304 + 64 * (j))
#define XB_TOP      3328
#define XB_TOPGEN   3392
#define XCD_BAR_WORDS 3456
#define XB_SPIN_CAP (1u << 18)
__device__ __forceinline__ unsigned xb_ld(unsigned* p)              { return __hip_atomic_load(p, __ATOMIC_RELAXED, __HIP_MEMORY_SCOPE_AGENT); }
__device__ __forceinline__ unsigned xb_add(unsigned* p, unsigned v) { return __hip_atomic_fetch_add(p, v, __ATOMIC_RELAXED, __HIP_MEMORY_SCOPE_AGENT); }
__device__ __forceinline__ unsigned xb_xcc_id() { return (unsigned)__builtin_amdgcn_s_getreg((3 << 11) | 20) & 0xFu; }
#define XB_SPIN(cond, bar) do { unsigned _sp = 0; while (cond) { __builtin_amdgcn_s_sleep(1); \
    if ((++_sp & 255u) == 0u) { if (xb_ld(&(bar)[XB_TMO])) break; if (_sp > XB_SPIN_CAP) { atomicAdd(&(bar)[XB_TMO], 1u); break; } } } } while (0)
struct XcdBarrier { unsigned* bar; unsigned x; volatile LAS unsigned* st; };
__device__ __forceinline__ XcdBarrier xcd_barrier_post(unsigned* bar, volatile LAS unsigned* st) {
    XcdBarrier b; b.bar = bar; b.x = xb_xcc_id(); b.st = st;
    if (threadIdx.x == 0) (void)xb_add(&bar[XB_XCNT(b.x)], 1u);
    return b;
}
__device__ __forceinline__ void xcd_barrier_complete(unsigned* bar, unsigned x, unsigned& nloc, unsigned& nx) {
    const unsigned G = gridDim.x * gridDim.y * gridDim.z;
    unsigned sum, cnt, mine, sp = 0u;
    for (;;) {
        sum = 0u; cnt = 0u; mine = 0u;
#pragma unroll 1
        for (unsigned j = 0; j < 16; ++j) { const unsigned c = xb_ld(&bar[XB_XCNT(j)]); sum += c; cnt += (c > 0u) ? 1u : 0u; mine = (j == x) ? c : mine; }
        if (sum == G) break;
        __builtin_amdgcn_s_sleep(1);
        if ((++sp & 255u) == 0u) { if (xb_ld(&bar[XB_TMO])) break; if (sp > XB_SPIN_CAP) { atomicAdd(&bar[XB_TMO], 1u); break; } }
    }
    nloc = mine > 0u ? mine : 1u; nx = cnt > 0u ? cnt : 1u;
}
__device__ __forceinline__ void xcd_barrier(const XcdBarrier& b) {
    asm volatile("s_waitcnt vmcnt(0)" ::: "memory");
    __syncthreads();
    if (threadIdx.x == 0) {
        unsigned* bar = b.bar; asm volatile("" : "+s"(bar));
        __builtin_amdgcn_s_waitcnt(0);
        unsigned nloc = b.st[0], nx = b.st[1];
        if (nloc == 0u) { xcd_barrier_complete(bar, b.x, nloc, nx); b.st[0] = nloc; b.st[1] = nx; }
        const unsigned old = xb_add(&bar[XB_XSUB(b.x)], 1u);
        const unsigned gen = old / nloc;
        if (old + 1u == (gen + 1u) * nloc) {
            __builtin_amdgcn_fence(__ATOMIC_RELEASE, "agent");
            asm volatile("s_waitcnt vmcnt(0)" ::: "memory");
            const unsigned og = xb_add(&bar[XB_TOP], 1u);
            const unsigned tg = og / nx;
            if (og + 1u == (tg + 1u) * nx) xb_add(&bar[XB_TOPGEN], 1u);
            else XB_SPIN(xb_ld(&bar[XB_TOPGEN]) == tg, bar);
            __builtin_amdgcn_fence(__ATOMIC_ACQUIRE, "agent");
            xb_add(&bar[XB_XGEN(b.x)], 1u);
            asm volatile("s_waitcnt vmcnt(0)" ::: "memory");
        } else {
            XB_SPIN(xb_ld(&bar[XB_XGEN(b.x)]) == gen, bar);
            __builtin_amdgcn_fence(__ATOMIC_ACQUIRE, "agent");
            asm volatile("s_waitcnt vmcnt(0)" ::: "memory");
        }
    }
    __syncthreads();
}

constexpr size_t MiB = 1u << 20;
constexpr size_t WS_SSA = 0, WS_SSB = 1 * MiB, WS_SSQ = 2 * MiB, WS_SSKV = 3 * MiB, WS_BIASP = 3 * MiB + 512 * 1024, WS_BAR = 3 * MiB + 768 * 1024, BAR_ZERO_BYTES = 32768, WS_LFLAG = WS_BAR + 16384, WS_SPLITF = WS_BAR + 24576, WS_LCARRY = WS_BAR + 32768, WS_W = 4 * MiB, WS_XB = 55 * MiB, WS_R1 = 87 * MiB;
constexpr size_t WS_GG = 183 * MiB, WS_AC = 199 * MiB, WS_CQ = 215 * MiB, WS_Q = 227 * MiB, WS_KPE = 251 * MiB, WS_KR = 252 * MiB, WS_CS = 253 * MiB, WS_END = 255 * MiB;
constexpr size_t WS_CKV = WS_W;
constexpr size_t W_F1W1 = 0, W_F1W2 = 11 * MiB, W_F2W1 = 16 * MiB + 512 * 1024, W_F2W2 = 27 * MiB + 512 * 1024, W_IN = 33 * MiB, W_LRUO = 44 * MiB + 512 * 1024,
                 W_UQ = 45 * MiB + 512 * 1024, W_UKV = 46 * MiB + 256 * 1024, W_MLAO = 46 * MiB + 768 * 1024, W_CONVO = 47 * MiB + 768 * 1024, W_OUT = 48 * MiB + 768 * 1024;
constexpr size_t DO_XPRE = 0, DO_PC = 16 * MiB, DO_KN = 32 * MiB, DO_V = 48 * MiB, DO_O = 0, DO_MERGED = 32 * MiB;
constexpr int LDS_BYTES = 147456, LDS_BARST = LDS_BYTES - 64;
static_assert(att::L_END <= LDS_BARST && lru::L_END <= LDS_BARST && cv::L_END <= LDS_BARST && pg8::STAGE_BYTES <= LDS_BARST && XCD_BAR_WORDS * 4 <= BAR_ZERO_BYTES, "LDS / barrier map");
static_assert(att::L_END <= LDS_BYTES && lru::L_END <= LDS_BYTES && cv::L_END <= LDS_BYTES && pg8::STAGE_BYTES <= LDS_BYTES, "LDS");

__device__ const float INVF[16] = {1.0f, 0.5623413251903491f, 0.31622776601683794f, 0.1778279410038923f, 0.1f, 0.05623413251903491f, 0.031622776601683794f, 0.01778279410038923f,
                                   0.01f, 0.005623413251903491f, 0.0031622776601683794f, 0.001778279410038923f, 0.001f, 0.0005623413251903491f, 0.00031622776601683794f, 0.0001778279410038923f};

__device__ __forceinline__ int dest_row(int kind, int n0) {
    if (kind == 1) { if (n0 < FF) return 256 * (n0 / 128) + (n0 % 128); const int n1 = n0 - FF; return 256 * (n1 / 128) + 128 + (n1 % 128); }
    if (kind == 2) {
        if (n0 < 1696) return n0;
        if (n0 < 2208) { const int v = n0 - 1696; return 1792 + 256 * (v / 128) + (v % 128); }
        if (n0 < 2720) { const int v = n0 - 2208; return 1792 + 256 * (v / 128) + 128 + (v % 128); }
        return 2816 + (n0 - 2720);
    }
    return n0;
}
__device__ __forceinline__ void cvt_item(const float* W, int K, int N, bf16_t* WT, int kind, const float* gk, LAS float* scr, int item, int lane) {
    const int nblk = N / 32, kb = item / nblk, nb = item % nblk, k0 = 64 * kb, n0 = 32 * nb;
#pragma unroll 32
    for (int i = 0; i < 32; ++i) { const int kk = 2 * i + (lane >> 5); scr[kk * 33 + (lane & 31)] = __builtin_nontemporal_load(W + (size_t)(k0 + kk) * N + n0 + (lane & 31)); }
    asm volatile("s_waitcnt lgkmcnt(0)" ::: "memory");
    const int c = lane & 7; const int dr = dest_row(kind, n0);
    float gs[8];
#pragma unroll
    for (int i = 0; i < 8; ++i) gs[i] = gk ? gk[k0 + 8 * c + i] : 1.0f;
#pragma unroll
    for (int j = 0; j < 4; ++j) { const int n = (lane >> 3) + 8 * j; const LAS float* s = scr + (8 * c) * 33 + n;
        u32x4 o; o.x = cvt_pk_bf16(s[0 * 33] * gs[0], s[1 * 33] * gs[1]); o.y = cvt_pk_bf16(s[2 * 33] * gs[2], s[3 * 33] * gs[3]); o.z = cvt_pk_bf16(s[4 * 33] * gs[4], s[5 * 33] * gs[5]); o.w = cvt_pk_bf16(s[6 * 33] * gs[6], s[7 * 33] * gs[7]);
        *(u32x4*)(WT + (size_t)(dr + n) * K + k0 + 8 * c) = o; }
    asm volatile("s_waitcnt lgkmcnt(0)" ::: "memory");
}

#ifndef GASQ
#define GASQ __attribute__((address_space(1)))
#endif
__device__ __forceinline__ const float* gptr(const GASQ float* p) { asm volatile("" : "+s"(p)); return (const float*)p; }
struct KArgs { const void* in[30]; float* out; unsigned char* ws; int ph_lo, ph_hi; };

__global__ void __launch_bounds__(512, 2) fwd_kernel(KArgs a) {
    extern __shared__ __attribute__((aligned(16))) unsigned char lds_raw[];
    LAS unsigned char* lds = (LAS unsigned char*)lds_raw;
    cg::grid_group grid = cg::this_grid();
#define OPAQUE_TID int tid_ = threadIdx.x; asm volatile("" : "+v"(tid_)); const int tid = tid_, lane = tid & 63, wave = __builtin_amdgcn_readfirstlane(tid >> 6), gw = bid * 8 + wave;
#define CS ((float*)(ws_ + WS_CS))
#define BIASP ((float*)(ws_ + WS_BIASP))
#define XB ((bf16_t*)(ws_ + WS_XB))
#define HB ((bf16_t*)(ws_ + WS_R1))
#define GB ((bf16_t*)(ws_ + WS_R1))
#define GG ((bf16_t*)(ws_ + WS_GG))
#define AC ((bf16_t*)(ws_ + WS_AC))
#define CQ ((bf16_t*)(ws_ + WS_CQ))
#define CKV ((bf16_t*)(ws_ + WS_CKV))
#define QB ((bf16_t*)(ws_ + WS_Q))
#define KPE ((bf16_t*)(ws_ + WS_KPE))
#define KR ((bf16_t*)(ws_ + WS_KR))
#define XPRE ((bf16_t*)(do_ + DO_XPRE))
#define PC ((bf16_t*)(do_ + DO_PC))
#define KN ((bf16_t*)(do_ + DO_KN))
#define VB ((bf16_t*)(do_ + DO_V))
#define OB ((bf16_t*)(do_ + DO_O))
#define MG ((bf16_t*)(do_ + DO_MERGED))
#define WB (ws_ + WS_W)
    const int lo = a.ph_lo, hi = a.ph_hi;
    int ph = 0;
    if (threadIdx.x < 16) ((LAS unsigned*)(lds + LDS_BARST))[threadIdx.x] = 0u;
    __syncthreads();
    XcdBarrier xbar = xcd_barrier_post((unsigned*)(a.ws + WS_BAR), (volatile LAS unsigned*)(lds + LDS_BARST));
    if (hi < 0) grid.sync();
typedef const float* cfp_t; typedef unsigned char* ucp_t;
#define KAS __attribute__((address_space(4)))
#define GASQ __attribute__((address_space(1)))
#define PHASE_BEGIN if (ph >= lo && ph < hi) { int G = gridDim.x, bid = blockIdx.x; asm volatile("" : "+s"(G), "+s"(bid)); const int NGW = G * 8; (void)NGW;     \
    const KAS void* kp_ = (const KAS void*)__builtin_amdgcn_kernarg_segment_ptr(); asm volatile("" : "+s"(kp_)); \
    GASQ unsigned char* wsg_ = (GASQ unsigned char*)(((const KAS ucp_t*)kp_)[31]); GASQ unsigned char* dog_ = (GASQ unsigned char*)(((const KAS ucp_t*)kp_)[30]); asm volatile("" : "+s"(wsg_), "+s"(dog_)); \
    unsigned char* ws_ = (unsigned char*)wsg_; unsigned char* do_ = (unsigned char*)dog_;
#define PHASE_END   if (ph + 1 < hi) { for (int r_ = 0; r_ < REP_SYNC; ++r_) xcd_barrier(xbar); } } ++ph;
#define INF(i) (gptr((const GASQ float*)(((const KAS cfp_t*)kp_)[i])))

    for (int l = 0; l < 2; ++l) {
        PHASE_BEGIN
        {
            OPAQUE_TID
            LAS float* scr = (LAS float*)(lds + wave * 16384);
            const float* w1a = INF(3) + (size_t)l * DM * 5632; const float* w2a = INF(4) + (size_t)l * FF * DM;
            const float* w1b = INF(27) + (size_t)l * DM * 5632; const float* w2b = INF(28) + (size_t)l * FF * DM;
            const float* win = INF(6) + (size_t)l * DM * DIN;
            constexpr int I_W1 = 16 * 176, I_W2 = 44 * 32, I_IN = 16 * 181, I_LO = 8 * 32, I_UQ = 6 * 24, I_UKV = 4 * 32, I_OUT = 16 * 32;
            constexpr int NITEMS = 2 * I_W1 + 2 * I_W2 + I_IN + 3 * I_LO + I_UQ + I_UKV + I_OUT;
            for (int r_ = 0; r_ < REP_CVT; ++r_)
            for (int it = gw; it < NITEMS; it += NGW) {
                int r = it;
                if (r < I_W1) { cvt_item(w1a, DM, 5632, (bf16_t*)(WB + W_F1W1), 1, INF(2) + l * DM, scr, r, lane); continue; } r -= I_W1;
                if (r < I_W1) { cvt_item(w1b, DM, 5632, (bf16_t*)(WB + W_F2W1), 1, INF(26) + l * DM, scr, r, lane); continue; } r -= I_W1;
                if (r < I_IN) { cvt_item(win, DM, DIN, (bf16_t*)(WB + W_IN), 2, INF(5) + l * DM, scr, r, lane); continue; } r -= I_IN;
                if (r < I_W2) { cvt_item(w2a, FF, DM, (bf16_t*)(WB + W_F1W2), 0, nullptr, scr, r, lane); continue; } r -= I_W2;
                if (r < I_W2) { cvt_item(w2b, FF, DM, (bf16_t*)(WB + W_F2W2), 0, nullptr, scr, r, lane); continue; } r -= I_W2;
                if (r < I_OUT) { cvt_item(INF(25) + (size_t)l * DM * DM, DM, DM, (bf16_t*)(WB + W_OUT), 0, nullptr, scr, r, lane); continue; } r -= I_OUT;
                if (r < I_LO) { cvt_item(INF(13) + (size_t)l * 512 * DM, 512, DM, (bf16_t*)(WB + W_LRUO), 0, nullptr, scr, r, lane); continue; } r -= I_LO;
                if (r < I_LO) { cvt_item(INF(18) + (size_t)l * 512 * DM, 512, DM, (bf16_t*)(WB + W_MLAO), 0, nullptr, scr, r, lane); continue; } r -= I_LO;
                if (r < I_LO) { cvt_item(INF(23) + (size_t)l * 512 * DM, 512, DM, (bf16_t*)(WB + W_CONVO), 0, nullptr, scr, r, lane); continue; } r -= I_LO;
                if (r < I_UQ) { cvt_item(INF(15) + (size_t)l * 384 * 768, 384, 768, (bf16_t*)(WB + W_UQ), 0, INF(14) + l * 384, scr, r, lane); continue; } r -= I_UQ;
                cvt_item(INF(17) + (size_t)l * 256 * 1024, 256, 1024, (bf16_t*)(WB + W_UKV), 0, INF(16) + l * 256, scr, r, lane);
            }
            { u32x4* z = (u32x4*)((bf16_t*)(WB + W_IN) + (size_t)1696 * DM); for (int i = bid * 512 + tid; i < 96 * DM / 8; i += G * 512) { unsigned zz = 0u; asm volatile("" : "+v"(zz)); z[i] = (u32x4){zz, zz, zz, zz}; } }
            if (l == 0) {
                const float* x = INF(0);
                for (int m = gw; m < MROWS; m += NGW) {
                    const f32x4* xr = (const f32x4*)(x + (size_t)m * DM) + lane; float s = 0.f; f32x4 v[4];
#pragma unroll
                    for (int j = 0; j < 4; ++j) { v[j] = __builtin_nontemporal_load(xr + 64 * j); s += (v[j][0] * v[j][0] + v[j][1] * v[j][1]) + (v[j][2] * v[j][2] + v[j][3] * v[j][3]); }
                    s = wave_sum(s);
                    u32x2* o8 = (u32x2*)(XB + (size_t)m * DM) + lane;
#pragma unroll
                    for (int j = 0; j < 4; ++j) o8[64 * j] = (u32x2){cvt_pk_bf16(v[j][0], v[j][1]), cvt_pk_bf16(v[j][2], v[j][3])};
                    if (lane < 16) ((float*)(ws_ + WS_SSA))[(size_t)m * 16 + lane] = (lane == 0) ? s : 0.f;
                }
                const int* pos = (const int*)INF(1);
                for (int i = bid * 512 + tid; i < MROWS * 16; i += G * 512) { const int m = i >> 4, j = i & 15;
                    const float ang = (float)pos[m] * INVF[j];
                    double t = (double)ang * 0.15915494309189535; t -= rint(t); const float tf = (float)t;
                    CS[(size_t)m * 32 + j] = __builtin_amdgcn_cosf(tf); CS[(size_t)m * 32 + 16 + j] = __builtin_amdgcn_sinf(tf); }
                for (int i = bid * 512 + tid; i < 2 * DINP; i += G * 512) { const int ll = i / DINP, d = i % DINP; int n = -1;
                    if (d < 1696) n = d; else if (d < 1792) n = -1; else if (d < 2816) { const int t = d - 1792, p = t / 256, r = t % 256; n = (r < 128) ? (1696 + p * 128 + r) : (2208 + p * 128 + (r - 128)); } else n = 2720 + (d - 2816);
                    BIASP[i] = (n >= 0) ? INF(7)[(size_t)ll * DIN + n] : 0.f; }
            }
            __syncthreads();
        }
        PHASE_END

#define SSX(k) ((float*)(ws_ + ((((k) & 1) != 0) ? WS_SSB : WS_SSA)))
#define ss0 SSX(3 * l)
#define ss1 SSX(3 * l + 1)
#define ss2 SSX(3 * l + 2)
#define ss3 SSX(3 * l + 3)
#define ssq ((float*)(ws_ + WS_SSQ))
#define sskv ((float*)(ws_ + WS_SSKV))

        PHASE_BEGIN
#ifndef NO_G1
        for (int r_ = 0; r_ < REP_F1UP; ++r_) { pg8::Gemm g{XB, XB, XB, (bf16_t*)(WB + W_F1W1), nullptr, nullptr, MROWS, 5632, DM, DM}; pg8::StaticOrder S; S.init(MROWS, 5632, G, bid, 1, false);
          pg8::EpiUp E{HB, ss0}; pg8::gemm_phase<pg8::EpiUp, true>(lds, g, S, E);
          pg8::TailOrder T; T.init(MROWS, 5632, G, bid);
          if (T.on) { const int kh = T.half() * 512; pg8::Gemm gt{XB + kh, XB + kh, XB + kh, (bf16_t*)(WB + W_F1W1) + kh, nullptr, nullptr, MROWS, 5632, 512, DM};
              pg8::EpiUpTail Et{HB, ss0, (float*)do_, (unsigned*)(ws_ + WS_SPLITF) + (l * 2 + 0) * 128}; pg8::gemm_phase<pg8::EpiUpTail, true, pg8::TailOrder>(lds, gt, T, Et); } }
#endif
        PHASE_END
        PHASE_BEGIN
#ifndef NO_G2
        { pg8::Gemm g{HB, HB, HB, (bf16_t*)(WB + W_F1W2), nullptr, nullptr, MROWS, DM, FF, FF}; pg8::StaticOrder S; S.init(MROWS, DM, G, bid, 1);
          pg8::EpiRes E{XB, 0.5f, ss1, nullptr}; pg8::gemm_phase<pg8::EpiRes, true>(lds, g, S, E); }
#endif
        PHASE_END
        PHASE_BEGIN
#ifndef NO_G3
        for (int r_ = 0; r_ < REP_WIN; ++r_) { pg8::Gemm g{XB, XB, XB, (bf16_t*)(WB + W_IN), nullptr, nullptr, MROWS, DINP, DM, DM}; pg8::StaticOrder S; S.init(MROWS, DINP, G, bid, 1);
          pg8::EpiWin E{ss1, BIASP + l * DINP, XPRE, GG, CQ, CKV, KPE, PC, GB, ssq, sskv}; pg8::gemm_phase<pg8::EpiWin, true>(lds, g, S, E); }
#endif
        PHASE_END
        PHASE_BEGIN
#ifndef NO_G4
        for (int r_ = 0; r_ < REP_S4G; ++r_) { pg8::Gemm g{CQ, CQ, CQ, (bf16_t*)(WB + W_UQ), nullptr, nullptr, MROWS, 768, 384, 384}; pg8::StaticOrder S; S.init(MROWS, 768, G, bid, 1);
          pg8::EpiQ E{QB, ssq, CS}; pg8::gemm_phase<pg8::EpiQ, true>(lds, g, S, E); }
#endif
#ifndef NO_G4B
        for (int r_ = 0; r_ < REP_S4G; ++r_) { pg8::Gemm g{CKV, CKV, CKV, (bf16_t*)(WB + W_UKV), nullptr, nullptr, MROWS, 1024, 256, 256}; pg8::StaticOrder S; S.init(MROWS, 1024, G, bid, 1);
          pg8::EpiKV E{KN, VB, sskv}; pg8::gemm_phase<pg8::EpiKV, true>(lds, g, S, E); }
#endif
#ifndef NO_LRU
        for (int u = bid; u < 256; u += G)
            lru::lru_unit(u, l, XPRE, GG, INF(8) + l * 4 * 512, INF(9) + l * 512, INF(10) + (size_t)l * 8 * 64 * 128, INF(11) + l * 8 * 128, INF(12) + l * 512, (unsigned*)(ws_ + WS_LFLAG), (float*)(ws_ + WS_LCARRY), lds);
#endif
#ifndef NO_CONV
        for (int r_ = 0; r_ < REP_CONV; ++r_)
        for (int u = bid; u < 512; u += G)
            cv::conv_unit(u, PC, AC, INF(19) + l * 31 * 512, INF(20) + l * 512, INF(21) + l * 512, INF(22) + l * 512, KPE, KR, CS, lds);
#endif
        PHASE_END
        PHASE_BEGIN
#ifndef NO_ATT
        for (int r_ = 0; r_ < REP_ATT; ++r_)
        for (int u = ((G & 7) == 0 ? (bid & 7) * (G >> 3) + (bid >> 3) : bid); u < 256; u += G) { const int bh = u >> 2, s = u & 3;
            att::attn_block(bh >> 3, bh & 7, 7 - s, QB, KN, KR, VB, OB, lds);
            att::attn_block(bh >> 3, bh & 7, s, QB, KN, KR, VB, OB, lds); }
#endif
        PHASE_END
        PHASE_BEGIN
#ifndef NO_G6
        for (int r_ = 0; r_ < REP_MERGE; ++r_) { pg8::Gemm g{GG, OB, AC, (bf16_t*)(WB + W_LRUO), (bf16_t*)(WB + W_MLAO), (bf16_t*)(WB + W_CONVO), MROWS, DM, 512, 512}; pg8::StaticOrder S; S.init(MROWS, DM, G, bid, 3);
          pg8::EpiMerge E{GB, INF(24) + l * DM, MG}; pg8::gemm_phase<pg8::EpiMerge, true>(lds, g, S, E); }
#endif
        PHASE_END
        PHASE_BEGIN
#ifndef NO_G7
        { pg8::Gemm g{MG, MG, MG, (bf16_t*)(WB + W_OUT), nullptr, nullptr, MROWS, DM, DM, DM}; pg8::StaticOrder S; S.init(MROWS, DM, G, bid, 1);
          pg8::EpiRes E{XB, 1.0f, ss2, nullptr}; pg8::gemm_phase<pg8::EpiRes, true>(lds, g, S, E); }
#endif
        PHASE_END
        PHASE_BEGIN
#ifndef NO_G8
        { pg8::Gemm g{XB, XB, XB, (bf16_t*)(WB + W_F2W1), nullptr, nullptr, MROWS, 5632, DM, DM}; pg8::StaticOrder S; S.init(MROWS, 5632, G, bid, 1, false);
          pg8::EpiUp E{HB, ss2}; pg8::gemm_phase<pg8::EpiUp, true>(lds, g, S, E);
          pg8::TailOrder T; T.init(MROWS, 5632, G, bid);
          if (T.on) { const int kh = T.half() * 512; pg8::Gemm gt{XB + kh, XB + kh, XB + kh, (bf16_t*)(WB + W_F2W1) + kh, nullptr, nullptr, MROWS, 5632, 512, DM};
              pg8::EpiUpTail Et{HB, ss2, (float*)do_, (unsigned*)(ws_ + WS_SPLITF) + (l * 2 + 1) * 128}; pg8::gemm_phase<pg8::EpiUpTail, true, pg8::TailOrder>(lds, gt, T, Et); } }
#endif
        PHASE_END
        PHASE_BEGIN
#ifndef NO_G9
        { pg8::Gemm g{HB, HB, HB, (bf16_t*)(WB + W_F2W2), nullptr, nullptr, MROWS, DM, FF, FF}; pg8::StaticOrder S; S.init(MROWS, DM, G, bid, 1);
          pg8::EpiRes E{XB, 0.5f, ss3, (l == 1) ? (float*)do_ : nullptr}; pg8::gemm_phase<pg8::EpiRes, true>(lds, g, S, E); }
#endif
        PHASE_END
    }
    PHASE_BEGIN
    {
        OPAQUE_TID
        const float* ssf = (const float*)(ws_ + WS_SSA); const float* gf = INF(29);
        for (int m = gw; m < MROWS; m += NGW) {
            const float rs = rsqrtf(sum_slots16(ssf + (size_t)m * 16) * (1.0f / DM) + EPS);
            f32x4* xr = (f32x4*)((float*)do_ + (size_t)m * DM) + lane; const f32x4* gr = (const f32x4*)gf + lane;
#pragma unroll
            for (int j = 0; j < 4; ++j) xr[64 * j] = xr[64 * j] * rs * gr[64 * j];
        }
    }
    PHASE_END
}

constexpr int N_PHASES = 21;
#ifndef MK_PER_PHASE
#define MK_PER_PHASE 0
#endif

extern "C" void kernel_launch(void* const* d_in, const int* in_sizes, int n_in, void* d_out, int out_size, void* d_ws, size_t ws_size, hipStream_t stream) {
    static int grid = 0;
    if (grid == 0) {
        if (n_in != 30 || out_size != MROWS * DM || ws_size < WS_END) { fprintf(stderr, "kernel_launch: unexpected problem (n_in %d out %d ws %zu)\n", n_in, out_size, ws_size); grid = -1; return; }
        int dev = 0, cus = 0, per_cu = 0;
        hipGetDevice(&dev); hipDeviceGetAttribute(&cus, hipDeviceAttributeMultiprocessorCount, dev);
        hipFuncSetAttribute((const void*)fwd_kernel, hipFuncAttributeMaxDynamicSharedMemorySize, LDS_BYTES);
        hipOccupancyMaxActiveBlocksPerMultiprocessor(&per_cu, (const void*)fwd_kernel, 512, LDS_BYTES);
        if (per_cu < 1) { fprintf(stderr, "kernel_launch: occupancy query says %d blocks per CU\n", per_cu); per_cu = 1; }
        (void)hipGetLastError();
        grid = cus * 1;
    }
    if (grid < 0) return;
    hipMemsetAsync((char*)d_ws + WS_BAR, 0, BAR_ZERO_BYTES, stream);
    KArgs a{};
    for (int i = 0; i < 30; ++i) a.in[i] = d_in[i];
    a.out = (float*)d_out; a.ws = (unsigned char*)d_ws;
#if MK_PER_PHASE
    for (int p = 0; p < N_PHASES; ++p) { a.ph_lo = p; a.ph_hi = p + 1; hipLaunchKernelGGL(fwd_kernel, dim3(grid), dim3(512), LDS_BYTES, stream, a); }
#else
    a.ph_lo = 0; a.ph_hi = N_PHASES;
    void* args[] = {&a};
    hipError_t e = hipLaunchCooperativeKernel((const void*)fwd_kernel, dim3(grid), dim3(512), args, LDS_BYTES, stream);
    if (e != hipSuccess) fprintf(stderr, "cooperative launch failed: %s (grid %d)\n", hipGetErrorString(e), grid);
#endif
}
```
